# Optimizing an MI355X kernel written in HIP

```python
import math
import jax, jax.numpy as jnp
from jax import lax
import numpy as np

D_MODEL = 2048
BATCH = 4
SEQ = 2048
DEPTH = 1

GRID_W = 64
D_SSM = 1024
SSM_GROUP = 16
N_SSM_GROUPS = D_SSM // SSM_GROUP
SSM_STATE = 64
DT_MIN = 1e-3
DT_MAX = 1e-1
N_HEADS = 16
HEAD_DIM = 64
D_ATTN = N_HEADS * HEAD_DIM
WIN_H_MAX = 8
WIN_W = 16
D_MIX = D_SSM + D_ATTN
D_IN_PROJ = D_SSM + 3 * D_ATTN
N_EXPERTS = 16
CAPACITY_FACTOR = 2
D_FF_EXPERT = 2816
EPS = 1e-6

kernel_name = "hybrid_s5_natten_ecmoe_encoder"


def rms_norm(x, g):
    xf = x.astype(jnp.float32)
    y = xf * lax.rsqrt(jnp.mean(xf * xf, axis=-1, keepdims=True) + EPS)
    return (y * g.astype(jnp.float32)).astype(x.dtype)


def modulate(h, shift, scale):
    return h * (1.0 + scale[:, None, :]) + shift[:, None, :]


def _complex_linear_scan(a_re, a_im, b_re, b_im):
    def combine(e1, e2):
        a1r, a1i, b1r, b1i = e1
        a2r, a2i, b2r, b2i = e2
        ar = a1r * a2r - a1i * a2i
        ai = a1r * a2i + a1i * a2r
        br = a2r * b1r - a2i * b1i + b2r
        bi = a2r * b1i + a2i * b1r + b2i
        return (ar, ai, br, bi)
    _, _, xr, xi = lax.associative_scan(combine, (a_re, a_im, b_re, b_im), axis=1)
    return xr, xi


def s5_mixer(u, a_re, a_im, log_dt, b_re, b_im, c_re, c_im, d_skip, w_glu, b_glu):
    bsz, L, _ = u.shape
    ug = u.reshape(bsz, L, N_SSM_GROUPS, SSM_GROUP).astype(jnp.float32)
    y = (d_skip * u).astype(jnp.float32).reshape(bsz, L, N_SSM_GROUPS, SSM_GROUP)
    for direction in range(2):
        dt = jnp.exp(log_dt[direction].astype(jnp.float32))[:, None]
        lr = a_re[direction].astype(jnp.float32)
        li = a_im[direction].astype(jnp.float32)
        mag = jnp.exp(lr * dt)
        lbr = mag * jnp.cos(li * dt)
        lbi = mag * jnp.sin(li * dt)
        den = lr * lr + li * li
        nr = lbr - 1.0
        fr = (nr * lr + lbi * li) / den
        fi = (lbi * lr - nr * li) / den
        br = b_re[direction].astype(jnp.float32)
        bi = b_im[direction].astype(jnp.float32)
        bbr = fr[..., None] * br - fi[..., None] * bi
        bbi = fr[..., None] * bi + fi[..., None] * br
        bu_re = jnp.einsum('blgh,gph->blgp', ug, bbr)
        bu_im = jnp.einsum('blgh,gph->blgp', ug, bbi)
        if direction == 1:
            bu_re = jnp.flip(bu_re, axis=1)
            bu_im = jnp.flip(bu_im, axis=1)
        ar = jnp.broadcast_to(lbr[None, None], (1, L, N_SSM_GROUPS, SSM_STATE))
        ai = jnp.broadcast_to(lbi[None, None], (1, L, N_SSM_GROUPS, SSM_STATE))
        xr, xi = _complex_linear_scan(ar, ai, bu_re, bu_im)
        if direction == 1:
            xr = jnp.flip(xr, axis=1)
            xi = jnp.flip(xi, axis=1)
        y = y + jnp.einsum('blgp,ghp->blgh', xr, c_re[direction].astype(jnp.float32)) \
              - jnp.einsum('blgp,ghp->blgh', xi, c_im[direction].astype(jnp.float32))
    y = y.reshape(bsz, L, D_SSM).astype(u.dtype)
    z = jax.nn.gelu(y)
    return z * jax.nn.sigmoid(z @ w_glu + b_glu)


def neighbourhood_attention(q, k, v, rpb):
    bsz, L, H, Dh = q.shape
    rows = L // GRID_W
    kh = min(WIN_H_MAX, rows)
    r = jnp.arange(rows)
    row_start = jnp.clip(r - kh // 2, 0, rows - kh)
    row_idx = row_start[:, None] + jnp.arange(kh)[None, :]
    w = jnp.arange(GRID_W)
    col_start = jnp.clip(w - WIN_W // 2, 0, GRID_W - WIN_W)
    col_mask = (w[None, :] >= col_start[:, None]) & (w[None, :] < col_start[:, None] + WIN_W)

    qg = q.reshape(bsz, rows, GRID_W, H, Dh)
    kg = k.reshape(bsz, rows, GRID_W, H, Dh)[:, row_idx]
    vg = v.reshape(bsz, rows, GRID_W, H, Dh)[:, row_idx]
    s = jnp.einsum('brqhd,brjkhd->bhrqjk', qg, kg).astype(jnp.float32) * (Dh ** -0.5)
    dr = row_idx - r[:, None] + (WIN_H_MAX - 1)
    dc = jnp.clip(w[None, :] - w[:, None] + (WIN_W - 1), 0, 2 * WIN_W - 2)
    bias = rpb[:, dr[:, None, :, None], dc[None, :, None, :]].astype(jnp.float32)
    s = s + bias[None]
    s = jnp.where(col_mask[None, None, None, :, None, :], s, jnp.float32(-1e30))
    shp = s.shape
    p = jax.nn.softmax(s.reshape(shp[:-2] + (kh * GRID_W,)), axis=-1).reshape(shp)
    out = jnp.einsum('bhrqjk,brjkhd->brqhd', p.astype(v.dtype), vg)
    return out.reshape(bsz, L, H * Dh)


def expert_choice_ffn(h, w_router, w_gate, w_up, w_down):
    bsz, L, _ = h.shape
    cap = CAPACITY_FACTOR * L // N_EXPERTS
    logits = jnp.einsum('bld,de->ble', h, w_router).astype(jnp.float32)
    aff = jax.nn.softmax(logits, axis=-1)
    top_aff, top_idx = lax.top_k(jnp.swapaxes(aff, 1, 2), cap)
    b_idx = jnp.arange(bsz)[:, None, None]
    xe = h[b_idx, top_idx]
    hid = jax.nn.silu(jnp.einsum('becd,edf->becf', xe, w_gate)) * jnp.einsum('becd,edf->becf', xe, w_up)
    ye = jnp.einsum('becf,efd->becd', hid, w_down) * top_aff[..., None].astype(h.dtype)
    return jnp.zeros_like(h).at[b_idx, top_idx].add(ye)


def setup_inputs(seed: int = 0) -> dict:
    key = jax.random.key(seed)
    ks = jax.random.split(key, 32)
    f32 = jnp.float32

    def nrm(k, shape, s):
        return jax.random.normal(k, shape, f32) * s

    G, P, H = N_SSM_GROUPS, SSM_STATE, SSM_GROUP
    n = jnp.arange(P, dtype=f32)
    return {
        "x": nrm(ks[0], (BATCH, SEQ, D_MODEL), 1.0),
        "c": nrm(ks[1], (BATCH, D_MODEL), 1.0),
        "w_ada": nrm(ks[2], (DEPTH, D_MODEL, 6 * D_MODEL), 0.5 * D_MODEL ** -0.5),
        "b_ada": nrm(ks[3], (DEPTH, 6 * D_MODEL), 0.02),
        "g_mix": 1.0 + nrm(ks[4], (DEPTH, D_MODEL), 0.02),
        "w_in": nrm(ks[5], (DEPTH, D_MODEL, D_IN_PROJ), D_MODEL ** -0.5),
        "ssm_a_re": -0.5 + nrm(ks[6], (DEPTH, 2, G, P), 0.02),
        "ssm_a_im": math.pi * n + nrm(ks[7], (DEPTH, 2, G, P), 0.02),
        "ssm_log_dt": jax.random.uniform(ks[8], (DEPTH, 2, G), f32, math.log(DT_MIN), math.log(DT_MAX)),
        "ssm_b_re": nrm(ks[9], (DEPTH, 2, G, P, H), (2 * H) ** -0.5),
        "ssm_b_im": nrm(ks[10], (DEPTH, 2, G, P, H), (2 * H) ** -0.5),
        "ssm_c_re": nrm(ks[11], (DEPTH, 2, G, H, P), (2 * P) ** -0.5),
        "ssm_c_im": nrm(ks[12], (DEPTH, 2, G, H, P), (2 * P) ** -0.5),
        "ssm_d": nrm(ks[13], (DEPTH, D_SSM), 1.0),
        "w_glu": nrm(ks[14], (DEPTH, D_SSM, D_SSM), D_SSM ** -0.5),
        "b_glu": nrm(ks[15], (DEPTH, D_SSM), 0.02),
        "rpb": nrm(ks[16], (DEPTH, N_HEADS, 2 * WIN_H_MAX - 1, 2 * WIN_W - 1), 0.1),
        "g_ssm_out": 1.0 + nrm(ks[17], (DEPTH, D_SSM), 0.02),
        "g_attn_out": 1.0 + nrm(ks[18], (DEPTH, D_ATTN), 0.02),
        "w_out": nrm(ks[19], (DEPTH, D_MIX, D_MODEL), D_MIX ** -0.5),
        "g_ffn": 1.0 + nrm(ks[20], (DEPTH, D_MODEL), 0.02),
        "w_router": nrm(ks[21], (DEPTH, D_MODEL, N_EXPERTS), D_MODEL ** -0.5),
        "w_gate": nrm(ks[22], (DEPTH, N_EXPERTS, D_MODEL, D_FF_EXPERT), D_MODEL ** -0.5),
        "w_up": nrm(ks[23], (DEPTH, N_EXPERTS, D_MODEL, D_FF_EXPERT), D_MODEL ** -0.5),
        "w_down": nrm(ks[24], (DEPTH, N_EXPERTS, D_FF_EXPERT, D_MODEL), D_FF_EXPERT ** -0.5),
        "g_final": 1.0 + nrm(ks[25], (D_MODEL,), 0.02),
    }


def reference(x, c, w_ada, b_ada, g_mix, w_in, ssm_a_re, ssm_a_im, ssm_log_dt,
              ssm_b_re, ssm_b_im, ssm_c_re, ssm_c_im, ssm_d, w_glu, b_glu, rpb,
              g_ssm_out, g_attn_out, w_out, g_ffn, w_router, w_gate, w_up, w_down,
              g_final):
    bsz, L, _ = x.shape
    c_act = jax.nn.silu(c)
    for layer in range(DEPTH):
        mod = c_act @ w_ada[layer] + b_ada[layer]
        sh1, sc1, gt1, sh2, sc2, gt2 = jnp.split(mod, 6, axis=-1)

        h = modulate(rms_norm(x, g_mix[layer]), sh1, sc1)
        proj = h @ w_in[layer]
        u, q, k, v = jnp.split(proj, [D_SSM, D_SSM + D_ATTN, D_SSM + 2 * D_ATTN], axis=-1)
        y_ssm = s5_mixer(u, ssm_a_re[layer], ssm_a_im[layer], ssm_log_dt[layer],
                         ssm_b_re[layer], ssm_b_im[layer], ssm_c_re[layer], ssm_c_im[layer],
                         ssm_d[layer], w_glu[layer], b_glu[layer])
        y_attn = neighbourhood_attention(q.reshape(bsz, L, N_HEADS, HEAD_DIM),
                                         k.reshape(bsz, L, N_HEADS, HEAD_DIM),
                                         v.reshape(bsz, L, N_HEADS, HEAD_DIM), rpb[layer])
        mixed = jnp.concatenate([rms_norm(y_ssm, g_ssm_out[layer]),
                                 rms_norm(y_attn, g_attn_out[layer])], axis=-1)
        x = x + gt1[:, None, :] * (mixed @ w_out[layer])

        h = modulate(rms_norm(x, g_ffn[layer]), sh2, sc2)
        x = x + gt2[:, None, :] * expert_choice_ffn(h, w_router[layer], w_gate[layer],
                                                     w_up[layer], w_down[layer])
    return rms_norm(x, g_final)
```

```cpp
#include <hip/hip_runtime.h>
#include <stdint.h>
#include <stdio.h>

#ifndef N_LAUNCH_MODE
#define N_LAUNCH_MODE 0
#endif

#define LAS __attribute__((address_space(3)))
typedef unsigned short bf16_t;
typedef float f32x4 __attribute__((ext_vector_type(4)));
typedef float f32x2 __attribute__((ext_vector_type(2)));
typedef short bf16x8 __attribute__((ext_vector_type(8)));
typedef short s16x4 __attribute__((ext_vector_type(4)));
typedef unsigned u32x2 __attribute__((ext_vector_type(2)));
typedef unsigned u32x4 __attribute__((ext_vector_type(4)));

constexpr int NT = 512;
constexpr int TOK = 8192, DM = 2048, NB = 4, SEQ = 2048;
constexpr int DSSM = 1024, DATT = 1024, NH = 16, HD = 64, DINP = 4096;
constexpr int NE = 16, CAP = 256, DFF = 2816;
constexpr int NG = 64, NP = 64, GH = 16;
constexpr float EPS = 1e-6f;

constexpr size_t al256(size_t x) { return (x + 255) & ~(size_t)255; }
constexpr size_t WS_CTL   = 0;
constexpr size_t CTL_BYTES = 32768;
constexpr size_t WS_MOD   = WS_CTL + CTL_BYTES;
constexpr size_t WS_H1    = al256(WS_MOD + (size_t)NB * 12288 * 4);
constexpr size_t WS_UX    = al256(WS_H1 + (size_t)TOK * DM * 2);
constexpr size_t WS_Q     = al256(WS_UX + (size_t)64 * 512 * 512 * 2);
constexpr size_t WS_K     = al256(WS_Q + (size_t)TOK * 1024 * 2);
constexpr size_t WS_V     = al256(WS_K + (size_t)TOK * 1024 * 2);
constexpr size_t WS_SS    = al256(WS_V + (size_t)TOK * 1024 * 2);
constexpr size_t WS_ZB    = al256(WS_SS + (size_t)64 * 512 * 256 * 4);
constexpr size_t WS_YSSM  = al256(WS_ZB + (size_t)TOK * 1024 * 2);
constexpr size_t WS_YATT  = al256(WS_YSSM + (size_t)TOK * 1024 * 2);
constexpr size_t WS_MIX   = al256(WS_YATT + (size_t)TOK * 1024 * 2);
constexpr size_t WS_X1    = al256(WS_MIX + (size_t)TOK * DM * 2);
constexpr size_t WS_H2    = al256(WS_X1 + (size_t)TOK * DM * 4);
constexpr size_t WS_AFF   = al256(WS_H2 + (size_t)TOK * DM * 2);
constexpr size_t WS_IDX   = al256(WS_AFF + (size_t)NB * NE * SEQ * 4);
constexpr size_t WS_WAFF  = al256(WS_IDX + (size_t)NB * NE * CAP * 4);
constexpr size_t WS_SLOT  = al256(WS_WAFF + (size_t)NB * NE * CAP * 4);
constexpr size_t WS_HID   = al256(WS_SLOT + (size_t)NB * NE * SEQ * 4);
constexpr size_t WS_YE    = al256(WS_HID + (size_t)NE * 1024 * DFF * 2);
constexpr size_t WS_BMAT  = al256(WS_YE + (size_t)NE * 1024 * DM * 2);
constexpr size_t WS_KCMAT = al256(WS_BMAT + (size_t)64 * 256 * 256 * 2);
constexpr size_t WS_LAM   = al256(WS_KCMAT + (size_t)64 * 512 * 256 * 2);
constexpr size_t WS_END   = al256(WS_LAM + (size_t)2 * 64 * 64 * 2 * 4);

constexpr int LDS_BYTES = 147456;

__device__ __forceinline__ bf16_t f2bf(float f) { unsigned u = __float_as_uint(f); u += 0x7FFFu + ((u >> 16) & 1u); return (bf16_t)(u >> 16); }
__device__ __forceinline__ float bf2f(bf16_t b) { return __uint_as_float(((unsigned)b) << 16); }
__device__ __forceinline__ float bflo(unsigned w) { return __uint_as_float(w << 16); }
__device__ __forceinline__ float bfhi(unsigned w) { return __uint_as_float(w & 0xffff0000u); }
__device__ __forceinline__ unsigned pack2(float lo, float hi) { return (unsigned)f2bf(lo) | ((unsigned)f2bf(hi) << 16); }
__device__ __forceinline__ float wave_sum(float v) {
#pragma unroll
    for (int m = 32; m >= 1; m >>= 1) v += __shfl_xor(v, m);
    return v;
}
__device__ __forceinline__ float silu_f(float v) { return v / (1.0f + __expf(-v)); }
__device__ __forceinline__ float sigmoid_f(float v) { return 1.0f / (1.0f + __expf(-v)); }
__device__ __forceinline__ float gelu_tanh(float y) { const float t = 0.7978845608028654f * (y + 0.044715f * y * y * y); return 0.5f * y * (1.0f + tanhf(t)); }

#define XB_TMO      128
#define XB_XCNT(j)  (256  + 64 * (j))
#define XB_XSUB(j)  (1280 + 64 * (j))
#define XB_XGEN(j)  (2304 + 64 * (j))
#define XB_TOP      3328
#define XB_TOPGEN   3392
#define XCD_BAR_WORDS 3456
#define XB_SPIN_CAP (1u << 18)
__device__ __forceinline__ unsigned xb_ld(unsigned* p)              { return __hip_atomic_load(p, __ATOMIC_RELAXED, __HIP_MEMORY_SCOPE_AGENT); }
__device__ __forceinline__ unsigned xb_add(unsigned* p, unsigned v) { return __hip_atomic_fetch_add(p, v, __ATOMIC_RELAXED, __HIP_MEMORY_SCOPE_AGENT); }
__device__ __forceinline__ unsigned xb_xcc_id() { return (unsigned)__builtin_amdgcn_s_getreg((3 << 11) | 20) & 0xFu; }
#define XB_SPIN(cond, bar) do { unsigned _sp = 0; while (cond) { __builtin_amdgcn_s_sleep(1); \
    if ((++_sp & 255u) == 0u) { if (xb_ld(&(bar)[XB_TMO])) break; if (_sp > XB_SPIN_CAP) { atomicAdd(&(bar)[XB_TMO], 1u); break; } } } } while (0)
struct XcdBarrier { unsigned* bar; unsigned x; volatile LAS unsigned* st; };
__device__ __forceinline__ XcdBarrier xcd_barrier_post(unsigned* bar, volatile LAS unsigned* st) {
    XcdBarrier b; b.bar = bar; b.x = xb_xcc_id(); b.st = st;
    if (threadIdx.x == 0) (void)xb_add(&bar[XB_XCNT(b.x)], 1u);
    return b;
}
__device__ __forceinline__ void xcd_barrier_complete(unsigned* bar, unsigned x, unsigned& nloc, unsigned& nx) {
    const unsigned G = gridDim.x * gridDim.y * gridDim.z;
    unsigned sum, cnt, mine, sp = 0u;
    for (;;) {
        sum = 0u; cnt = 0u; mine = 0u;
#pragma unroll
        for (unsigned j = 0; j < 16; ++j) { const unsigned c = xb_ld(&bar[XB_XCNT(j)]); sum += c; cnt += (c > 0u) ? 1u : 0u; mine = (j == x) ? c : mine; }
        if (sum == G) break;
        __builtin_amdgcn_s_sleep(1);
        if ((++sp & 255u) == 0u) { if (xb_ld(&bar[XB_TMO])) break; if (sp > XB_SPIN_CAP) { atomicAdd(&bar[XB_TMO], 1u); break; } }
    }
    nloc = mine > 0u ? mine : 1u; nx = cnt > 0u ? cnt : 1u;
}
__device__ __forceinline__ void xcd_barrier(const XcdBarrier& b) {
    asm volatile("s_waitcnt vmcnt(0)" ::: "memory");
    __syncthreads();
    if (threadIdx.x == 0) {
        unsigned* bar = b.bar;
        __builtin_amdgcn_s_waitcnt(0);
        unsigned nloc = b.st[0], nx = b.st[1];
        if (nloc == 0u) { xcd_barrier_complete(bar, b.x, nloc, nx); b.st[0] = nloc; b.st[1] = nx; }
        const unsigned old = xb_add(&bar[XB_XSUB(b.x)], 1u);
        const unsigned gen = old / nloc;
        if (old + 1u == (gen + 1u) * nloc) {
            __builtin_amdgcn_fence(__ATOMIC_RELEASE, "agent");
            asm volatile("s_waitcnt vmcnt(0)" ::: "memory");
            const unsigned og = xb_add(&bar[XB_TOP], 1u);
            const unsigned tg = og / nx;
            if (og + 1u == (tg + 1u) * nx) xb_add(&bar[XB_TOPGEN], 1u);
            else XB_SPIN(xb_ld(&bar[XB_TOPGEN]) == tg, bar);
            __builtin_amdgcn_fence(__ATOMIC_ACQUIRE, "agent");
            xb_add(&bar[XB_XGEN(b.x)], 1u);
            asm volatile("s_waitcnt vmcnt(0)" ::: "memory");
        } else {
            XB_SPIN(xb_ld(&bar[XB_XGEN(b.x)]) == gen, bar);
            __builtin_amdgcn_fence(__ATOMIC_ACQUIRE, "agent");
            asm volatile("s_waitcnt vmcnt(0)" ::: "memory");
        }
    }
    __syncthreads();
}

struct Args { const float* in[26]; float* out; unsigned char* ws; int ph_lo, ph_hi; };
enum { I_X = 0, I_C, I_WADA, I_BADA, I_GMIX, I_WIN, I_ARE, I_AIM, I_LOGDT, I_BRE, I_BIM, I_CRE, I_CIM, I_SSMD, I_WGLU, I_BGLU, I_RPB,
       I_GSSM, I_GATT, I_WOUT, I_GFFN, I_WROUTER, I_WGATE, I_WUP, I_WDOWN, I_GFINAL };

struct ARows { const bf16_t* base; size_t ld; __device__ __forceinline__ const bf16_t* ptr(int r) const { return base + (size_t)r * ld; } };
struct AGather { const bf16_t* base; const int* idx; int e;
    __device__ __forceinline__ const bf16_t* ptr(int r) const { const int b = r >> 8; return base + (size_t)(b * SEQ + idx[(b * NE + e) * CAP + (r & 255)]) * DM; } };
struct BF32 { const float* base; size_t ld; __device__ __forceinline__ float get(int k, int n) const { return base[(size_t)k * ld + n]; }
    __device__ __forceinline__ float get2(int, int) const { return 0.f; } };
struct BF32Dual { const float* g; const float* u; size_t ld; __device__ __forceinline__ float get(int k, int n) const { return g[(size_t)k * ld + n]; }
    __device__ __forceinline__ float get2(int k, int n) const { return u[(size_t)k * ld + n]; } };

struct EpiInProj { bf16_t* UX; bf16_t* Q; bf16_t* K; bf16_t* V;
    __device__ __forceinline__ void store(int t, int n, float v) const {
        if (n < 1024) { const int g = n >> 4, h = n & 15, b = t >> 11, l = t & 2047; UX[(size_t)(g * 512 + b * 128 + (l >> 4)) * 512 + (l & 15) * 16 + h] = f2bf(v); }
        else if (n < 2048) Q[(size_t)t * 1024 + (n - 1024)] = f2bf(v * 0.125f);
        else if (n < 3072) K[(size_t)t * 1024 + (n - 2048)] = f2bf(v);
        else V[(size_t)t * 1024 + (n - 3072)] = f2bf(v);
    }
    __device__ __forceinline__ void store2(int, int, float, float) const {} };
struct EpiGlu { const bf16_t* Z; const float* bglu; bf16_t* Y;
    __device__ __forceinline__ void store(int t, int n, float v) const { const float gate = v + bglu[n]; const float z = bf2f(Z[(size_t)t * 1024 + n]); Y[(size_t)t * 1024 + n] = f2bf(z * sigmoid_f(gate)); }
    __device__ __forceinline__ void store2(int, int, float, float) const {} };
struct EpiOut { const float* x; const float* mod; float* X1;
    __device__ __forceinline__ void store(int t, int n, float v) const { const int b = t >> 11; X1[(size_t)t * DM + n] = x[(size_t)t * DM + n] + mod[b * 12288 + 4096 + n] * v; }
    __device__ __forceinline__ void store2(int, int, float, float) const {} };
struct EpiMoe1 { bf16_t* HID;
    __device__ __forceinline__ void store(int, int, float) const {}
    __device__ __forceinline__ void store2(int r, int n, float g, float u) const { HID[(size_t)r * DFF + n] = f2bf(silu_f(g) * u); } };
struct EpiMoe2 { bf16_t* YE; const float* waff; int e;
    __device__ __forceinline__ void store(int r, int n, float v) const { const int b = r >> 8; YE[(size_t)r * DM + n] = f2bf(v * waff[(b * NE + e) * CAP + (r & 255)]); }
    __device__ __forceinline__ void store2(int, int, float, float) const {} };

template <class AF, class BF, class EF, bool DUAL>
__device__ __forceinline__ void gemm_naive_tile(float* lds, const AF& A, const BF& Bm, const EF& E, int m0, int n0, int K) {
    float* As = lds;
    float* Bs = lds + 16 * 132;
    float* Bs2 = Bs + 16 * 68;
    float acc[4][4], acc2[4][4];
#pragma unroll
    for (int i = 0; i < 4; ++i)
#pragma unroll
        for (int j = 0; j < 4; ++j) { acc[i][j] = 0.f; acc2[i][j] = 0.f; }
    const int tid = threadIdx.x, tm = tid >> 4, tn = tid & 15;
    const int ar = tid >> 2, ak = (tid & 3) * 4;
    const bf16_t* ap = A.ptr(m0 + ar);
    const int bk = tid >> 5, bc = (tid & 31) * 2;
    for (int k0 = 0; k0 < K; k0 += 16) {
        const u32x2 av = *(const u32x2*)(ap + k0 + ak);
        As[(ak + 0) * 132 + ar] = bflo(av.x); As[(ak + 1) * 132 + ar] = bfhi(av.x); As[(ak + 2) * 132 + ar] = bflo(av.y); As[(ak + 3) * 132 + ar] = bfhi(av.y);
        Bs[bk * 68 + bc] = Bm.get(k0 + bk, n0 + bc); Bs[bk * 68 + bc + 1] = Bm.get(k0 + bk, n0 + bc + 1);
        if (DUAL) { Bs2[bk * 68 + bc] = Bm.get2(k0 + bk, n0 + bc); Bs2[bk * 68 + bc + 1] = Bm.get2(k0 + bk, n0 + bc + 1); }
        __syncthreads();
#pragma unroll
        for (int kk = 0; kk < 16; ++kk) {
            const f32x4 a4 = *(const f32x4*)(As + kk * 132 + tm * 4);
            const f32x4 b4 = *(const f32x4*)(Bs + kk * 68 + tn * 4);
#pragma unroll
            for (int i = 0; i < 4; ++i)
#pragma unroll
                for (int j = 0; j < 4; ++j) acc[i][j] += a4[i] * b4[j];
            if (DUAL) {
                const f32x4 c4 = *(const f32x4*)(Bs2 + kk * 68 + tn * 4);
#pragma unroll
                for (int i = 0; i < 4; ++i)
#pragma unroll
                    for (int j = 0; j < 4; ++j) acc2[i][j] += a4[i] * c4[j];
            }
        }
        __syncthreads();
    }
#pragma unroll
    for (int i = 0; i < 4; ++i)
#pragma unroll
        for (int j = 0; j < 4; ++j) { if (DUAL) E.store2(m0 + tm * 4 + i, n0 + tn * 4 + j, acc[i][j], acc2[i][j]); else E.store(m0 + tm * 4 + i, n0 + tn * 4 + j, acc[i][j]); }
}

struct Frame {
    const float* in[26]; float* out; unsigned char* ws; unsigned char* lds;
    int tid, lane, wave, G, bid;
    __device__ __forceinline__ float* modp() const { return (float*)(ws + WS_MOD); }
};

__device__ __forceinline__ void p_ada(const Frame& F) {
    float* sc = (float*)F.lds;
    float* red = sc + 4 * 2048;
    const float* c = F.in[I_C]; const float* w = F.in[I_WADA]; const float* bias = F.in[I_BADA];
    for (int i = F.tid; i < 4 * 2048; i += NT) sc[i] = silu_f(c[i]);
    __syncthreads();
    const int cq = F.tid & 15, kq = F.tid >> 4;
    for (int u = F.bid; u < 192; u += F.G) {
        const int n0 = u * 64 + cq * 4;
        float acc[4][4];
#pragma unroll
        for (int b = 0; b < 4; ++b)
#pragma unroll
            for (int j = 0; j < 4; ++j) acc[b][j] = 0.f;
#pragma unroll 8
        for (int k = kq; k < 2048; k += 32) {
            const f32x4 wv = *(const f32x4*)(w + (size_t)k * 12288 + n0);
#pragma unroll
            for (int b = 0; b < 4; ++b) { const float s = sc[b * 2048 + k];
#pragma unroll
                for (int j = 0; j < 4; ++j) acc[b][j] += s * wv[j]; }
        }
#pragma unroll
        for (int b = 0; b < 4; ++b)
#pragma unroll
            for (int j = 0; j < 4; ++j) red[(kq * 16 + cq) * 16 + b * 4 + j] = acc[b][j];
        __syncthreads();
        if (F.tid < 256) {
            const int b = F.tid >> 6, col = F.tid & 63;
            float s = 0.f;
            for (int q = 0; q < 32; ++q) s += red[(q * 16 + (col >> 2)) * 16 + b * 4 + (col & 3)];
            F.modp()[b * 12288 + u * 64 + col] = s + bias[u * 64 + col];
        }
        __syncthreads();
    }
}

__device__ __forceinline__ void p_h1(const Frame& F) {
    const float* x = F.in[I_X]; const float* g = F.in[I_GMIX]; const float* mod = F.modp(); bf16_t* H1 = (bf16_t*)(F.ws + WS_H1);
    for (int t = F.bid * 8 + F.wave; t < TOK; t += F.G * 8) {
        const int b = t >> 11; const float* xr = x + (size_t)t * DM;
        f32x4 v[8]; float ss = 0.f;
#pragma unroll
        for (int i = 0; i < 8; ++i) { v[i] = *(const f32x4*)(xr + i * 256 + F.lane * 4); ss += v[i][0] * v[i][0] + v[i][1] * v[i][1] + v[i][2] * v[i][2] + v[i][3] * v[i][3]; }
        ss = wave_sum(ss);
        const float rstd = rsqrtf(ss * (1.0f / DM) + EPS);
#pragma unroll
        for (int i = 0; i < 8; ++i) { const int k = i * 256 + F.lane * 4;
            const f32x4 gv = *(const f32x4*)(g + k), sh = *(const f32x4*)(mod + b * 12288 + k), sc = *(const f32x4*)(mod + b * 12288 + 2048 + k);
            float o[4];
#pragma unroll
            for (int j = 0; j < 4; ++j) o[j] = (v[i][j] * rstd * gv[j]) * (1.0f + sc[j]) + sh[j];
            u32x2 w; w.x = pack2(o[0], o[1]); w.y = pack2(o[2], o[3]);
            *(u32x2*)(H1 + (size_t)t * DM + k) = w; }
    }
}

__device__ __forceinline__ void p_inproj_naive(const Frame& F) {
    const ARows A{(const bf16_t*)(F.ws + WS_H1), DM}; const BF32 Bm{F.in[I_WIN], DINP};
    const EpiInProj E{(bf16_t*)(F.ws + WS_UX), (bf16_t*)(F.ws + WS_Q), (bf16_t*)(F.ws + WS_K), (bf16_t*)(F.ws + WS_V)};
    const int nM = TOK / 128, nN = DINP / 64;
    for (int u = F.bid; u < nM * nN; u += F.G) gemm_naive_tile<ARows, BF32, EpiInProj, false>((float*)F.lds, A, Bm, E, (u / nN) * 128, (u % nN) * 64, DM);
}
__device__ __forceinline__ void p_glu_naive(const Frame& F) {
    const ARows A{(const bf16_t*)(F.ws + WS_ZB), 1024}; const BF32 Bm{F.in[I_WGLU], 1024};
    const EpiGlu E{(const bf16_t*)(F.ws + WS_ZB), F.in[I_BGLU], (bf16_t*)(F.ws + WS_YSSM)};
    const int nM = TOK / 128, nN = 1024 / 64;
    for (int u = F.bid; u < nM * nN; u += F.G) gemm_naive_tile<ARows, BF32, EpiGlu, false>((float*)F.lds, A, Bm, E, (u / nN) * 128, (u % nN) * 64, 1024);
}
__device__ __forceinline__ void p_outproj_naive(const Frame& F) {
    const ARows A{(const bf16_t*)(F.ws + WS_MIX), DM}; const BF32 Bm{F.in[I_WOUT], DM};
    const EpiOut E{F.in[I_X], F.modp(), (float*)(F.ws + WS_X1)};
    const int nM = TOK / 128, nN = DM / 64;
    for (int u = F.bid; u < nM * nN; u += F.G) gemm_naive_tile<ARows, BF32, EpiOut, false>((float*)F.lds, A, Bm, E, (u / nN) * 128, (u % nN) * 64, DM);
}
__device__ __forceinline__ void p_moe1_naive(const Frame& F) {
    const int nM = 1024 / 128, nN = DFF / 64;
    for (int u = F.bid; u < NE * nM * nN; u += F.G) {
        const int e = u / (nM * nN), r = u % (nM * nN);
        const AGather A{(const bf16_t*)(F.ws + WS_H2), (const int*)(F.ws + WS_IDX), e};
        const BF32Dual Bm{F.in[I_WGATE] + (size_t)e * DM * DFF, F.in[I_WUP] + (size_t)e * DM * DFF, DFF};
        const EpiMoe1 E{(bf16_t*)(F.ws + WS_HID) + (size_t)e * 1024 * DFF};
        gemm_naive_tile<AGather, BF32Dual, EpiMoe1, true>((float*)F.lds, A, Bm, E, (r / nN) * 128, (r % nN) * 64, DM);
    }
}
__device__ __forceinline__ void p_moe2_naive(const Frame& F) {
    const int nM = 1024 / 128, nN = DM / 64;
    for (int u = F.bid; u < NE * nM * nN; u += F.G) {
        const int e = u / (nM * nN), r = u % (nM * nN);
        const ARows A{(const bf16_t*)(F.ws + WS_HID) + (size_t)e * 1024 * DFF, DFF};
        const BF32 Bm{F.in[I_WDOWN] + (size_t)e * DFF * DM, DM};
        const EpiMoe2 E{(bf16_t*)(F.ws + WS_YE) + (size_t)e * 1024 * DM, (const float*)(F.ws + WS_WAFF), e};
        gemm_naive_tile<ARows, BF32, EpiMoe2, false>((float*)F.lds, A, Bm, E, (r / nN) * 128, (r % nN) * 64, DFF);
    }
}

__device__ __forceinline__ void p_ssm_naive(const Frame& F) {
    if (F.wave != 0) return;
    const bf16_t* UX = (const bf16_t*)(F.ws + WS_UX); float* ybuf = (float*)(F.ws + WS_SS); bf16_t* ZB = (bf16_t*)(F.ws + WS_ZB);
    const int lane = F.lane;
    for (int u = F.bid; u < NB * NG; u += F.G) {
        const int b = u >> 6, g = u & 63;
        for (int dir = 0; dir < 2; ++dir) {
            const int pg = dir * 64 + g;
            const float dt = expf(F.in[I_LOGDT][pg]);
            const float lr = F.in[I_ARE][pg * 64 + lane], li = F.in[I_AIM][pg * 64 + lane];
            const float mag = expf(lr * dt); const float lbr = mag * cosf(li * dt), lbi = mag * sinf(li * dt);
            const float den = lr * lr + li * li, nr = lbr - 1.0f;
            const float fr = (nr * lr + lbi * li) / den, fi = (lbi * lr - nr * li) / den;
            float bbr[16], bbi[16], cr[16], ci[16];
#pragma unroll
            for (int h = 0; h < 16; ++h) { const float br = F.in[I_BRE][(size_t)(pg * 64 + lane) * 16 + h], bi = F.in[I_BIM][(size_t)(pg * 64 + lane) * 16 + h];
                bbr[h] = fr * br - fi * bi; bbi[h] = fr * bi + fi * br;
                cr[h] = F.in[I_CRE][(size_t)(pg * 16 + h) * 64 + lane]; ci[h] = F.in[I_CIM][(size_t)(pg * 16 + h) * 64 + lane]; }
            const float dsk = F.in[I_SSMD][g * 16 + (lane & 15)];
            float xr = 0.f, xi = 0.f;
            for (int s = 0; s < SEQ; ++s) {
                const int l = dir ? (SEQ - 1 - s) : s;
                const bf16_t* up = UX + (size_t)(g * 512 + b * 128 + (l >> 4)) * 512 + (l & 15) * 16;
                const float uval = bf2f(up[lane & 15]);
                float bur = 0.f, bui = 0.f;
#pragma unroll
                for (int h = 0; h < 16; ++h) { const float uh = __shfl(uval, h); bur += bbr[h] * uh; bui += bbi[h] * uh; }
                const float nxr = lbr * xr - lbi * xi + bur, nxi = lbr * xi + lbi * xr + bui; xr = nxr; xi = nxi;
                float myy = 0.f;
#pragma unroll
                for (int h = 0; h < 16; ++h) { const float v = wave_sum(cr[h] * xr - ci[h] * xi); if (lane == h) myy = v; }
                const size_t o = (size_t)(b * SEQ + l) * 1024 + g * 16;
                if (lane < 16) {
                    if (dir == 0) ybuf[o + lane] = myy;
                    else { const float y = ybuf[o + lane] + myy + dsk * uval; ZB[o + lane] = f2bf(gelu_tanh(y)); }
                }
            }
        }
    }
}

__device__ __forceinline__ void p_attn_naive(const Frame& F) {
    const bf16_t* Q = (const bf16_t*)(F.ws + WS_Q); const bf16_t* Kb = (const bf16_t*)(F.ws + WS_K); const bf16_t* Vb = (const bf16_t*)(F.ws + WS_V);
    bf16_t* Y = (bf16_t*)(F.ws + WS_YATT); const float* rpb = F.in[I_RPB];
    for (int id = F.bid * NT + F.tid; id < TOK * NH; id += F.G * NT) {
        const int t = id >> 4, h = id & 15, b = t >> 11, l = t & 2047, r = l >> 6, w = l & 63;
        int rs = r - 4; rs = rs < 0 ? 0 : (rs > 24 ? 24 : rs);
        int cs = w - 8; cs = cs < 0 ? 0 : (cs > 48 ? 48 : cs);
        float q[64], acc[64];
        const u32x4* qp = (const u32x4*)(Q + (size_t)t * 1024 + h * 64);
#pragma unroll
        for (int i = 0; i < 8; ++i) { const u32x4 v = qp[i]; q[i * 8 + 0] = bflo(v.x); q[i * 8 + 1] = bfhi(v.x); q[i * 8 + 2] = bflo(v.y); q[i * 8 + 3] = bfhi(v.y);
            q[i * 8 + 4] = bflo(v.z); q[i * 8 + 5] = bfhi(v.z); q[i * 8 + 6] = bflo(v.w); q[i * 8 + 7] = bfhi(v.w); }
#pragma unroll
        for (int d = 0; d < 64; ++d) acc[d] = 0.f;
        float m = -1e30f, lsum = 0.f;
        for (int j = 0; j < 8; ++j) {
            const int kr = rs + j, dr = kr - r + 7;
            for (int kk = 0; kk < 16; ++kk) {
                const int wk = cs + kk, dc = wk - w + 15;
                const size_t kt = (size_t)(b * SEQ + kr * 64 + wk) * 1024 + h * 64;
                const u32x4* kp = (const u32x4*)(Kb + kt);
                float s = 0.f;
#pragma unroll
                for (int i = 0; i < 8; ++i) { const u32x4 v = kp[i];
                    s += q[i * 8 + 0] * bflo(v.x) + q[i * 8 + 1] * bfhi(v.x) + q[i * 8 + 2] * bflo(v.y) + q[i * 8 + 3] * bfhi(v.y)
                       + q[i * 8 + 4] * bflo(v.z) + q[i * 8 + 5] * bfhi(v.z) + q[i * 8 + 6] * bflo(v.w) + q[i * 8 + 7] * bfhi(v.w); }
                s += rpb[(h * 15 + dr) * 31 + dc];
                const float mn = fmaxf(m, s); const float corr = __expf(m - mn), p = __expf(s - mn);
                lsum = lsum * corr + p; m = mn;
                const u32x4* vp = (const u32x4*)(Vb + kt);
#pragma unroll
                for (int i = 0; i < 8; ++i) { const u32x4 v = vp[i];
                    acc[i * 8 + 0] = acc[i * 8 + 0] * corr + p * bflo(v.x); acc[i * 8 + 1] = acc[i * 8 + 1] * corr + p * bfhi(v.x);
                    acc[i * 8 + 2] = acc[i * 8 + 2] * corr + p * bflo(v.y); acc[i * 8 + 3] = acc[i * 8 + 3] * corr + p * bfhi(v.y);
                    acc[i * 8 + 4] = acc[i * 8 + 4] * corr + p * bflo(v.z); acc[i * 8 + 5] = acc[i * 8 + 5] * corr + p * bfhi(v.z);
                    acc[i * 8 + 6] = acc[i * 8 + 6] * corr + p * bflo(v.w); acc[i * 8 + 7] = acc[i * 8 + 7] * corr + p * bfhi(v.w); }
            }
        }
        const float inv = 1.0f / lsum;
        u32x4* yp = (u32x4*)(Y + (size_t)t * 1024 + h * 64);
#pragma unroll
        for (int i = 0; i < 8; ++i) { u32x4 o; o.x = pack2(acc[i * 8 + 0] * inv, acc[i * 8 + 1] * inv); o.y = pack2(acc[i * 8 + 2] * inv, acc[i * 8 + 3] * inv);
            o.z = pack2(acc[i * 8 + 4] * inv, acc[i * 8 + 5] * inv); o.w = pack2(acc[i * 8 + 6] * inv, acc[i * 8 + 7] * inv); yp[i] = o; }
    }
}

__device__ __forceinline__ void p_normcat(const Frame& F) {
    const bf16_t* YS = (const bf16_t*)(F.ws + WS_YSSM); const bf16_t* YA = (const bf16_t*)(F.ws + WS_YATT); bf16_t* MIX = (bf16_t*)(F.ws + WS_MIX);
    for (int t = F.bid * 8 + F.wave; t < TOK; t += F.G * 8) {
#pragma unroll
        for (int half = 0; half < 2; ++half) {
            const bf16_t* src = (half ? YA : YS) + (size_t)t * 1024; const float* g = F.in[half ? I_GATT : I_GSSM];
            float v[16]; float ss = 0.f;
#pragma unroll
            for (int i = 0; i < 2; ++i) { const u32x4 w = *(const u32x4*)(src + i * 512 + F.lane * 8);
                v[i * 8 + 0] = bflo(w.x); v[i * 8 + 1] = bfhi(w.x); v[i * 8 + 2] = bflo(w.y); v[i * 8 + 3] = bfhi(w.y); v[i * 8 + 4] = bflo(w.z); v[i * 8 + 5] = bfhi(w.z); v[i * 8 + 6] = bflo(w.w); v[i * 8 + 7] = bfhi(w.w); }
#pragma unroll
            for (int i = 0; i < 16; ++i) ss += v[i] * v[i];
            ss = wave_sum(ss);
            const float rstd = rsqrtf(ss * (1.0f / 1024.0f) + EPS);
#pragma unroll
            for (int i = 0; i < 2; ++i) { const int k = i * 512 + F.lane * 8; const f32x4 g0 = *(const f32x4*)(g + k), g1 = *(const f32x4*)(g + k + 4);
                u32x4 o; o.x = pack2(v[i * 8 + 0] * rstd * g0[0], v[i * 8 + 1] * rstd * g0[1]); o.y = pack2(v[i * 8 + 2] * rstd * g0[2], v[i * 8 + 3] * rstd * g0[3]);
                o.z = pack2(v[i * 8 + 4] * rstd * g1[0], v[i * 8 + 5] * rstd * g1[1]); o.w = pack2(v[i * 8 + 6] * rstd * g1[2], v[i * 8 + 7] * rstd * g1[3]);
                *(u32x4*)(MIX + (size_t)t * DM + half * 1024 + k) = o; }
        }
    }
}

__device__ __forceinline__ void p_h2(const Frame& F) {
    const float* X1 = (const float*)(F.ws + WS_X1); const float* g = F.in[I_GFFN]; const float* mod = F.modp(); const float* wr = F.in[I_WROUTER];
    bf16_t* H2 = (bf16_t*)(F.ws + WS_H2); float* AFF = (float*)(F.ws + WS_AFF);
    for (int t = F.bid * 8 + F.wave; t < TOK; t += F.G * 8) {
        const int b = t >> 11, l = t & 2047; const float* xr = X1 + (size_t)t * DM;
        f32x4 v[8]; float ss = 0.f;
#pragma unroll
        for (int i = 0; i < 8; ++i) { v[i] = *(const f32x4*)(xr + i * 256 + F.lane * 4); ss += v[i][0] * v[i][0] + v[i][1] * v[i][1] + v[i][2] * v[i][2] + v[i][3] * v[i][3]; }
        ss = wave_sum(ss);
        const float rstd = rsqrtf(ss * (1.0f / DM) + EPS);
        float lg[16];
#pragma unroll
        for (int e = 0; e < 16; ++e) lg[e] = 0.f;
#pragma unroll
        for (int i = 0; i < 8; ++i) { const int k = i * 256 + F.lane * 4;
            const f32x4 gv = *(const f32x4*)(g + k), sh = *(const f32x4*)(mod + b * 12288 + 6144 + k), sc = *(const f32x4*)(mod + b * 12288 + 8192 + k);
            float o[4];
#pragma unroll
            for (int j = 0; j < 4; ++j) { o[j] = (v[i][j] * rstd * gv[j]) * (1.0f + sc[j]) + sh[j];
                const f32x4* wp = (const f32x4*)(wr + (size_t)(k + j) * 16);
#pragma unroll
                for (int q = 0; q < 4; ++q) { const f32x4 wv = wp[q]; lg[q * 4 + 0] += o[j] * wv[0]; lg[q * 4 + 1] += o[j] * wv[1]; lg[q * 4 + 2] += o[j] * wv[2]; lg[q * 4 + 3] += o[j] * wv[3]; } }
            u32x2 w; w.x = pack2(o[0], o[1]); w.y = pack2(o[2], o[3]);
            *(u32x2*)(H2 + (size_t)t * DM + k) = w; }
        float mx = -1e30f;
#pragma unroll
        for (int e = 0; e < 16; ++e) { lg[e] = wave_sum(lg[e]); mx = fmaxf(mx, lg[e]); }
        float den = 0.f;
#pragma unroll
        for (int e = 0; e < 16; ++e) { lg[e] = expf(lg[e] - mx); den += lg[e]; }
        float mine = 0.f;
#pragma unroll
        for (int e = 0; e < 16; ++e) if (F.lane == e) mine = lg[e] / den;
        if (F.lane < 16) AFF[(size_t)(b * NE + F.lane) * SEQ + l] = mine;
    }
}

__device__ __forceinline__ void p_topk(const Frame& F) {
    unsigned long long* key = (unsigned long long*)F.lds;
    const float* AFF = (const float*)(F.ws + WS_AFF); int* IDX = (int*)(F.ws + WS_IDX); float* WAFF = (float*)(F.ws + WS_WAFF); int* SLOT = (int*)(F.ws + WS_SLOT);
    for (int u = F.bid; u < NB * NE; u += F.G) {
        for (int i = F.tid; i < SEQ; i += NT) key[i] = ((unsigned long long)__float_as_uint(AFF[(size_t)u * SEQ + i]) << 32) | (unsigned)(0xFFFFFFFFu - (unsigned)i);
        __syncthreads();
        for (int k = 2; k <= SEQ; k <<= 1)
            for (int j = k >> 1; j > 0; j >>= 1) {
                for (int i = F.tid; i < SEQ; i += NT) { const int ixj = i ^ j;
                    if (ixj > i) { const unsigned long long a = key[i], c = key[ixj]; const bool desc = ((i & k) == 0);
                        if (desc ? (a < c) : (a > c)) { key[i] = c; key[ixj] = a; } } }
                __syncthreads();
            }
        for (int i = F.tid; i < SEQ; i += NT) { const unsigned long long kv = key[i]; const int tok = (int)(0xFFFFFFFFu - (unsigned)(kv & 0xFFFFFFFFull));
            if (i < CAP) { IDX[u * CAP + i] = tok; WAFF[u * CAP + i] = __uint_as_float((unsigned)(kv >> 32)); }
            SLOT[(size_t)u * SEQ + tok] = (i < CAP) ? i : -1; }
        __syncthreads();
    }
}

__device__ __forceinline__ void p_final(const Frame& F) {
    const float* X1 = (const float*)(F.ws + WS_X1); const float* mod = F.modp(); const float* g = F.in[I_GFINAL];
    const bf16_t* YE = (const bf16_t*)(F.ws + WS_YE); const int* SLOT = (const int*)(F.ws + WS_SLOT);
    for (int t = F.bid * 8 + F.wave; t < TOK; t += F.G * 8) {
        const int b = t >> 11, l = t & 2047; const float* xr = X1 + (size_t)t * DM;
        f32x4 mo[8];
#pragma unroll
        for (int i = 0; i < 8; ++i) mo[i] = (f32x4){0.f, 0.f, 0.f, 0.f};
        for (int e = 0; e < NE; ++e) {
            const int s = SLOT[(size_t)(b * NE + e) * SEQ + l];
            if (s >= 0) { const bf16_t* yr = YE + ((size_t)e * 1024 + b * 256 + s) * DM;
#pragma unroll
                for (int i = 0; i < 8; ++i) { const u32x2 w = *(const u32x2*)(yr + i * 256 + F.lane * 4); mo[i][0] += bflo(w.x); mo[i][1] += bfhi(w.x); mo[i][2] += bflo(w.y); mo[i][3] += bfhi(w.y); } }
        }
        f32x4 v[8]; float ss = 0.f;
#pragma unroll
        for (int i = 0; i < 8; ++i) { const int k = i * 256 + F.lane * 4; const f32x4 xv = *(const f32x4*)(xr + k), gt = *(const f32x4*)(mod + b * 12288 + 10240 + k);
            v[i] = xv + gt * mo[i]; ss += v[i][0] * v[i][0] + v[i][1] * v[i][1] + v[i][2] * v[i][2] + v[i][3] * v[i][3]; }
        ss = wave_sum(ss);
        const float rstd = rsqrtf(ss * (1.0f / DM) + EPS);
#pragma unroll
        for (int i = 0; i < 8; ++i) { const int k = i * 256 + F.lane * 4; const f32x4 gv = *(const f32x4*)(g + k);
            *(f32x4*)(F.out + (size_t)t * DM + k) = v[i] * rstd * gv; }
    }
}

constexpr int N_PHASES = 14;
__global__ void __launch_bounds__(NT, 2) fwd(Args args) {
    extern __shared__ __attribute__((aligned(16))) unsigned char lds[];
    Frame F;
#pragma unroll
    for (int i = 0; i < 26; ++i) F.in[i] = args.in[i];
    F.out = args.out; F.ws = args.ws; F.lds = lds;
    F.tid = threadIdx.x; F.lane = F.tid & 63; F.wave = __builtin_amdgcn_readfirstlane(F.tid >> 6); F.G = gridDim.x; F.bid = blockIdx.x;
    volatile LAS unsigned* xbw = (volatile LAS unsigned*)(lds + LDS_BYTES - 16);
    if (F.tid == 0) { xbw[0] = 0u; xbw[1] = 0u; xbw[2] = 0u; xbw[3] = 0u; }
    __syncthreads();
    const int lo = args.ph_lo, hi = args.ph_hi;
    XcdBarrier bar; bar.bar = (unsigned*)(F.ws + WS_CTL); bar.x = 0; bar.st = xbw;
    if (hi - lo > 1) bar = xcd_barrier_post((unsigned*)(F.ws + WS_CTL), xbw);
#define IN(k) (lo <= (k) && (k) < hi)
#define SEAM(k) do { if (IN(k) && IN((k) + 1)) xcd_barrier(bar); } while (0)
    if (IN(0)) { p_ada(F); } SEAM(0);
    if (IN(1)) { p_h1(F); } SEAM(1);
    if (IN(2)) { p_inproj_naive(F); } SEAM(2);
    if (IN(3)) { p_ssm_naive(F); __syncthreads(); p_attn_naive(F); } SEAM(3);
    if (IN(4)) { } SEAM(4);
    if (IN(5)) { } SEAM(5);
    if (IN(6)) { p_glu_naive(F); } SEAM(6);
    if (IN(7)) { p_normcat(F); } SEAM(7);
    if (IN(8)) { p_outproj_naive(F); } SEAM(8);
    if (IN(9)) { p_h2(F); } SEAM(9);
    if (IN(10)) { p_topk(F); } SEAM(10);
    if (IN(11)) { p_moe1_naive(F); } SEAM(11);
    if (IN(12)) { p_moe2_naive(F); } SEAM(12);
    if (IN(13)) { p_final(F); }
#undef IN
#undef SEAM
}

extern "C" void kernel_launch(void* const* d_in, const int* in_sizes, int n_in, void* d_out, int out_size, void* d_ws, size_t ws_size, hipStream_t stream) {
    static int grid = 0;
    if (grid == 0) {
        if (n_in != 26 || out_size != TOK * DM || ws_size < WS_END) { fprintf(stderr, "kernel_launch: unexpected problem (n_in %d out %d ws %zu need %zu)\n", n_in, out_size, ws_size, (size_t)WS_END); grid = -1; return; }
        int dev = 0, cus = 0, per_cu = 0;
        if (hipGetDevice(&dev) != hipSuccess || hipDeviceGetAttribute(&cus, hipDeviceAttributeMultiprocessorCount, dev) != hipSuccess) { grid = -1; return; }
        if (hipFuncSetAttribute((const void*)fwd, hipFuncAttributeMaxDynamicSharedMemorySize, LDS_BYTES) != hipSuccess) { fprintf(stderr, "kernel_launch: hipFuncSetAttribute failed\n"); grid = -1; return; }
        if (hipOccupancyMaxActiveBlocksPerMultiprocessor(&per_cu, (const void*)fwd, NT, LDS_BYTES) != hipSuccess || per_cu < 1) { fprintf(stderr, "kernel_launch: occupancy query says %d\n", per_cu); }
        (void)hipGetLastError();
        grid = cus;
    }
    if (grid < 0) return;
    (void)hipMemsetAsync((char*)d_ws + WS_CTL, 0, CTL_BYTES, stream);
    Args a{};
    for (int i = 0; i < 26; ++i) a.in[i] = (const float*)d_in[i];
    a.out = (float*)d_out; a.ws = (unsigned char*)d_ws;
#if N_LAUNCH_MODE == 1
    a.ph_lo = 0; a.ph_hi = N_PHASES;
    hipLaunchKernelGGL(fwd, dim3(grid), dim3(NT), LDS_BYTES, stream, a);
#else
    for (int p = 0; p < N_PHASES; ++p) {
        if (p == 4 || p == 5) continue;
        a.ph_lo = p; a.ph_hi = p + 1;
        hipLaunchKernelGGL(fwd, dim3(grid), dim3(NT), LDS_BYTES, stream, a);
    }
#endif
}
```

```cpp
#include <hip/hip_runtime.h>
#include <stdint.h>
#include <stdio.h>

#ifndef N_LAUNCH_MODE
#define N_LAUNCH_MODE 1
#endif

#define FAST_INPROJ 1
#define FAST_GLU 1
#define FAST_OUT 1
#define FAST_MOE1 1
#define FAST_MOE2 1
#define FAST_SSM 1
#define FAST_ATTN 1
#define LAS __attribute__((address_space(3)))
typedef unsigned short bf16_t;
typedef float f32x4 __attribute__((ext_vector_type(4)));
typedef float f32x2 __attribute__((ext_vector_type(2)));
typedef short bf16x8 __attribute__((ext_vector_type(8)));
typedef short s16x4 __attribute__((ext_vector_type(4)));
typedef unsigned u32x2 __attribute__((ext_vector_type(2)));
typedef unsigned u32x4 __attribute__((ext_vector_type(4)));

constexpr int NT = 512;
constexpr int TOK = 8192, DM = 2048, NB = 4, SEQ = 2048;
constexpr int DSSM = 1024, DATT = 1024, NH = 16, HD = 64, DINP = 4096;
constexpr int NE = 16, CAP = 256, DFF = 2816;
constexpr int NG = 64, NP = 64, GH = 16;
constexpr float EPS = 1e-6f;

constexpr size_t al256(size_t x) { return (x + 255) & ~(size_t)255; }
constexpr size_t WS_CTL   = 0;
constexpr size_t CTL_BYTES = 32768;
constexpr size_t WS_MOD   = WS_CTL + CTL_BYTES;
constexpr size_t WS_H1    = al256(WS_MOD + (size_t)NB * 12288 * 4);
constexpr size_t WS_UX    = al256(WS_H1 + (size_t)TOK * DM * 2);
constexpr size_t WS_Q     = al256(WS_UX + (size_t)64 * 512 * 512 * 2);
constexpr size_t WS_K     = al256(WS_Q + (size_t)TOK * 1024 * 2);
constexpr size_t WS_V     = al256(WS_K + (size_t)TOK * 1024 * 2);
constexpr size_t WS_SS    = al256(WS_V + (size_t)TOK * 1024 * 2);
constexpr size_t WS_ZB    = al256(WS_SS + (size_t)64 * 512 * 256 * 4);
constexpr size_t WS_YSSM  = al256(WS_ZB + (size_t)TOK * 1024 * 2);
constexpr size_t WS_YATT  = al256(WS_YSSM + (size_t)TOK * 1024 * 2);
constexpr size_t WS_MIX   = al256(WS_YATT + (size_t)TOK * 1024 * 2);
constexpr size_t WS_X1    = al256(WS_MIX + (size_t)TOK * DM * 2);
constexpr size_t WS_H2    = al256(WS_X1 + (size_t)TOK * DM * 4);
constexpr size_t WS_AFF   = al256(WS_H2 + (size_t)TOK * DM * 2);
constexpr size_t WS_IDX   = al256(WS_AFF + (size_t)NB * NE * SEQ * 4);
constexpr size_t WS_WAFF  = al256(WS_IDX + (size_t)NB * NE * CAP * 4);
constexpr size_t WS_SLOT  = al256(WS_WAFF + (size_t)NB * NE * CAP * 4);
constexpr size_t WS_HID   = al256(WS_SLOT + (size_t)NB * NE * SEQ * 4);
constexpr size_t WS_YE    = al256(WS_HID + (size_t)NE * 1024 * DFF * 2);
constexpr size_t WS_BMAT  = al256(WS_YE + (size_t)NE * 1024 * DM * 2);
constexpr size_t WS_KCMAT = al256(WS_BMAT + (size_t)64 * 256 * 256 * 2);
constexpr size_t WS_LAM   = al256(WS_KCMAT + (size_t)64 * 512 * 256 * 2);
constexpr size_t WS_END   = al256(WS_LAM + (size_t)2 * 64 * 64 * 2 * 4);

constexpr int LDS_BYTES = 147456;

__device__ __forceinline__ bf16_t f2bf(float f) { unsigned u = __float_as_uint(f); u += 0x7FFFu + ((u >> 16) & 1u); return (bf16_t)(u >> 16); }
__device__ __forceinline__ float bf2f(bf16_t b) { return __uint_as_float(((unsigned)b) << 16); }
__device__ __forceinline__ float bflo(unsigned w) { return __uint_as_float(w << 16); }
__device__ __forceinline__ float bfhi(unsigned w) { return __uint_as_float(w & 0xffff0000u); }
__device__ __forceinline__ unsigned pack2(float lo, float hi) { return (unsigned)f2bf(lo) | ((unsigned)f2bf(hi) << 16); }
__device__ __forceinline__ float wave_sum(float v) {
#pragma unroll
    for (int m = 32; m >= 1; m >>= 1) v += __shfl_xor(v, m);
    return v;
}
__device__ __forceinline__ float silu_f(float v) { return v / (1.0f + __expf(-v)); }
__device__ __forceinline__ float sigmoid_f(float v) { return 1.0f / (1.0f + __expf(-v)); }
__device__ __forceinline__ float gelu_tanh(float y) { const float t = 0.7978845608028654f * (y + 0.044715f * y * y * y); return 0.5f * y * (1.0f + tanhf(t)); }

#define XB_TMO      128
#define XB_XCNT(j)  (256  + 64 * (j))
#define XB_XSUB(j)  (1280 + 64 * (j))
#define XB_XGEN(j)  (2304 + 64 * (j))
#define XB_TOP      3328
#define XB_TOPGEN   3392
#define XCD_BAR_WORDS 3456
#define XB_SPIN_CAP (1u << 18)
__device__ __forceinline__ unsigned xb_ld(unsigned* p)              { return __hip_atomic_load(p, __ATOMIC_RELAXED, __HIP_MEMORY_SCOPE_AGENT); }
__device__ __forceinline__ unsigned xb_add(unsigned* p, unsigned v) { return __hip_atomic_fetch_add(p, v, __ATOMIC_RELAXED, __HIP_MEMORY_SCOPE_AGENT); }
__device__ __forceinline__ unsigned xb_xcc_id() { return (unsigned)__builtin_amdgcn_s_getreg((3 << 11) | 20) & 0xFu; }
#define XB_SPIN(cond, bar) do { unsigned _sp = 0; while (cond) { __builtin_amdgcn_s_sleep(1); \
    if ((++_sp & 255u) == 0u) { if (xb_ld(&(bar)[XB_TMO])) break; if (_sp > XB_SPIN_CAP) { atomicAdd(&(bar)[XB_TMO], 1u); break; } } } } while (0)
struct XcdBarrier { unsigned* bar; unsigned x; volatile LAS unsigned* st; };
__device__ __forceinline__ XcdBarrier xcd_barrier_post(unsigned* bar, volatile LAS unsigned* st) {
    XcdBarrier b; b.bar = bar; b.x = xb_xcc_id(); b.st = st;
    if (threadIdx.x == 0) (void)xb_add(&bar[XB_XCNT(b.x)], 1u);
    return b;
}
__device__ __forceinline__ void xcd_barrier_complete(unsigned* bar, unsigned x, unsigned& nloc, unsigned& nx) {
    const unsigned G = gridDim.x * gridDim.y * gridDim.z;
    unsigned sum, cnt, mine, sp = 0u;
    for (;;) {
        sum = 0u; cnt = 0u; mine = 0u;
#pragma unroll
        for (unsigned j = 0; j < 16; ++j) { const unsigned c = xb_ld(&bar[XB_XCNT(j)]); sum += c; cnt += (c > 0u) ? 1u : 0u; mine = (j == x) ? c : mine; }
        if (sum == G) break;
        __builtin_amdgcn_s_sleep(1);
        if ((++sp & 255u) == 0u) { if (xb_ld(&bar[XB_TMO])) break; if (sp > XB_SPIN_CAP) { atomicAdd(&bar[XB_TMO], 1u); break; } }
    }
    nloc = mine > 0u ? mine : 1u; nx = cnt > 0u ? cnt : 1u;
}
__device__ __forceinline__ void xcd_barrier(const XcdBarrier& b) {
    asm volatile("s_waitcnt vmcnt(0)" ::: "memory");
    __syncthreads();
    if (threadIdx.x == 0) {
        unsigned* bar = b.bar;
        __builtin_amdgcn_s_waitcnt(0);
        unsigned nloc = b.st[0], nx = b.st[1];
        if (nloc == 0u) { xcd_barrier_complete(bar, b.x, nloc, nx); b.st[0] = nloc; b.st[1] = nx; }
        const unsigned old = xb_add(&bar[XB_XSUB(b.x)], 1u);
        const unsigned gen = old / nloc;
        if (old + 1u == (gen + 1u) * nloc) {
            __builtin_amdgcn_fence(__ATOMIC_RELEASE, "agent");
            asm volatile("s_waitcnt vmcnt(0)" ::: "memory");
            const unsigned og = xb_add(&bar[XB_TOP], 1u);
            const unsigned tg = og / nx;
            if (og + 1u == (tg + 1u) * nx) xb_add(&bar[XB_TOPGEN], 1u);
            else XB_SPIN(xb_ld(&bar[XB_TOPGEN]) == tg, bar);
            __builtin_amdgcn_fence(__ATOMIC_ACQUIRE, "agent");
            xb_add(&bar[XB_XGEN(b.x)], 1u);
            asm volatile("s_waitcnt vmcnt(0)" ::: "memory");
        } else {
            XB_SPIN(xb_ld(&bar[XB_XGEN(b.x)]) == gen, bar);
            __builtin_amdgcn_fence(__ATOMIC_ACQUIRE, "agent");
            asm volatile("s_waitcnt vmcnt(0)" ::: "memory");
        }
    }
    __syncthreads();
}

struct Args { const float* in[26]; float* out; unsigned char* ws; int ph_lo, ph_hi; };
enum { I_X = 0, I_C, I_WADA, I_BADA, I_GMIX, I_WIN, I_ARE, I_AIM, I_LOGDT, I_BRE, I_BIM, I_CRE, I_CIM, I_SSMD, I_WGLU, I_BGLU, I_RPB,
       I_GSSM, I_GATT, I_WOUT, I_GFFN, I_WROUTER, I_WGATE, I_WUP, I_WDOWN, I_GFINAL };

struct ARows { const bf16_t* base; size_t ld; __device__ __forceinline__ const bf16_t* ptr(int r) const { return base + (size_t)r * ld; }
    __device__ __forceinline__ unsigned off(int r) const { return (unsigned)r * (unsigned)ld; } };
struct AGather { const bf16_t* base; const int* idx; int e;
    __device__ __forceinline__ const bf16_t* ptr(int r) const { const int b = r >> 8; return base + (size_t)(b * SEQ + idx[(b * NE + e) * CAP + (r & 255)]) * DM; }
    __device__ __forceinline__ unsigned off(int r) const { const int b = r >> 8; return (unsigned)(b * SEQ + idx[(b * NE + e) * CAP + (r & 255)]) * (unsigned)DM; } };
struct BF32 { const float* base; size_t ld; __device__ __forceinline__ float get(int k, int n) const { return base[(size_t)k * ld + n]; }
    __device__ __forceinline__ float get2(int, int) const { return 0.f; } };
struct BF32Dual { const float* g; const float* u; size_t ld; __device__ __forceinline__ float get(int k, int n) const { return g[(size_t)k * ld + n]; }
    __device__ __forceinline__ float get2(int k, int n) const { return u[(size_t)k * ld + n]; } };

struct EpiInProj { bf16_t* UX; bf16_t* Q; bf16_t* K; bf16_t* V;
    __device__ __forceinline__ void store(int t, int n, float v) const {
        if (n < 1024) { const int g = n >> 4, h = n & 15, b = t >> 11, l = t & 2047; UX[(size_t)(g * 512 + b * 128 + (l >> 4)) * 512 + (l & 15) * 16 + h] = f2bf(v); }
        else if (n < 2048) Q[(size_t)t * 1024 + (n - 1024)] = f2bf(v * 0.125f);
        else if (n < 3072) K[(size_t)t * 1024 + (n - 2048)] = f2bf(v);
        else V[(size_t)t * 1024 + (n - 3072)] = f2bf(v);
    }
    __device__ __forceinline__ void store2(int, int, float, float) const {}
    __device__ __forceinline__ void store4(int t, int n, f32x4 v) const {
        u32x2 w;
        if (n < 1024) { const int g = n >> 4, h = n & 15, b = t >> 11, l = t & 2047; w.x = pack2(v[0], v[1]); w.y = pack2(v[2], v[3]);
            *(u32x2*)(UX + (size_t)(g * 512 + b * 128 + (l >> 4)) * 512 + (l & 15) * 16 + h) = w; }
        else if (n < 2048) { w.x = pack2(v[0] * 0.125f, v[1] * 0.125f); w.y = pack2(v[2] * 0.125f, v[3] * 0.125f); *(u32x2*)(Q + (size_t)t * 1024 + (n - 1024)) = w; }
        else if (n < 3072) { w.x = pack2(v[0], v[1]); w.y = pack2(v[2], v[3]); *(u32x2*)(K + (size_t)t * 1024 + (n - 2048)) = w; }
        else { w.x = pack2(v[0], v[1]); w.y = pack2(v[2], v[3]); *(u32x2*)(V + (size_t)t * 1024 + (n - 3072)) = w; }
    } };
struct EpiGlu { const bf16_t* Z; const float* bglu; bf16_t* Y;
    __device__ __forceinline__ void store(int t, int n, float v) const { const float gate = v + bglu[n]; const float z = bf2f(Z[(size_t)t * 1024 + n]); Y[(size_t)t * 1024 + n] = f2bf(z * sigmoid_f(gate)); }
    __device__ __forceinline__ void store2(int, int, float, float) const {}
    __device__ __forceinline__ void store4(int t, int n, f32x4 v) const {
        const f32x4 bb = *(const f32x4*)(bglu + n); const u32x2 zw = *(const u32x2*)(Z + (size_t)t * 1024 + n);
        u32x2 w; w.x = pack2(bflo(zw.x) * sigmoid_f(v[0] + bb[0]), bfhi(zw.x) * sigmoid_f(v[1] + bb[1])); w.y = pack2(bflo(zw.y) * sigmoid_f(v[2] + bb[2]), bfhi(zw.y) * sigmoid_f(v[3] + bb[3]));
        *(u32x2*)(Y + (size_t)t * 1024 + n) = w; } };
struct EpiOut { const float* x; const float* mod; float* X1;
    __device__ __forceinline__ void store(int t, int n, float v) const { const int b = t >> 11; X1[(size_t)t * DM + n] = x[(size_t)t * DM + n] + mod[b * 12288 + 4096 + n] * v; }
    __device__ __forceinline__ void store2(int, int, float, float) const {}
    __device__ __forceinline__ void store4(int t, int n, f32x4 v) const { const int b = t >> 11;
        const f32x4 xv = *(const f32x4*)(x + (size_t)t * DM + n), gt = *(const f32x4*)(mod + b * 12288 + 4096 + n);
        *(f32x4*)(X1 + (size_t)t * DM + n) = xv + gt * v; } };
struct EpiMoe1 { bf16_t* HID;
    __device__ __forceinline__ void store(int, int, float) const {}
    __device__ __forceinline__ void store2(int r, int n, float g, float u) const { HID[(size_t)r * DFF + n] = f2bf(silu_f(g) * u); }
    __device__ __forceinline__ void store4d(int r, int n, f32x4 g, f32x4 u) const { u32x2 w; w.x = pack2(silu_f(g[0]) * u[0], silu_f(g[1]) * u[1]); w.y = pack2(silu_f(g[2]) * u[2], silu_f(g[3]) * u[3]);
        *(u32x2*)(HID + (size_t)r * DFF + n) = w; } };
struct EpiMoe2 { bf16_t* YE; const float* waff; int e;
    __device__ __forceinline__ void store(int r, int n, float v) const { const int b = r >> 8; YE[(size_t)r * DM + n] = f2bf(v * waff[(b * NE + e) * CAP + (r & 255)]); }
    __device__ __forceinline__ void store2(int, int, float, float) const {}
    __device__ __forceinline__ void store4(int r, int n, f32x4 v) const { const int b = r >> 8; const float a = waff[(b * NE + e) * CAP + (r & 255)];
        u32x2 w; w.x = pack2(v[0] * a, v[1] * a); w.y = pack2(v[2] * a, v[3] * a); *(u32x2*)(YE + (size_t)r * DM + n) = w; } };

template <class AF, class BF, class EF, bool DUAL>
__device__ __forceinline__ void gemm_naive_tile(float* lds, const AF& A, const BF& Bm, const EF& E, int m0, int n0, int K) {
    float* As = lds;
    float* Bs = lds + 16 * 132;
    float* Bs2 = Bs + 16 * 68;
    float acc[4][4], acc2[4][4];
#pragma unroll
    for (int i = 0; i < 4; ++i)
#pragma unroll
        for (int j = 0; j < 4; ++j) { acc[i][j] = 0.f; acc2[i][j] = 0.f; }
    const int tid = threadIdx.x, tm = tid >> 4, tn = tid & 15;
    const int ar = tid >> 2, ak = (tid & 3) * 4;
    const bf16_t* ap = A.ptr(m0 + ar);
    const int bk = tid >> 5, bc = (tid & 31) * 2;
    for (int k0 = 0; k0 < K; k0 += 16) {
        const u32x2 av = *(const u32x2*)(ap + k0 + ak);
        As[(ak + 0) * 132 + ar] = bflo(av.x); As[(ak + 1) * 132 + ar] = bfhi(av.x); As[(ak + 2) * 132 + ar] = bflo(av.y); As[(ak + 3) * 132 + ar] = bfhi(av.y);
        Bs[bk * 68 + bc] = Bm.get(k0 + bk, n0 + bc); Bs[bk * 68 + bc + 1] = Bm.get(k0 + bk, n0 + bc + 1);
        if (DUAL) { Bs2[bk * 68 + bc] = Bm.get2(k0 + bk, n0 + bc); Bs2[bk * 68 + bc + 1] = Bm.get2(k0 + bk, n0 + bc + 1); }
        __syncthreads();
#pragma unroll
        for (int kk = 0; kk < 16; ++kk) {
            const f32x4 a4 = *(const f32x4*)(As + kk * 132 + tm * 4);
            const f32x4 b4 = *(const f32x4*)(Bs + kk * 68 + tn * 4);
#pragma unroll
            for (int i = 0; i < 4; ++i)
#pragma unroll
                for (int j = 0; j < 4; ++j) acc[i][j] += a4[i] * b4[j];
            if (DUAL) {
                const f32x4 c4 = *(const f32x4*)(Bs2 + kk * 68 + tn * 4);
#pragma unroll
                for (int i = 0; i < 4; ++i)
#pragma unroll
                    for (int j = 0; j < 4; ++j) acc2[i][j] += a4[i] * c4[j];
            }
        }
        __syncthreads();
    }
#pragma unroll
    for (int i = 0; i < 4; ++i)
#pragma unroll
        for (int j = 0; j < 4; ++j) { if (DUAL) E.store2(m0 + tm * 4 + i, n0 + tn * 4 + j, acc[i][j], acc2[i][j]); else E.store(m0 + tm * 4 + i, n0 + tn * 4 + j, acc[i][j]); }
}

struct Frame {
    const float* in[26]; float* out; unsigned char* ws; unsigned char* lds;
    int tid, lane, wave, G, bid;
    __device__ __forceinline__ float* modp() const { return (float*)(ws + WS_MOD); }
};

__device__ __forceinline__ void p_ada(const Frame& F) {
    float* sc = (float*)F.lds;
    float* red = sc + 4 * 2048;
    const float* c = F.in[I_C]; const float* w = F.in[I_WADA]; const float* bias = F.in[I_BADA];
    for (int i = F.tid; i < 4 * 2048; i += NT) sc[i] = silu_f(c[i]);
    __syncthreads();
    const int cq = F.tid & 15, kq = F.tid >> 4;
    for (int u = F.bid; u < 192; u += F.G) {
        const int n0 = u * 64 + cq * 4;
        float acc[4][4];
#pragma unroll
        for (int b = 0; b < 4; ++b)
#pragma unroll
            for (int j = 0; j < 4; ++j) acc[b][j] = 0.f;
#pragma unroll 8
        for (int k = kq; k < 2048; k += 32) {
            const f32x4 wv = *(const f32x4*)(w + (size_t)k * 12288 + n0);
#pragma unroll
            for (int b = 0; b < 4; ++b) { const float s = sc[b * 2048 + k];
#pragma unroll
                for (int j = 0; j < 4; ++j) acc[b][j] += s * wv[j]; }
        }
#pragma unroll
        for (int b = 0; b < 4; ++b)
#pragma unroll
            for (int j = 0; j < 4; ++j) red[(kq * 16 + cq) * 16 + b * 4 + j] = acc[b][j];
        __syncthreads();
        if (F.tid < 256) {
            const int b = F.tid >> 6, col = F.tid & 63;
            float s = 0.f;
            for (int q = 0; q < 32; ++q) s += red[(q * 16 + (col >> 2)) * 16 + b * 4 + (col & 3)];
            F.modp()[b * 12288 + u * 64 + col] = s + bias[u * 64 + col];
        }
        __syncthreads();
    }
}

__device__ __forceinline__ void p_h1(const Frame& F) {
    const float* x = F.in[I_X]; const float* g = F.in[I_GMIX]; const float* mod = F.modp(); bf16_t* H1 = (bf16_t*)(F.ws + WS_H1);
    for (int t = F.bid * 8 + F.wave; t < TOK; t += F.G * 8) {
        const int b = t >> 11; const float* xr = x + (size_t)t * DM;
        f32x4 v[8]; float ss = 0.f;
#pragma unroll
        for (int i = 0; i < 8; ++i) { v[i] = *(const f32x4*)(xr + i * 256 + F.lane * 4); ss += v[i][0] * v[i][0] + v[i][1] * v[i][1] + v[i][2] * v[i][2] + v[i][3] * v[i][3]; }
        ss = wave_sum(ss);
        const float rstd = rsqrtf(ss * (1.0f / DM) + EPS);
#pragma unroll
        for (int i = 0; i < 8; ++i) { const int k = i * 256 + F.lane * 4;
            const f32x4 gv = *(const f32x4*)(g + k), sh = *(const f32x4*)(mod + b * 12288 + k), sc = *(const f32x4*)(mod + b * 12288 + 2048 + k);
            float o[4];
#pragma unroll
            for (int j = 0; j < 4; ++j) o[j] = (v[i][j] * rstd * gv[j]) * (1.0f + sc[j]) + sh[j];
            u32x2 w; w.x = pack2(o[0], o[1]); w.y = pack2(o[2], o[3]);
            *(u32x2*)(H1 + (size_t)t * DM + k) = w; }
    }
}

__device__ __forceinline__ void p_inproj_naive(const Frame& F) {
    const ARows A{(const bf16_t*)(F.ws + WS_H1), DM}; const BF32 Bm{F.in[I_WIN], DINP};
    const EpiInProj E{(bf16_t*)(F.ws + WS_UX), (bf16_t*)(F.ws + WS_Q), (bf16_t*)(F.ws + WS_K), (bf16_t*)(F.ws + WS_V)};
    const int nM = TOK / 128, nN = DINP / 64;
    for (int u = F.bid; u < nM * nN; u += F.G) gemm_naive_tile<ARows, BF32, EpiInProj, false>((float*)F.lds, A, Bm, E, (u / nN) * 128, (u % nN) * 64, DM);
}
__device__ __forceinline__ void p_glu_naive(const Frame& F) {
    const ARows A{(const bf16_t*)(F.ws + WS_ZB), 1024}; const BF32 Bm{F.in[I_WGLU], 1024};
    const EpiGlu E{(const bf16_t*)(F.ws + WS_ZB), F.in[I_BGLU], (bf16_t*)(F.ws + WS_YSSM)};
    const int nM = TOK / 128, nN = 1024 / 64;
    for (int u = F.bid; u < nM * nN; u += F.G) gemm_naive_tile<ARows, BF32, EpiGlu, false>((float*)F.lds, A, Bm, E, (u / nN) * 128, (u % nN) * 64, 1024);
}
__device__ __forceinline__ void p_outproj_naive(const Frame& F) {
    const ARows A{(const bf16_t*)(F.ws + WS_MIX), DM}; const BF32 Bm{F.in[I_WOUT], DM};
    const EpiOut E{F.in[I_X], F.modp(), (float*)(F.ws + WS_X1)};
    const int nM = TOK / 128, nN = DM / 64;
    for (int u = F.bid; u < nM * nN; u += F.G) gemm_naive_tile<ARows, BF32, EpiOut, false>((float*)F.lds, A, Bm, E, (u / nN) * 128, (u % nN) * 64, DM);
}
__device__ __forceinline__ void p_moe1_naive(const Frame& F) {
    const int nM = 1024 / 128, nN = DFF / 64;
    for (int u = F.bid; u < NE * nM * nN; u += F.G) {
        const int e = u / (nM * nN), r = u % (nM * nN);
        const AGather A{(const bf16_t*)(F.ws + WS_H2), (const int*)(F.ws + WS_IDX), e};
        const BF32Dual Bm{F.in[I_WGATE] + (size_t)e * DM * DFF, F.in[I_WUP] + (size_t)e * DM * DFF, DFF};
        const EpiMoe1 E{(bf16_t*)(F.ws + WS_HID) + (size_t)e * 1024 * DFF};
        gemm_naive_tile<AGather, BF32Dual, EpiMoe1, true>((float*)F.lds, A, Bm, E, (r / nN) * 128, (r % nN) * 64, DM);
    }
}
__device__ __forceinline__ void p_moe2_naive(const Frame& F) {
    const int nM = 1024 / 128, nN = DM / 64;
    for (int u = F.bid; u < NE * nM * nN; u += F.G) {
        const int e = u / (nM * nN), r = u % (nM * nN);
        const ARows A{(const bf16_t*)(F.ws + WS_HID) + (size_t)e * 1024 * DFF, DFF};
        const BF32 Bm{F.in[I_WDOWN] + (size_t)e * DFF * DM, DM};
        const EpiMoe2 E{(bf16_t*)(F.ws + WS_YE) + (size_t)e * 1024 * DM, (const float*)(F.ws + WS_WAFF), e};
        gemm_naive_tile<ARows, BF32, EpiMoe2, false>((float*)F.lds, A, Bm, E, (r / nN) * 128, (r % nN) * 64, DFF);
    }
}

__host__ __device__ __forceinline__ int lds_byte(int r, int c) { const int st = (r >> 4) * 2 + (c >> 5), rr = r & 15, cc = c & 31, ob = rr * 64 + cc * 2; return st * 1024 + (ob ^ (((ob >> 9) & 1) << 5)); }
__host__ __device__ __forceinline__ void stage_rc(int b, int& R, int& C) { const int st = b / 1024, sb = b % 1024, swz = sb ^ (((sb >> 9) & 1) << 5); R = (st >> 1) * 16 + swz / 64; C = (st & 1) * 32 + (swz % 64) / 2; }

struct BLF32 {
    const float* base; unsigned ld; static constexpr int NL = 8;
    unsigned loff, bw0, bw1; int wid;
    __device__ __forceinline__ void init(int lane, int wid_) { wid = wid_; loff = (unsigned)lane * 16u; bw0 = (unsigned)(wid * 512 + ((8 * lane) ^ ((wid & 3) * 32))); bw1 = bw0 ^ 128u; }
    __device__ __forceinline__ void load(int kt, f32x4 (&r)[8]) const {
#pragma unroll
        for (int i = 0; i < 8; ++i) { const char* rowb = (const char*)(base + (size_t)(kt * 64 + wid + 8 * i) * ld); r[i] = *(const f32x4*)(rowb + loff); } }
    __device__ __forceinline__ void write(LAS unsigned char* st, const f32x4 (&r)[8]) const {
#pragma unroll
        for (int i = 0; i < 8; ++i) { u32x2 w; w.x = pack2(r[i][0], r[i][1]); w.y = pack2(r[i][2], r[i][3]); *(LAS u32x2*)(st + ((i & 1) ? bw1 : bw0) + i * 4096) = w; } }
};
struct BLF32Dual {
    const float* g; const float* u; unsigned ld; static constexpr int NL = 8;
    unsigned loff, bw0, bw1; int wid;
    __device__ __forceinline__ void init(int lane, int wid_) { wid = wid_; loff = (unsigned)(lane >> 5) * ld * 4u + (unsigned)(lane & 31) * 16u;
        const int k = 2 * wid + (lane >> 5), slot = (k & 3) | ((k >> 1) & 4), x = 4 * (lane & 31), c = (x >> 5) * 64 + ((x >> 4) & 1) * 16 + (x & 15);
        bw0 = (unsigned)(k * 512 + ((2 * c) ^ (slot * 32))); bw1 = bw0 ^ 64u; }
    __device__ __forceinline__ void load(int kt, f32x4 (&r)[8]) const {
#pragma unroll
        for (int i = 0; i < 8; ++i) { const char* rowb = (const char*)(((i >> 2) ? u : g) + (size_t)(kt * 64 + 2 * wid + 16 * (i & 3)) * ld); r[i] = *(const f32x4*)(rowb + loff); } }
    __device__ __forceinline__ void write(LAS unsigned char* st, const f32x4 (&r)[8]) const {
#pragma unroll
        for (int i = 0; i < 8; ++i) { u32x2 w; w.x = pack2(r[i][0], r[i][1]); w.y = pack2(r[i][2], r[i][3]); *(LAS u32x2*)(st + ((i >> 2) ? bw1 : bw0) + (i & 3) * 8192) = w; } }
};
struct BLBf16 {
    const bf16_t* base; unsigned ld; static constexpr int NL = 4;
    unsigned loff, bw0; int wid;
    __device__ __forceinline__ void init(int lane, int wid_) { wid = wid_; loff = (unsigned)(lane >> 5) * ld * 2u + (unsigned)(lane & 31) * 16u;
        const int k = 2 * wid + (lane >> 5), slot = (k & 3) | ((k >> 1) & 4); bw0 = (unsigned)(k * 512 + ((16 * (lane & 31)) ^ (slot * 32))); }
    __device__ __forceinline__ void load(int kt, f32x4 (&r)[8]) const {
#pragma unroll
        for (int i = 0; i < 4; ++i) { const char* rowb = (const char*)(base + (size_t)(kt * 64 + 2 * wid + 16 * i) * ld); r[i] = *(const f32x4*)(rowb + loff); } }
    __device__ __forceinline__ void write(LAS unsigned char* st, const f32x4 (&r)[8]) const {
#pragma unroll
        for (int i = 0; i < 4; ++i) *(LAS f32x4*)(st + bw0 + i * 8192) = r[i]; }
};

template <class AF, class BL, class EF, bool DUAL>
__device__ __forceinline__ void gemm_mfma_tile(unsigned char* ldsg, const AF& A, BL Bl, const EF& E, int m0, int n0, int K) {
    LAS unsigned char* lds = (LAS unsigned char*)ldsg;
    const int tid = threadIdx.x, lane = tid & 63, wid = __builtin_amdgcn_readfirstlane(tid >> 6), wr = wid >> 2, wc = wid & 3, fr = lane & 15, fq = lane >> 4;
    const int nt = K / 64;
    const bf16_t* abase = A.base;
    unsigned aso[2][2];
#pragma unroll
    for (int h = 0; h < 2; ++h)
#pragma unroll
        for (int i = 0; i < 2; ++i) { int R, C; stage_rc(tid * 16 + i * 8192, R, C); aso[h][i] = A.off(m0 + h * 128 + R) + (unsigned)C; }
    Bl.init(lane, wid);
    const unsigned aoff = (unsigned)(wr * 16384 + lds_byte(fr, fq * 8));
    unsigned boffn[4];
    { const int G = fq, q = fr >> 2, p = fr & 3, slot = q | ((G & 1) << 2);
#pragma unroll
      for (int ni = 0; ni < 4; ++ni) boffn[ni] = (unsigned)((8 * G + q) * 512 + (((wc * 128 + ni * 32) ^ (slot * 32)) + 8 * p)); }
    f32x4 acc[8][4];
#pragma unroll
    for (int mi = 0; mi < 8; ++mi)
#pragma unroll
        for (int ni = 0; ni < 4; ++ni) acc[mi][ni] = (f32x4){0.f, 0.f, 0.f, 0.f};

#define GM_STAGE_A(s, kt) do { _Pragma("unroll") for (int h_ = 0; h_ < 2; ++h_) _Pragma("unroll") for (int i_ = 0; i_ < 2; ++i_) \
        __builtin_amdgcn_global_load_lds((const unsigned*)(abase + (size_t)(aso[h_][i_] + (unsigned)(kt) * 64u)), (LAS unsigned*)(lds + (s) * 32768 + h_ * 16384 + i_ * 8192 + wid * 1024), 16, 0, 0); } while (0)
    f32x4 breg[8];

    GM_STAGE_A(0, 0); Bl.load(0, breg); Bl.write(lds + 65536, breg);
    asm volatile("s_waitcnt vmcnt(0)" ::: "memory");
    __syncthreads();
    for (int t = 0; t < nt; ++t) {
        const int cur = t & 1;
        if (t + 1 < nt) { GM_STAGE_A(cur ^ 1, t + 1); Bl.load(t + 1, breg); }
#pragma unroll
        for (int ks = 0; ks < 2; ++ks) {
            bf16x8 bf[4];
#pragma unroll
            for (int ni = 0; ni < 4; ++ni) {
                const s16x4 lo = __builtin_amdgcn_ds_read_tr16_b64_v4i16((LAS s16x4*)(lds + 65536 + cur * 32768 + boffn[ni] + (ks * 32) * 512));
                const s16x4 hi = __builtin_amdgcn_ds_read_tr16_b64_v4i16((LAS s16x4*)(lds + 65536 + cur * 32768 + boffn[ni] + (ks * 32 + 4) * 512));
                bf[ni] = (bf16x8){lo[0], lo[1], lo[2], lo[3], hi[0], hi[1], hi[2], hi[3]};
            }
#pragma unroll
            for (int mh = 0; mh < 2; ++mh) {
                bf16x8 af[4];
#pragma unroll
                for (int mi = 0; mi < 4; ++mi) af[mi] = *(const LAS bf16x8*)(lds + cur * 32768 + aoff + (mh * 4 + mi) * 2048 + ks * 1024);
#pragma unroll
                for (int mi = 0; mi < 4; ++mi)
#pragma unroll
                    for (int ni = 0; ni < 4; ++ni) acc[mh * 4 + mi][ni] = __builtin_amdgcn_mfma_f32_16x16x32_bf16(bf[ni], af[mi], acc[mh * 4 + mi][ni], 0, 0, 0);
            }
            __builtin_amdgcn_sched_barrier(0);
        }
        if (t + 1 < nt) { Bl.write(lds + 65536 + (cur ^ 1) * 32768, breg); }
        asm volatile("s_waitcnt vmcnt(0)" ::: "memory");
        __syncthreads();
    }
#undef GM_STAGE_A
    int fr2 = fr, fq2 = fq; asm volatile("" : "+v"(fr2), "+v"(fq2));
#pragma unroll
    for (int mi = 0; mi < 8; ++mi) {
        const int row = m0 + wr * 128 + mi * 16 + fr2;
        if constexpr (DUAL) {
#pragma unroll
            for (int ni = 0; ni < 2; ++ni) E.store4d(row, n0 + wc * 32 + ni * 16 + 4 * fq2, acc[mi][ni], acc[mi][ni + 2]);
        } else {
#pragma unroll
            for (int ni = 0; ni < 4; ++ni) E.store4(row, n0 + wc * 64 + ni * 16 + 4 * fq2, acc[mi][ni]);
        }
    }
}
__device__ __forceinline__ int unit_of(const Frame& F, int round) { return (F.G % 8 == 0) ? round * F.G + (F.bid & 7) * (F.G >> 3) + (F.bid >> 3) : round * F.G + F.bid; }
__device__ __forceinline__ void tile_of(int v, int nN, int& pm, int& pn) { const int gid = v >> 5, loc = v & 31, gn = nN >> 2; pm = (gid / gn) * 8 + (loc & 7); pn = (gid % gn) * 4 + (loc >> 3); }

__device__ __forceinline__ void p_inproj_fast(const Frame& F) {
    const ARows A{(const bf16_t*)(F.ws + WS_H1), DM};
    const EpiInProj E{(bf16_t*)(F.ws + WS_UX), (bf16_t*)(F.ws + WS_Q), (bf16_t*)(F.ws + WS_K), (bf16_t*)(F.ws + WS_V)};
    for (int r = 0;; ++r) { const int v = unit_of(F, r); if (v >= 32 * 16) break; int pm, pn; tile_of(v, 16, pm, pn);
        BLF32 Bl; Bl.base = F.in[I_WIN] + pn * 256; Bl.ld = DINP;
        gemm_mfma_tile<ARows, BLF32, EpiInProj, false>(F.lds, A, Bl, E, pm * 256, pn * 256, DM); }
}
__device__ __forceinline__ void p_glu_fast(const Frame& F) {
    const ARows A{(const bf16_t*)(F.ws + WS_ZB), 1024};
    const EpiGlu E{(const bf16_t*)(F.ws + WS_ZB), F.in[I_BGLU], (bf16_t*)(F.ws + WS_YSSM)};
    for (int r = 0;; ++r) { const int v = unit_of(F, r); if (v >= 32 * 4) break; int pm, pn; tile_of(v, 4, pm, pn);
        BLF32 Bl; Bl.base = F.in[I_WGLU] + pn * 256; Bl.ld = 1024;
        gemm_mfma_tile<ARows, BLF32, EpiGlu, false>(F.lds, A, Bl, E, pm * 256, pn * 256, 1024); }
}
__device__ __forceinline__ void p_outproj_fast(const Frame& F) {
    const ARows A{(const bf16_t*)(F.ws + WS_MIX), DM};
    const EpiOut E{F.in[I_X], F.modp(), (float*)(F.ws + WS_X1)};
    for (int r = 0;; ++r) { const int v = unit_of(F, r); if (v >= 32 * 8) break; int pm, pn; tile_of(v, 8, pm, pn);
        BLF32 Bl; Bl.base = F.in[I_WOUT] + pn * 256; Bl.ld = DM;
        gemm_mfma_tile<ARows, BLF32, EpiOut, false>(F.lds, A, Bl, E, pm * 256, pn * 256, DM); }
}
__device__ __forceinline__ void p_moe1_fast(const Frame& F) {
    for (int r = 0;; ++r) { const int v = unit_of(F, r); if (v >= NE * 22 * 4) break; const int pm = v & 3, pn = (v >> 2) % 22, e = (v >> 2) / 22;
        const AGather A{(const bf16_t*)(F.ws + WS_H2), (const int*)(F.ws + WS_IDX), e};
        BLF32Dual Bl; Bl.g = F.in[I_WGATE] + (size_t)e * DM * DFF + pn * 128; Bl.u = F.in[I_WUP] + (size_t)e * DM * DFF + pn * 128; Bl.ld = DFF;
        const EpiMoe1 E{(bf16_t*)(F.ws + WS_HID) + (size_t)e * 1024 * DFF};
        gemm_mfma_tile<AGather, BLF32Dual, EpiMoe1, true>(F.lds, A, Bl, E, pm * 256, pn * 128, DM); }
}
__device__ __forceinline__ void p_moe2_fast(const Frame& F) {
    for (int r = 0;; ++r) { const int v = unit_of(F, r); if (v >= NE * 8 * 4) break; const int pm = v & 3, pn = (v >> 2) & 7, e = v >> 5;
        const ARows A{(const bf16_t*)(F.ws + WS_HID) + (size_t)e * 1024 * DFF, DFF};
        BLF32 Bl; Bl.base = F.in[I_WDOWN] + (size_t)e * DFF * DM + pn * 256; Bl.ld = DM;
        const EpiMoe2 E{(bf16_t*)(F.ws + WS_YE) + (size_t)e * 1024 * DM, (const float*)(F.ws + WS_WAFF), e};
        gemm_mfma_tile<ARows, BLF32, EpiMoe2, false>(F.lds, A, Bl, E, pm * 256, pn * 256, DFF); }
}


__device__ __forceinline__ void p_ssm_prep(const Frame& F, int g) {
    float* lam = (float*)F.lds;
    float* bb = lam + 2 * 64 * 17 * 2;
    float* cc = bb + 2 * 64 * 16 * 2;
    float* Tt = cc + 2 * 16 * 64 * 2;
    const int tid = F.tid;
    if (tid < 128) {
        const int dir = tid >> 6, p = tid & 63, pg = dir * 64 + g;
        const double dt = exp((double)F.in[I_LOGDT][pg]);
        const double lr = (double)F.in[I_ARE][pg * 64 + p], li = (double)F.in[I_AIM][pg * 64 + p];
        const double rho = lr * dt, th = li * dt;
        for (int m = 0; m <= 16; ++m) { const double mg = exp(rho * m); lam[((dir * 64 + p) * 17 + m) * 2 + 0] = (float)(mg * cos(th * m)); lam[((dir * 64 + p) * 17 + m) * 2 + 1] = (float)(mg * sin(th * m)); }
        const double lbr = exp(rho) * cos(th), lbi = exp(rho) * sin(th), den = lr * lr + li * li, nr = lbr - 1.0;
        const double fr = (nr * lr + lbi * li) / den, fi = (lbi * lr - nr * li) / den;
        for (int h = 0; h < 16; ++h) { const double br = (double)F.in[I_BRE][(size_t)(pg * 64 + p) * 16 + h], bi = (double)F.in[I_BIM][(size_t)(pg * 64 + p) * 16 + h];
            bb[((dir * 64 + p) * 16 + h) * 2 + 0] = (float)(fr * br - fi * bi); bb[((dir * 64 + p) * 16 + h) * 2 + 1] = (float)(fr * bi + fi * br); }
        float* LAM = (float*)(F.ws + WS_LAM);
        const double m16 = exp(rho * 16.0); LAM[((dir * 64 + g) * 64 + p) * 2 + 0] = (float)(m16 * cos(th * 16.0)); LAM[((dir * 64 + g) * 64 + p) * 2 + 1] = (float)(m16 * sin(th * 16.0));
    }
    for (int i = tid; i < 2048; i += NT) { const int dir = i >> 10, h = (i >> 6) & 15, p = i & 63;
        cc[i * 2 + 0] = F.in[I_CRE][(size_t)((dir * 64 + g) * 16 + h) * 64 + p]; cc[i * 2 + 1] = F.in[I_CIM][(size_t)((dir * 64 + g) * 16 + h) * 64 + p]; }
    __syncthreads();
    for (int i = tid; i < 31 * 256; i += NT) {
        const int ti = i >> 8, hp = (i >> 4) & 15, h = i & 15, tau = ti - 15;
        float s = 0.f;
        if (tau >= 0) { const int m = tau;
            for (int p = 0; p < 64; ++p) { const float cr = cc[((0 * 16 + hp) * 64 + p) * 2], ci = cc[((0 * 16 + hp) * 64 + p) * 2 + 1], lr = lam[((0 * 64 + p) * 17 + m) * 2], li = lam[((0 * 64 + p) * 17 + m) * 2 + 1];
                const float br = bb[((0 * 64 + p) * 16 + h) * 2], bi = bb[((0 * 64 + p) * 16 + h) * 2 + 1]; const float mr = cr * lr - ci * li, mi = cr * li + ci * lr; s += mr * br - mi * bi; } }
        if (tau <= 0) { const int m = -tau;
            for (int p = 0; p < 64; ++p) { const float cr = cc[((1 * 16 + hp) * 64 + p) * 2], ci = cc[((1 * 16 + hp) * 64 + p) * 2 + 1], lr = lam[((1 * 64 + p) * 17 + m) * 2], li = lam[((1 * 64 + p) * 17 + m) * 2 + 1];
                const float br = bb[((1 * 64 + p) * 16 + h) * 2], bi = bb[((1 * 64 + p) * 16 + h) * 2 + 1]; const float mr = cr * lr - ci * li, mi = cr * li + ci * lr; s += mr * br - mi * bi; } }
        if (tau == 0 && hp == h) s += F.in[I_SSMD][g * 16 + h];
        Tt[i] = s;
    }
    __syncthreads();
    bf16_t* BM = (bf16_t*)(F.ws + WS_BMAT) + (size_t)g * 256 * 256;
    for (int i = tid; i < 256 * 128; i += NT) { const int k = i >> 7, n0 = (i & 127) * 2, j = k >> 4, h = k & 15; float v[2];
#pragma unroll
        for (int q = 0; q < 2; ++q) { const int n = n0 + q, dir = n >> 7, ri = (n >> 6) & 1, p = n & 63, m = dir ? j : 15 - j;
            const float lr = lam[((dir * 64 + p) * 17 + m) * 2], li = lam[((dir * 64 + p) * 17 + m) * 2 + 1], br = bb[((dir * 64 + p) * 16 + h) * 2], bi = bb[((dir * 64 + p) * 16 + h) * 2 + 1];
            v[q] = ri ? (lr * bi + li * br) : (lr * br - li * bi); }
        *(unsigned*)(BM + (size_t)k * 256 + n0) = pack2(v[0], v[1]); }
    bf16_t* KC = (bf16_t*)(F.ws + WS_KCMAT) + (size_t)g * 512 * 256;
    for (int i = tid; i < 512 * 128; i += NT) { const int k = i >> 7, n0 = (i & 127) * 2; float v[2];
#pragma unroll
        for (int q = 0; q < 2; ++q) { const int n = n0 + q, ii = n >> 4, hp = n & 15;
            if (k < 256) { const int j = k >> 4, h = k & 15; v[q] = Tt[((ii - j + 15) * 16 + hp) * 16 + h]; }
            else { const int kk = k - 256, dir = kk >> 7, ri = (kk >> 6) & 1, p = kk & 63, m = dir ? 16 - ii : ii + 1;
                const float cr = cc[((dir * 16 + hp) * 64 + p) * 2], ci = cc[((dir * 16 + hp) * 64 + p) * 2 + 1], lr = lam[((dir * 64 + p) * 17 + m) * 2], li = lam[((dir * 64 + p) * 17 + m) * 2 + 1];
                v[q] = ri ? -(cr * li + ci * lr) : (cr * lr - ci * li); } }
        *(unsigned*)(KC + (size_t)k * 256 + n0) = pack2(v[0], v[1]); }
    __syncthreads();
}
struct EpiS { float* SS;
    __device__ __forceinline__ void store4(int r, int n, f32x4 v) const { *(f32x4*)(SS + (size_t)r * 256 + n) = v; } };
struct EpiY { bf16_t* ZB; int g;
    __device__ __forceinline__ void store4(int r, int n, f32x4 v) const { const int b = r >> 7, c = r & 127, i = n >> 4, hp = n & 15; const size_t t = (size_t)b * SEQ + c * 16 + i;
        u32x2 w; w.x = pack2(gelu_tanh(v[0]), gelu_tanh(v[1])); w.y = pack2(gelu_tanh(v[2]), gelu_tanh(v[3])); *(u32x2*)(ZB + t * 1024 + g * 16 + hp) = w; } };
__device__ __forceinline__ void p_ssm_sgemm(const Frame& F) {
    for (int r = 0;; ++r) { const int v = unit_of(F, r); if (v >= 128) break; const int g = v >> 1, pm = v & 1;
        const ARows A{(const bf16_t*)(F.ws + WS_UX) + (size_t)g * 512 * 512, 512};
        BLBf16 Bl; Bl.base = (const bf16_t*)(F.ws + WS_BMAT) + (size_t)g * 256 * 256; Bl.ld = 256;
        const EpiS E{(float*)(F.ws + WS_SS) + (size_t)g * 512 * 256};
        gemm_mfma_tile<ARows, BLBf16, EpiS, false>(F.lds, A, Bl, E, pm * 256, 0, 256); }
}
__device__ __forceinline__ void p_ssm_ygemm(const Frame& F) {
    for (int r = 0;; ++r) { const int v = unit_of(F, r); if (v >= 128) break; const int g = v >> 1, pm = v & 1;
        const ARows A{(const bf16_t*)(F.ws + WS_UX) + (size_t)g * 512 * 512, 512};
        BLBf16 Bl; Bl.base = (const bf16_t*)(F.ws + WS_KCMAT) + (size_t)g * 512 * 256; Bl.ld = 256;
        const EpiY E{(bf16_t*)(F.ws + WS_ZB), g};
        gemm_mfma_tile<ARows, BLBf16, EpiY, false>(F.lds, A, Bl, E, pm * 256, 0, 512); }
}
__device__ __forceinline__ void p_ssm_scan(const Frame& F) {
    const float* SS = (const float*)(F.ws + WS_SS); bf16_t* UX = (bf16_t*)(F.ws + WS_UX); const float* LAM = (const float*)(F.ws + WS_LAM);
    for (int w = F.bid + F.G * F.wave; w < NG * NB * 2; w += F.G * 8) {
        const int dir = w & 1, b = (w >> 1) & 3, g = w >> 3, p = F.lane;
        const float l16r = LAM[((dir * 64 + g) * 64 + p) * 2], l16i = LAM[((dir * 64 + g) * 64 + p) * 2 + 1];
        float xr = 0.f, xi = 0.f;
        for (int c0 = 0; c0 < 128; c0 += 8) {
            float sr[8], si[8];
#pragma unroll
            for (int q = 0; q < 8; ++q) { const int c = dir ? 127 - (c0 + q) : c0 + q; const float* sp = SS + ((size_t)g * 512 + b * 128 + c) * 256 + dir * 128 + p; sr[q] = sp[0]; si[q] = sp[64]; }
#pragma unroll
            for (int q = 0; q < 8; ++q) { const int c = dir ? 127 - (c0 + q) : c0 + q; bf16_t* xp = UX + ((size_t)g * 512 + b * 128 + c) * 512 + 256 + dir * 128 + p;
                xp[0] = f2bf(xr); xp[64] = f2bf(xi);
                const float nr = l16r * xr - l16i * xi + sr[q], ni = l16r * xi + l16i * xr + si[q]; xr = nr; xi = ni; }
        }
    }
}


__device__ __forceinline__ void p_attn_fast(const Frame& F) {
    LAS unsigned char* lds = (LAS unsigned char*)F.lds;
    LAS float* rp = (LAS float*)(lds + 73728);
    const bf16_t* Q = (const bf16_t*)(F.ws + WS_Q); const bf16_t* Kb = (const bf16_t*)(F.ws + WS_K); const bf16_t* Vb = (const bf16_t*)(F.ws + WS_V);
    bf16_t* Y = (bf16_t*)(F.ws + WS_YATT); const float* rpb = F.in[I_RPB];
    const int lane = F.lane, wave = F.wave, q = lane & 15, G = lane >> 4;
    for (int pu = F.bid; pu < NB * NH * 16; pu += F.G) {
        const int b = pu >> 8, h = (pu >> 4) & 15, i2 = pu & 15, r0 = 2 * i2;
        int rs0 = r0 - 4; rs0 = rs0 < 0 ? 0 : (rs0 > 24 ? 24 : rs0);
        const int base = rs0 < 23 ? rs0 : 23;
        for (int c = F.tid; c < 9 * 64 * 8; c += NT) { const int key = c >> 3, chunk = c & 7;
            const u32x4 v = *(const u32x4*)(Vb + (size_t)(b * SEQ + base * 64 + key) * 1024 + h * 64 + chunk * 8);
            const int phys = key * 128 + (((((chunk >> 1) ^ ((key >> 1) & 3)) << 1) | (chunk & 1)) << 4);
            *(LAS u32x4*)(lds + phys) = v; }
        if (F.tid < 465) rp[F.tid] = rpb[h * 465 + F.tid];
        __syncthreads();
        {
            const int r = r0 + (wave >> 2), qb = wave & 3;
            int rs = r - 4; rs = rs < 0 ? 0 : (rs > 24 ? 24 : rs);
            const int c0 = (qb == 0) ? 0 : (qb == 1) ? 8 : (qb == 2) ? 24 : 32;
            const int wq = 16 * qb + q;
            int cs = wq - 8; cs = cs < 0 ? 0 : (cs > 48 ? 48 : cs);
            const bf16_t* qp = Q + (size_t)(b * SEQ + r * 64 + wq) * 1024 + h * 64 + 8 * G;
            const bf16x8 qf0 = *(const bf16x8*)qp, qf1 = *(const bf16x8*)(qp + 32);
            f32x4 s[16];
#pragma unroll
            for (int t = 0; t < 16; ++t) {
                const bf16_t* kp = Kb + (size_t)(b * SEQ + (rs + (t >> 1)) * 64 + c0 + 16 * (t & 1) + q) * 1024 + h * 64 + 8 * G;
                const bf16x8 k0 = *(const bf16x8*)kp, k1 = *(const bf16x8*)(kp + 32);
                f32x4 a = (f32x4){0.f, 0.f, 0.f, 0.f};
                a = __builtin_amdgcn_mfma_f32_16x16x32_bf16(k0, qf0, a, 0, 0, 0);
                a = __builtin_amdgcn_mfma_f32_16x16x32_bf16(k1, qf1, a, 0, 0, 0);
                s[t] = a;
            }
            float mx = -1e30f;
#pragma unroll
            for (int t = 0; t < 16; ++t) {
                const int dr = rs + (t >> 1) - r + 7;
#pragma unroll
                for (int e = 0; e < 4; ++e) { const int wk = c0 + 16 * (t & 1) + 4 * G + e; const bool valid = (wk >= cs) && (wk < cs + 16);
                    int dc = wk - wq + 15; dc = dc < 0 ? 0 : (dc > 30 ? 30 : dc);
                    const float v = valid ? s[t][e] + rp[dr * 31 + dc] : -1e30f; s[t][e] = v; mx = fmaxf(mx, v); }
            }
            mx = fmaxf(mx, __shfl_xor(mx, 16)); mx = fmaxf(mx, __shfl_xor(mx, 32));
            float lsum = 0.f;
#pragma unroll
            for (int t = 0; t < 16; ++t)
#pragma unroll
                for (int e = 0; e < 4; ++e) { const float p = __expf(s[t][e] - mx); s[t][e] = p; lsum += p; }
            lsum += __shfl_xor(lsum, 16); lsum += __shfl_xor(lsum, 32);
            f32x4 o[4];
#pragma unroll
            for (int dt = 0; dt < 4; ++dt) o[dt] = (f32x4){0.f, 0.f, 0.f, 0.f};
#pragma unroll
            for (int kk = 0; kk < 8; ++kk) {
                union { bf16x8 v; unsigned u[4]; } pf;
                pf.u[0] = pack2(s[2 * kk][0], s[2 * kk][1]); pf.u[1] = pack2(s[2 * kk][2], s[2 * kk][3]);
                pf.u[2] = pack2(s[2 * kk + 1][0], s[2 * kk + 1][1]); pf.u[3] = pack2(s[2 * kk + 1][2], s[2 * kk + 1][3]);
                const int keyA = (rs + kk - base) * 64 + c0 + 4 * G + (q >> 2), keyB = keyA + 16;
#pragma unroll
                for (int dt = 0; dt < 4; ++dt) {
                    const int aA = keyA * 128 + ((dt ^ ((keyA >> 1) & 3)) << 5) + 8 * (q & 3), aB = keyB * 128 + ((dt ^ ((keyB >> 1) & 3)) << 5) + 8 * (q & 3);
                    const s16x4 lo = __builtin_amdgcn_ds_read_tr16_b64_v4i16((LAS s16x4*)(lds + aA));
                    const s16x4 hi = __builtin_amdgcn_ds_read_tr16_b64_v4i16((LAS s16x4*)(lds + aB));
                    const bf16x8 vf = (bf16x8){lo[0], lo[1], lo[2], lo[3], hi[0], hi[1], hi[2], hi[3]};
                    o[dt] = __builtin_amdgcn_mfma_f32_16x16x32_bf16(vf, pf.v, o[dt], 0, 0, 0);
                }
            }
            const float inv = 1.0f / lsum;
            bf16_t* yp = Y + (size_t)(b * SEQ + r * 64 + wq) * 1024 + h * 64 + 4 * G;
#pragma unroll
            for (int dt = 0; dt < 4; ++dt) { u32x2 w; w.x = pack2(o[dt][0] * inv, o[dt][1] * inv); w.y = pack2(o[dt][2] * inv, o[dt][3] * inv); *(u32x2*)(yp + 16 * dt) = w; }
        }
        __syncthreads();
    }
}

__device__ __forceinline__ void p_ssm_naive(const Frame& F) {
    if (F.wave != 0) return;
    const bf16_t* UX = (const bf16_t*)(F.ws + WS_UX); float* ybuf = (float*)(F.ws + WS_SS); bf16_t* ZB = (bf16_t*)(F.ws + WS_ZB);
    const int lane = F.lane;
    for (int u = F.bid; u < NB * NG; u += F.G) {
        const int b = u >> 6, g = u & 63;
        for (int dir = 0; dir < 2; ++dir) {
            const int pg = dir * 64 + g;
            const float dt = expf(F.in[I_LOGDT][pg]);
            const float lr = F.in[I_ARE][pg * 64 + lane], li = F.in[I_AIM][pg * 64 + lane];
            const float mag = expf(lr * dt); const float lbr = mag * cosf(li * dt), lbi = mag * sinf(li * dt);
            const float den = lr * lr + li * li, nr = lbr - 1.0f;
            const float fr = (nr * lr + lbi * li) / den, fi = (lbi * lr - nr * li) / den;
            float bbr[16], bbi[16], cr[16], ci[16];
#pragma unroll
            for (int h = 0; h < 16; ++h) { const float br = F.in[I_BRE][(size_t)(pg * 64 + lane) * 16 + h], bi = F.in[I_BIM][(size_t)(pg * 64 + lane) * 16 + h];
                bbr[h] = fr * br - fi * bi; bbi[h] = fr * bi + fi * br;
                cr[h] = F.in[I_CRE][(size_t)(pg * 16 + h) * 64 + lane]; ci[h] = F.in[I_CIM][(size_t)(pg * 16 + h) * 64 + lane]; }
            const float dsk = F.in[I_SSMD][g * 16 + (lane & 15)];
            float xr = 0.f, xi = 0.f;
            for (int s = 0; s < SEQ; ++s) {
                const int l = dir ? (SEQ - 1 - s) : s;
                const bf16_t* up = UX + (size_t)(g * 512 + b * 128 + (l >> 4)) * 512 + (l & 15) * 16;
                const float uval = bf2f(up[lane & 15]);
                float bur = 0.f, bui = 0.f;
#pragma unroll
                for (int h = 0; h < 16; ++h) { const float uh = __shfl(uval, h); bur += bbr[h] * uh; bui += bbi[h] * uh; }
                const float nxr = lbr * xr - lbi * xi + bur, nxi = lbr * xi + lbi * xr + bui; xr = nxr; xi = nxi;
                float myy = 0.f;
#pragma unroll
                for (int h = 0; h < 16; ++h) { const float v = wave_sum(cr[h] * xr - ci[h] * xi); if (lane == h) myy = v; }
                const size_t o = (size_t)(b * SEQ + l) * 1024 + g * 16;
                if (lane < 16) {
                    if (dir == 0) ybuf[o + lane] = myy;
                    else { const float y = ybuf[o + lane] + myy + dsk * uval; ZB[o + lane] = f2bf(gelu_tanh(y)); }
                }
            }
        }
    }
}

__device__ __forceinline__ void p_attn_naive(const Frame& F) {
    const bf16_t* Q = (const bf16_t*)(F.ws + WS_Q); const bf16_t* Kb = (const bf16_t*)(F.ws + WS_K); const bf16_t* Vb = (const bf16_t*)(F.ws + WS_V);
    bf16_t* Y = (bf16_t*)(F.ws + WS_YATT); const float* rpb = F.in[I_RPB];
    for (int id = F.bid * NT + F.tid; id < TOK * NH; id += F.G * NT) {
        const int t = id >> 4, h = id & 15, b = t >> 11, l = t & 2047, r = l >> 6, w = l & 63;
        int rs = r - 4; rs = rs < 0 ? 0 : (rs > 24 ? 24 : rs);
        int cs = w - 8; cs = cs < 0 ? 0 : (cs > 48 ? 48 : cs);
        float q[64], acc[64];
        const u32x4* qp = (const u32x4*)(Q + (size_t)t * 1024 + h * 64);
#pragma unroll
        for (int i = 0; i < 8; ++i) { const u32x4 v = qp[i]; q[i * 8 + 0] = bflo(v.x); q[i * 8 + 1] = bfhi(v.x); q[i * 8 + 2] = bflo(v.y); q[i * 8 + 3] = bfhi(v.y);
            q[i * 8 + 4] = bflo(v.z); q[i * 8 + 5] = bfhi(v.z); q[i * 8 + 6] = bflo(v.w); q[i * 8 + 7] = bfhi(v.w); }
#pragma unroll
        for (int d = 0; d < 64; ++d) acc[d] = 0.f;
        float m = -1e30f, lsum = 0.f;
        for (int j = 0; j < 8; ++j) {
            const int kr = rs + j, dr = kr - r + 7;
            for (int kk = 0; kk < 16; ++kk) {
                const int wk = cs + kk, dc = wk - w + 15;
                const size_t kt = (size_t)(b * SEQ + kr * 64 + wk) * 1024 + h * 64;
                const u32x4* kp = (const u32x4*)(Kb + kt);
                float s = 0.f;
#pragma unroll
                for (int i = 0; i < 8; ++i) { const u32x4 v = kp[i];
                    s += q[i * 8 + 0] * bflo(v.x) + q[i * 8 + 1] * bfhi(v.x) + q[i * 8 + 2] * bflo(v.y) + q[i * 8 + 3] * bfhi(v.y)
                       + q[i * 8 + 4] * bflo(v.z) + q[i * 8 + 5] * bfhi(v.z) + q[i * 8 + 6] * bflo(v.w) + q[i * 8 + 7] * bfhi(v.w); }
                s += rpb[(h * 15 + dr) * 31 + dc];
                const float mn = fmaxf(m, s); const float corr = __expf(m - mn), p = __expf(s - mn);
                lsum = lsum * corr + p; m = mn;
                const u32x4* vp = (const u32x4*)(Vb + kt);
#pragma unroll
                for (int i = 0; i < 8; ++i) { const u32x4 v = vp[i];
                    acc[i * 8 + 0] = acc[i * 8 + 0] * corr + p * bflo(v.x); acc[i * 8 + 1] = acc[i * 8 + 1] * corr + p * bfhi(v.x);
                    acc[i * 8 + 2] = acc[i * 8 + 2] * corr + p * bflo(v.y); acc[i * 8 + 3] = acc[i * 8 + 3] * corr + p * bfhi(v.y);
                    acc[i * 8 + 4] = acc[i * 8 + 4] * corr + p * bflo(v.z); acc[i * 8 + 5] = acc[i * 8 + 5] * corr + p * bfhi(v.z);
                    acc[i * 8 + 6] = acc[i * 8 + 6] * corr + p * bflo(v.w); acc[i * 8 + 7] = acc[i * 8 + 7] * corr + p * bfhi(v.w); }
            }
        }
        const float inv = 1.0f / lsum;
        u32x4* yp = (u32x4*)(Y + (size_t)t * 1024 + h * 64);
#pragma unroll
        for (int i = 0; i < 8; ++i) { u32x4 o; o.x = pack2(acc[i * 8 + 0] * inv, acc[i * 8 + 1] * inv); o.y = pack2(acc[i * 8 + 2] * inv, acc[i * 8 + 3] * inv);
            o.z = pack2(acc[i * 8 + 4] * inv, acc[i * 8 + 5] * inv); o.w = pack2(acc[i * 8 + 6] * inv, acc[i * 8 + 7] * inv); yp[i] = o; }
    }
}

__device__ __forceinline__ void p_normcat(const Frame& F) {
    const bf16_t* YS = (const bf16_t*)(F.ws + WS_YSSM); const bf16_t* YA = (const bf16_t*)(F.ws + WS_YATT); bf16_t* MIX = (bf16_t*)(F.ws + WS_MIX);
    for (int t = F.bid * 8 + F.wave; t < TOK; t += F.G * 8) {
#pragma unroll
        for (int half = 0; half < 2; ++half) {
            const bf16_t* src = (half ? YA : YS) + (size_t)t * 1024; const float* g = F.in[half ? I_GATT : I_GSSM];
            float v[16]; float ss = 0.f;
#pragma unroll
            for (int i = 0; i < 2; ++i) { const u32x4 w = *(const u32x4*)(src + i * 512 + F.lane * 8);
                v[i * 8 + 0] = bflo(w.x); v[i * 8 + 1] = bfhi(w.x); v[i * 8 + 2] = bflo(w.y); v[i * 8 + 3] = bfhi(w.y); v[i * 8 + 4] = bflo(w.z); v[i * 8 + 5] = bfhi(w.z); v[i * 8 + 6] = bflo(w.w); v[i * 8 + 7] = bfhi(w.w); }
#pragma unroll
            for (int i = 0; i < 16; ++i) ss += v[i] * v[i];
            ss = wave_sum(ss);
            const float rstd = rsqrtf(ss * (1.0f / 1024.0f) + EPS);
#pragma unroll
            for (int i = 0; i < 2; ++i) { const int k = i * 512 + F.lane * 8; const f32x4 g0 = *(const f32x4*)(g + k), g1 = *(const f32x4*)(g + k + 4);
                u32x4 o; o.x = pack2(v[i * 8 + 0] * rstd * g0[0], v[i * 8 + 1] * rstd * g0[1]); o.y = pack2(v[i * 8 + 2] * rstd * g0[2], v[i * 8 + 3] * rstd * g0[3]);
                o.z = pack2(v[i * 8 + 4] * rstd * g1[0], v[i * 8 + 5] * rstd * g1[1]); o.w = pack2(v[i * 8 + 6] * rstd * g1[2], v[i * 8 + 7] * rstd * g1[3]);
                *(u32x4*)(MIX + (size_t)t * DM + half * 1024 + k) = o; }
        }
    }
}

__device__ __forceinline__ void p_h2(const Frame& F) {
    const float* X1 = (const float*)(F.ws + WS_X1); const float* g = F.in[I_GFFN]; const float* mod = F.modp(); const float* wr = F.in[I_WROUTER];
    bf16_t* H2 = (bf16_t*)(F.ws + WS_H2); float* AFF = (float*)(F.ws + WS_AFF);
    for (int t = F.bid * 8 + F.wave; t < TOK; t += F.G * 8) {
        const int b = t >> 11, l = t & 2047; const float* xr = X1 + (size_t)t * DM;
        f32x4 v[8]; float ss = 0.f;
#pragma unroll
        for (int i = 0; i < 8; ++i) { v[i] = *(const f32x4*)(xr + i * 256 + F.lane * 4); ss += v[i][0] * v[i][0] + v[i][1] * v[i][1] + v[i][2] * v[i][2] + v[i][3] * v[i][3]; }
        ss = wave_sum(ss);
        const float rstd = rsqrtf(ss * (1.0f / DM) + EPS);
        float lg[16];
#pragma unroll
        for (int e = 0; e < 16; ++e) lg[e] = 0.f;
#pragma unroll
        for (int i = 0; i < 8; ++i) { const int k = i * 256 + F.lane * 4;
            const f32x4 gv = *(const f32x4*)(g + k), sh = *(const f32x4*)(mod + b * 12288 + 6144 + k), sc = *(const f32x4*)(mod + b * 12288 + 8192 + k);
            float o[4];
#pragma unroll
            for (int j = 0; j < 4; ++j) { o[j] = (v[i][j] * rstd * gv[j]) * (1.0f + sc[j]) + sh[j];
                const f32x4* wp = (const f32x4*)(wr + (size_t)(k + j) * 16);
#pragma unroll
                for (int q = 0; q < 4; ++q) { const f32x4 wv = wp[q]; lg[q * 4 + 0] += o[j] * wv[0]; lg[q * 4 + 1] += o[j] * wv[1]; lg[q * 4 + 2] += o[j] * wv[2]; lg[q * 4 + 3] += o[j] * wv[3]; } }
            u32x2 w; w.x = pack2(o[0], o[1]); w.y = pack2(o[2], o[3]);
            *(u32x2*)(H2 + (size_t)t * DM + k) = w; }
        float mx = -1e30f;
#pragma unroll
        for (int e = 0; e < 16; ++e) { lg[e] = wave_sum(lg[e]); mx = fmaxf(mx, lg[e]); }
        float den = 0.f;
#pragma unroll
        for (int e = 0; e < 16; ++e) { lg[e] = expf(lg[e] - mx); den += lg[e]; }
        float mine = 0.f;
#pragma unroll
        for (int e = 0; e < 16; ++e) if (F.lane == e) mine = lg[e] / den;
        if (F.lane < 16) AFF[(size_t)(b * NE + F.lane) * SEQ + l] = mine;
    }
}

__device__ __forceinline__ void p_topk(const Frame& F) {
    unsigned long long* key = (unsigned long long*)F.lds;
    const float* AFF = (const float*)(F.ws + WS_AFF); int* IDX = (int*)(F.ws + WS_IDX); float* WAFF = (float*)(F.ws + WS_WAFF); int* SLOT = (int*)(F.ws + WS_SLOT);
    for (int u = F.bid; u < NB * NE; u += F.G) {
        for (int i = F.tid; i < SEQ; i += NT) key[i] = ((unsigned long long)__float_as_uint(AFF[(size_t)u * SEQ + i]) << 32) | (unsigned)(0xFFFFFFFFu - (unsigned)i);
        __syncthreads();
        for (int k = 2; k <= SEQ; k <<= 1)
            for (int j = k >> 1; j > 0; j >>= 1) {
                for (int i = F.tid; i < SEQ; i += NT) { const int ixj = i ^ j;
                    if (ixj > i) { const unsigned long long a = key[i], c = key[ixj]; const bool desc = ((i & k) == 0);
                        if (desc ? (a < c) : (a > c)) { key[i] = c; key[ixj] = a; } } }
                __syncthreads();
            }
        for (int i = F.tid; i < SEQ; i += NT) { const unsigned long long kv = key[i]; const int tok = (int)(0xFFFFFFFFu - (unsigned)(kv & 0xFFFFFFFFull));
            if (i < CAP) { IDX[u * CAP + i] = tok; WAFF[u * CAP + i] = __uint_as_float((unsigned)(kv >> 32)); }
            SLOT[(size_t)u * SEQ + tok] = (i < CAP) ? i : -1; }
        __syncthreads();
    }
}

__device__ __forceinline__ void p_final(const Frame& F) {
    const float* X1 = (const float*)(F.ws + WS_X1); const float* mod = F.modp(); const float* g = F.in[I_GFINAL];
    const bf16_t* YE = (const bf16_t*)(F.ws + WS_YE); const int* SLOT = (const int*)(F.ws + WS_SLOT);
    for (int t = F.bid * 8 + F.wave; t < TOK; t += F.G * 8) {
        const int b = t >> 11, l = t & 2047; const float* xr = X1 + (size_t)t * DM;
        f32x4 mo[8];
#pragma unroll
        for (int i = 0; i < 8; ++i) mo[i] = (f32x4){0.f, 0.f, 0.f, 0.f};
        for (int e = 0; e < NE; ++e) {
            const int s = SLOT[(size_t)(b * NE + e) * SEQ + l];
            if (s >= 0) { const bf16_t* yr = YE + ((size_t)e * 1024 + b * 256 + s) * DM;
#pragma unroll
                for (int i = 0; i < 8; ++i) { const u32x2 w = *(const u32x2*)(yr + i * 256 + F.lane * 4); mo[i][0] += bflo(w.x); mo[i][1] += bfhi(w.x); mo[i][2] += bflo(w.y); mo[i][3] += bfhi(w.y); } }
        }
        f32x4 v[8]; float ss = 0.f;
#pragma unroll
        for (int i = 0; i < 8; ++i) { const int k = i * 256 + F.lane * 4; const f32x4 xv = *(const f32x4*)(xr + k), gt = *(const f32x4*)(mod + b * 12288 + 10240 + k);
            v[i] = xv + gt * mo[i]; ss += v[i][0] * v[i][0] + v[i][1] * v[i][1] + v[i][2] * v[i][2] + v[i][3] * v[i][3]; }
        ss = wave_sum(ss);
        const float rstd = rsqrtf(ss * (1.0f / DM) + EPS);
#pragma unroll
        for (int i = 0; i < 8; ++i) { const int k = i * 256 + F.lane * 4; const f32x4 gv = *(const f32x4*)(g + k);
            *(f32x4*)(F.out + (size_t)t * DM + k) = v[i] * rstd * gv; }
    }
}

constexpr int N_PHASES = 14;
__global__ void __launch_bounds__(NT, 2) fwd(Args args) {
    extern __shared__ __attribute__((aligned(16))) unsigned char lds[];
    Frame F;
#pragma unroll
    for (int i = 0; i < 26; ++i) F.in[i] = args.in[i];
    F.out = args.out; F.ws = args.ws; F.lds = lds;
    F.tid = threadIdx.x; F.lane = F.tid & 63; F.wave = __builtin_amdgcn_readfirstlane(F.tid >> 6); F.G = gridDim.x; F.bid = blockIdx.x;
    volatile LAS unsigned* xbw = (volatile LAS unsigned*)(lds + LDS_BYTES - 16);
    if (F.tid == 0) { xbw[0] = 0u; xbw[1] = 0u; xbw[2] = 0u; xbw[3] = 0u; }
    __syncthreads();
    const int lo = args.ph_lo, hi = args.ph_hi;
    XcdBarrier bar; bar.bar = (unsigned*)(F.ws + WS_CTL); bar.x = 0; bar.st = xbw;
    if (hi - lo > 1) bar = xcd_barrier_post((unsigned*)(F.ws + WS_CTL), xbw);
#define IN(k) (lo <= (k) && (k) < hi)
#define SEAM(k) do { if (IN(k) && IN((k) + 1)) xcd_barrier(bar); } while (0)
    if (IN(0)) { p_ada(F); if (FAST_SSM) { for (int g = F.G - 1 - F.bid; g < NG; g += F.G) p_ssm_prep(F, g); } } SEAM(0);
    if (IN(1)) { p_h1(F); } SEAM(1);
    if (IN(2)) { if (FAST_INPROJ) p_inproj_fast(F); else p_inproj_naive(F); } SEAM(2);
    if (IN(3)) { if (FAST_SSM) p_ssm_sgemm(F); else p_ssm_naive(F); __syncthreads(); if (FAST_ATTN) p_attn_fast(F); else p_attn_naive(F); } SEAM(3);
    if (IN(4)) { if (FAST_SSM) p_ssm_scan(F); } SEAM(4);
    if (IN(5)) { if (FAST_SSM) p_ssm_ygemm(F); } SEAM(5);
    if (IN(6)) { if (FAST_GLU) p_glu_fast(F); else p_glu_naive(F); } SEAM(6);
    if (IN(7)) { p_normcat(F); } SEAM(7);
    if (IN(8)) { if (FAST_OUT) p_outproj_fast(F); else p_outproj_naive(F); } SEAM(8);
    if (IN(9)) { p_h2(F); } SEAM(9);
    if (IN(10)) { p_topk(F); } SEAM(10);
    if (IN(11)) { if (FAST_MOE1) p_moe1_fast(F); else p_moe1_naive(F); } SEAM(11);
    if (IN(12)) { if (FAST_MOE2) p_moe2_fast(F); else p_moe2_naive(F); } SEAM(12);
    if (IN(13)) { p_final(F); }
#undef IN
#undef SEAM
}

extern "C" void kernel_launch(void* const* d_in, const int* in_sizes, int n_in, void* d_out, int out_size, void* d_ws, size_t ws_size, hipStream_t stream) {
    static int grid = 0;
    if (grid == 0) {
        if (n_in != 26 || out_size != TOK * DM || ws_size < WS_END) { fprintf(stderr, "kernel_launch: unexpected problem (n_in %d out %d ws %zu need %zu)\n", n_in, out_size, ws_size, (size_t)WS_END); grid = -1; return; }
        int dev = 0, cus = 0, per_cu = 0;
        if (hipGetDevice(&dev) != hipSuccess || hipDeviceGetAttribute(&cus, hipDeviceAttributeMultiprocessorCount, dev) != hipSuccess) { grid = -1; return; }
        if (hipFuncSetAttribute((const void*)fwd, hipFuncAttributeMaxDynamicSharedMemorySize, LDS_BYTES) != hipSuccess) { fprintf(stderr, "kernel_launch: hipFuncSetAttribute failed\n"); grid = -1; return; }
        if (hipOccupancyMaxActiveBlocksPerMultiprocessor(&per_cu, (const void*)fwd, NT, LDS_BYTES) != hipSuccess || per_cu < 1) { fprintf(stderr, "kernel_launch: occupancy query says %d\n", per_cu); }
        (void)hipGetLastError();
        grid = cus;
    }
    if (grid < 0) return;
    (void)hipMemsetAsync((char*)d_ws + WS_CTL, 0, CTL_BYTES, stream);
    Args a{};
    for (int i = 0; i < 26; ++i) a.in[i] = (const float*)d_in[i];
    a.out = (float*)d_out; a.ws = (unsigned char*)d_ws;
#if N_LAUNCH_MODE == 1
    a.ph_lo = 0; a.ph_hi = N_PHASES;
    hipLaunchKernelGGL(fwd, dim3(grid), dim3(NT), LDS_BYTES, stream, a);
#else
    for (int p = 0; p < N_PHASES; ++p) {
        if (p == 4 || p == 5) continue;
        a.ph_lo = p; a.ph_hi = p + 1;
        hipLaunchKernelGGL(fwd, dim3(grid), dim3(NT), LDS_BYTES, stream, a);
    }
#endif
}
```

```cpp
#include <hip/hip_runtime.h>
#include <stdint.h>
#include <stdio.h>

#ifndef N_LAUNCH_MODE
#define N_LAUNCH_MODE 1
#endif

#ifndef PROBE_MASK
#define PROBE_MASK 0
#endif
#define REPS(k) ((PROBE_MASK >> (k)) & 1)
#define FAST_INPROJ 1
#define FAST_GLU 1
#define FAST_OUT 1
#define FAST_MOE1 1
#define FAST_MOE2 1
#define FAST_SSM 1
#define FAST_ATTN 1
#define LAS __attribute__((address_space(3)))
typedef unsigned short bf16_t;
typedef float f32x4 __attribute__((ext_vector_type(4)));
typedef float f32x2 __attribute__((ext_vector_type(2)));
typedef short bf16x8 __attribute__((ext_vector_type(8)));
typedef short s16x4 __attribute__((ext_vector_type(4)));
typedef unsigned u32x2 __attribute__((ext_vector_type(2)));
typedef unsigned u32x4 __attribute__((ext_vector_type(4)));

constexpr int NT = 512;
constexpr int TOK = 8192, DM = 2048, NB = 4, SEQ = 2048;
constexpr int DSSM = 1024, DATT = 1024, NH = 16, HD = 64, DINP = 4096;
constexpr int NE = 16, CAP = 256, DFF = 2816;
constexpr int NG = 64, NP = 64, GH = 16;
constexpr float EPS = 1e-6f;

constexpr size_t al256(size_t x) { return (x + 255) & ~(size_t)255; }
constexpr size_t WS_CTL   = 0;
constexpr size_t CTL_BYTES = 32768;
constexpr size_t WS_MOD   = WS_CTL + CTL_BYTES;
constexpr size_t WS_H1    = al256(WS_MOD + (size_t)NB * 12288 * 4);
constexpr size_t WS_UX    = al256(WS_H1 + (size_t)TOK * DM * 2);
constexpr size_t WS_Q     = al256(WS_UX + (size_t)64 * 512 * 512 * 2);
constexpr size_t WS_K     = al256(WS_Q + (size_t)TOK * 1024 * 2);
constexpr size_t WS_V     = al256(WS_K + (size_t)TOK * 1024 * 2);
constexpr size_t WS_SS    = al256(WS_V + (size_t)TOK * 1024 * 2);
constexpr size_t WS_ZB    = al256(WS_SS + (size_t)64 * 512 * 256 * 4);
constexpr size_t WS_YSSM  = al256(WS_ZB + (size_t)TOK * 1024 * 2);
constexpr size_t WS_YATT  = al256(WS_YSSM + (size_t)TOK * 1024 * 2);
constexpr size_t WS_MIX   = al256(WS_YATT + (size_t)TOK * 1024 * 2);
constexpr size_t WS_X1    = al256(WS_MIX + (size_t)TOK * DM * 2);
constexpr size_t WS_H2    = al256(WS_X1 + (size_t)TOK * DM * 4);
constexpr size_t WS_AFF   = al256(WS_H2 + (size_t)TOK * DM * 2);
constexpr size_t WS_IDX   = al256(WS_AFF + (size_t)NB * NE * SEQ * 4);
constexpr size_t WS_WAFF  = al256(WS_IDX + (size_t)NB * NE * CAP * 4);
constexpr size_t WS_SLOT  = al256(WS_WAFF + (size_t)NB * NE * CAP * 4);
constexpr size_t WS_HID   = al256(WS_SLOT + (size_t)NB * NE * SEQ * 4);
constexpr size_t WS_YE    = al256(WS_HID + (size_t)NE * 1024 * DFF * 2);
constexpr size_t WS_BMAT  = al256(WS_YE + (size_t)NE * 1024 * DM * 2);
constexpr size_t WS_KCMAT = al256(WS_BMAT + (size_t)64 * 256 * 256 * 2);
constexpr size_t WS_LAM   = al256(WS_KCMAT + (size_t)64 * 512 * 256 * 2);
constexpr size_t WS_END   = al256(WS_LAM + (size_t)2 * 64 * 64 * 2 * 4);

constexpr int LDS_BYTES = 163840;

typedef __bf16 bf16x2_t __attribute__((ext_vector_type(2)));
__device__ __forceinline__ bf16_t f2bf(float f) { return __builtin_bit_cast(bf16_t, (__bf16)f); }
__device__ __forceinline__ float bf2f(bf16_t b) { return __uint_as_float(((unsigned)b) << 16); }
__device__ __forceinline__ float bflo(unsigned w) { return __uint_as_float(w << 16); }
__device__ __forceinline__ float bfhi(unsigned w) { return __uint_as_float(w & 0xffff0000u); }
__device__ __forceinline__ unsigned pack2(float lo, float hi) { const f32x2 f = {lo, hi}; return __builtin_bit_cast(unsigned, __builtin_convertvector(f, bf16x2_t)); }
__device__ __forceinline__ float wave_sum(float v) {
#pragma unroll
    for (int m = 32; m >= 1; m >>= 1) v += __shfl_xor(v, m);
    return v;
}
__device__ __forceinline__ float silu_f(float v) { return v / (1.0f + __expf(-v)); }
__device__ __forceinline__ float sigmoid_f(float v) { return 1.0f / (1.0f + __expf(-v)); }
__device__ __forceinline__ float gelu_tanh(float y) { const float t = 0.7978845608028654f * (y + 0.044715f * y * y * y); return 0.5f * y * (1.0f + tanhf(t)); }

#define XB_TMO      128
#define XB_XCNT(j)  (256  + 64 * (j))
#define XB_XSUB(j)  (1280 + 64 * (j))
#define XB_XGEN(j)  (2304 + 64 * (j))
#define XB_TOP      3328
#define XB_TOPGEN   3392
#define XCD_BAR_WORDS 3456
#define XB_SPIN_CAP (1u << 18)
__device__ __forceinline__ unsigned xb_ld(unsigned* p)              { return __hip_atomic_load(p, __ATOMIC_RELAXED, __HIP_MEMORY_SCOPE_AGENT); }
__device__ __forceinline__ unsigned xb_add(unsigned* p, unsigned v) { return __hip_atomic_fetch_add(p, v, __ATOMIC_RELAXED, __HIP_MEMORY_SCOPE_AGENT); }
__device__ __forceinline__ unsigned xb_xcc_id() { return (unsigned)__builtin_amdgcn_s_getreg((3 << 11) | 20) & 0xFu; }
#define XB_SPIN(cond, bar) do { unsigned _sp = 0; while (cond) { __builtin_amdgcn_s_sleep(1); \
    if ((++_sp & 255u) == 0u) { if (xb_ld(&(bar)[XB_TMO])) break; if (_sp > XB_SPIN_CAP) { atomicAdd(&(bar)[XB_TMO], 1u); break; } } } } while (0)
struct XcdBarrier { unsigned* bar; unsigned x; unsigned nloc, nx; };
__device__ __forceinline__ XcdBarrier xcd_barrier_post(unsigned* bar) {
    XcdBarrier b; b.bar = bar; b.x = xb_xcc_id(); b.nloc = 0u; b.nx = 0u;
    if (threadIdx.x == 0) (void)xb_add(&bar[XB_XCNT(b.x)], 1u);
    return b;
}
__device__ __forceinline__ void xcd_barrier_complete(unsigned* bar, unsigned x, unsigned& nloc, unsigned& nx) {
    const unsigned G = gridDim.x * gridDim.y * gridDim.z;
    unsigned sum, cnt, mine, sp = 0u;
    for (;;) {
        sum = 0u; cnt = 0u; mine = 0u;
#pragma unroll
        for (unsigned j = 0; j < 16; ++j) { const unsigned c = xb_ld(&bar[XB_XCNT(j)]); sum += c; cnt += (c > 0u) ? 1u : 0u; mine = (j == x) ? c : mine; }
        if (sum == G) break;
        __builtin_amdgcn_s_sleep(1);
        if ((++sp & 255u) == 0u) { if (xb_ld(&bar[XB_TMO])) break; if (sp > XB_SPIN_CAP) { atomicAdd(&bar[XB_TMO], 1u); break; } }
    }
    nloc = mine > 0u ? mine : 1u; nx = cnt > 0u ? cnt : 1u;
}
__device__ __forceinline__ void xcd_barrier(XcdBarrier& b) {
    asm volatile("s_waitcnt vmcnt(0)" ::: "memory");
    __syncthreads();
    if (threadIdx.x == 0) {
        unsigned* bar = b.bar;
        __builtin_amdgcn_s_waitcnt(0);
        unsigned nloc = b.nloc, nx = b.nx;
        if (nloc == 0u) { xcd_barrier_complete(bar, b.x, nloc, nx); b.nloc = nloc; b.nx = nx; }
        const unsigned old = xb_add(&bar[XB_XSUB(b.x)], 1u);
        const unsigned gen = old / nloc;
        if (old + 1u == (gen + 1u) * nloc) {
            __builtin_amdgcn_fence(__ATOMIC_RELEASE, "agent");
            asm volatile("s_waitcnt vmcnt(0)" ::: "memory");
            const unsigned og = xb_add(&bar[XB_TOP], 1u);
            const unsigned tg = og / nx;
            if (og + 1u == (tg + 1u) * nx) xb_add(&bar[XB_TOPGEN], 1u);
            else XB_SPIN(xb_ld(&bar[XB_TOPGEN]) == tg, bar);
            __builtin_amdgcn_fence(__ATOMIC_ACQUIRE, "agent");
            xb_add(&bar[XB_XGEN(b.x)], 1u);
            asm volatile("s_waitcnt vmcnt(0)" ::: "memory");
        } else {
            XB_SPIN(xb_ld(&bar[XB_XGEN(b.x)]) == gen, bar);
            __builtin_amdgcn_fence(__ATOMIC_ACQUIRE, "agent");
            asm volatile("s_waitcnt vmcnt(0)" ::: "memory");
        }
    }
    __syncthreads();
}

struct Args { const float* in[26]; float* out; unsigned char* ws; int ph_lo, ph_hi; };
enum { I_X = 0, I_C, I_WADA, I_BADA, I_GMIX, I_WIN, I_ARE, I_AIM, I_LOGDT, I_BRE, I_BIM, I_CRE, I_CIM, I_SSMD, I_WGLU, I_BGLU, I_RPB,
       I_GSSM, I_GATT, I_WOUT, I_GFFN, I_WROUTER, I_WGATE, I_WUP, I_WDOWN, I_GFINAL };

struct ARows { const bf16_t* base; size_t ld; __device__ __forceinline__ const bf16_t* ptr(int r) const { return base + (size_t)r * ld; }
    __device__ __forceinline__ unsigned off(int r) const { return (unsigned)r * (unsigned)ld; } };
struct AGather { const bf16_t* base; const int* idx; int e;
    __device__ __forceinline__ const bf16_t* ptr(int r) const { const int b = r >> 8; return base + (size_t)(b * SEQ + idx[(b * NE + e) * CAP + (r & 255)]) * DM; }
    __device__ __forceinline__ unsigned off(int r) const { const int b = r >> 8; return (unsigned)(b * SEQ + idx[(b * NE + e) * CAP + (r & 255)]) * (unsigned)DM; } };
struct BF32 { const float* base; size_t ld; __device__ __forceinline__ float get(int k, int n) const { return base[(size_t)k * ld + n]; }
    __device__ __forceinline__ float get2(int, int) const { return 0.f; } };
struct BF32Dual { const float* g; const float* u; size_t ld; __device__ __forceinline__ float get(int k, int n) const { return g[(size_t)k * ld + n]; }
    __device__ __forceinline__ float get2(int k, int n) const { return u[(size_t)k * ld + n]; } };

struct EpiInProj { bf16_t* UX; bf16_t* Q; bf16_t* K; bf16_t* V;
    __device__ __forceinline__ void store(int t, int n, float v) const {
        if (n < 1024) { const int g = n >> 4, h = n & 15, b = t >> 11, l = t & 2047; UX[(size_t)(g * 512 + b * 128 + (l >> 4)) * 512 + (l & 15) * 16 + h] = f2bf(v); }
        else if (n < 2048) Q[(size_t)t * 1024 + (n - 1024)] = f2bf(v * 0.125f);
        else if (n < 3072) K[(size_t)t * 1024 + (n - 2048)] = f2bf(v);
        else V[(size_t)t * 1024 + (n - 3072)] = f2bf(v);
    }
    __device__ __forceinline__ void store2(int, int, float, float) const {}
    __device__ __forceinline__ void store4(int t, int n, f32x4 v) const {
        u32x2 w;
        if (n < 1024) { const int g = n >> 4, h = n & 15, b = t >> 11, l = t & 2047; w.x = pack2(v[0], v[1]); w.y = pack2(v[2], v[3]);
            *(u32x2*)(UX + (size_t)(g * 512 + b * 128 + (l >> 4)) * 512 + (l & 15) * 16 + h) = w; }
        else if (n < 2048) { w.x = pack2(v[0] * 0.125f, v[1] * 0.125f); w.y = pack2(v[2] * 0.125f, v[3] * 0.125f); *(u32x2*)(Q + (size_t)t * 1024 + (n - 1024)) = w; }
        else if (n < 3072) { w.x = pack2(v[0], v[1]); w.y = pack2(v[2], v[3]); *(u32x2*)(K + (size_t)t * 1024 + (n - 2048)) = w; }
        else { w.x = pack2(v[0], v[1]); w.y = pack2(v[2], v[3]); *(u32x2*)(V + (size_t)t * 1024 + (n - 3072)) = w; }
    } };
struct EpiGlu { const bf16_t* Z; const float* bglu; bf16_t* Y;
    __device__ __forceinline__ void store(int t, int n, float v) const { const float gate = v + bglu[n]; const float z = bf2f(Z[(size_t)t * 1024 + n]); Y[(size_t)t * 1024 + n] = f2bf(z * sigmoid_f(gate)); }
    __device__ __forceinline__ void store2(int, int, float, float) const {}
    __device__ __forceinline__ void store4(int t, int n, f32x4 v) const {
        const f32x4 bb = *(const f32x4*)(bglu + n); const u32x2 zw = *(const u32x2*)(Z + (size_t)t * 1024 + n);
        u32x2 w; w.x = pack2(bflo(zw.x) * sigmoid_f(v[0] + bb[0]), bfhi(zw.x) * sigmoid_f(v[1] + bb[1])); w.y = pack2(bflo(zw.y) * sigmoid_f(v[2] + bb[2]), bfhi(zw.y) * sigmoid_f(v[3] + bb[3]));
        *(u32x2*)(Y + (size_t)t * 1024 + n) = w; } };
struct EpiOut { const float* x; const float* mod; float* X1;
    __device__ __forceinline__ void store(int t, int n, float v) const { const int b = t >> 11; X1[(size_t)t * DM + n] = x[(size_t)t * DM + n] + mod[b * 12288 + 4096 + n] * v; }
    __device__ __forceinline__ void store2(int, int, float, float) const {}
    __device__ __forceinline__ void store4(int t, int n, f32x4 v) const { const int b = t >> 11;
        const f32x4 xv = *(const f32x4*)(x + (size_t)t * DM + n), gt = *(const f32x4*)(mod + b * 12288 + 4096 + n);
        *(f32x4*)(X1 + (size_t)t * DM + n) = xv + gt * v; } };
struct EpiMoe1 { bf16_t* HID;
    __device__ __forceinline__ void store(int, int, float) const {}
    __device__ __forceinline__ void store2(int r, int n, float g, float u) const { HID[(size_t)r * DFF + n] = f2bf(silu_f(g) * u); }
    __device__ __forceinline__ void store4d(int r, int n, f32x4 g, f32x4 u) const { u32x2 w; w.x = pack2(silu_f(g[0]) * u[0], silu_f(g[1]) * u[1]); w.y = pack2(silu_f(g[2]) * u[2], silu_f(g[3]) * u[3]);
        *(u32x2*)(HID + (size_t)r * DFF + n) = w; } };
struct EpiMoe2 { bf16_t* YE; const float* waff; int e;
    __device__ __forceinline__ void store(int r, int n, float v) const { const int b = r >> 8; YE[(size_t)r * DM + n] = f2bf(v * waff[(b * NE + e) * CAP + (r & 255)]); }
    __device__ __forceinline__ void store2(int, int, float, float) const {}
    __device__ __forceinline__ void store4(int r, int n, f32x4 v) const { const int b = r >> 8; const float a = waff[(b * NE + e) * CAP + (r & 255)];
        u32x2 w; w.x = pack2(v[0] * a, v[1] * a); w.y = pack2(v[2] * a, v[3] * a); *(u32x2*)(YE + (size_t)r * DM + n) = w; } };

template <class AF, class BF, class EF, bool DUAL>
__device__ __forceinline__ void gemm_naive_tile(float* lds, const AF& A, const BF& Bm, const EF& E, int m0, int n0, int K) {
    float* As = lds;
    float* Bs = lds + 16 * 132;
    float* Bs2 = Bs + 16 * 68;
    float acc[4][4], acc2[4][4];
#pragma unroll
    for (int i = 0; i < 4; ++i)
#pragma unroll
        for (int j = 0; j < 4; ++j) { acc[i][j] = 0.f; acc2[i][j] = 0.f; }
    const int tid = threadIdx.x, tm = tid >> 4, tn = tid & 15;
    const int ar = tid >> 2, ak = (tid & 3) * 4;
    const bf16_t* ap = A.ptr(m0 + ar);
    const int bk = tid >> 5, bc = (tid & 31) * 2;
    for (int k0 = 0; k0 < K; k0 += 16) {
        const u32x2 av = *(const u32x2*)(ap + k0 + ak);
        As[(ak + 0) * 132 + ar] = bflo(av.x); As[(ak + 1) * 132 + ar] = bfhi(av.x); As[(ak + 2) * 132 + ar] = bflo(av.y); As[(ak + 3) * 132 + ar] = bfhi(av.y);
        Bs[bk * 68 + bc] = Bm.get(k0 + bk, n0 + bc); Bs[bk * 68 + bc + 1] = Bm.get(k0 + bk, n0 + bc + 1);
        if (DUAL) { Bs2[bk * 68 + bc] = Bm.get2(k0 + bk, n0 + bc); Bs2[bk * 68 + bc + 1] = Bm.get2(k0 + bk, n0 + bc + 1); }
        __syncthreads();
#pragma unroll
        for (int kk = 0; kk < 16; ++kk) {
            const f32x4 a4 = *(const f32x4*)(As + kk * 132 + tm * 4);
            const f32x4 b4 = *(const f32x4*)(Bs + kk * 68 + tn * 4);
#pragma unroll
            for (int i = 0; i < 4; ++i)
#pragma unroll
                for (int j = 0; j < 4; ++j) acc[i][j] += a4[i] * b4[j];
            if (DUAL) {
                const f32x4 c4 = *(const f32x4*)(Bs2 + kk * 68 + tn * 4);
#pragma unroll
                for (int i = 0; i < 4; ++i)
#pragma unroll
                    for (int j = 0; j < 4; ++j) acc2[i][j] += a4[i] * c4[j];
            }
        }
        __syncthreads();
    }
#pragma unroll
    for (int i = 0; i < 4; ++i)
#pragma unroll
        for (int j = 0; j < 4; ++j) { if (DUAL) E.store2(m0 + tm * 4 + i, n0 + tn * 4 + j, acc[i][j], acc2[i][j]); else E.store(m0 + tm * 4 + i, n0 + tn * 4 + j, acc[i][j]); }
}

struct Frame {
    const float* in[26]; float* out; unsigned char* ws; unsigned char* lds;
    int tid, lane, wave, G, bid;
    __device__ __forceinline__ float* modp() const { return (float*)(ws + WS_MOD); }
};

__device__ __forceinline__ void p_ada(const Frame& F) {
    float* sc = (float*)F.lds;
    float* red = sc + 4 * 2048;
    const float* c = F.in[I_C]; const float* w = F.in[I_WADA]; const float* bias = F.in[I_BADA];
    for (int i = F.tid; i < 4 * 2048; i += NT) sc[i] = silu_f(c[i]);
    __syncthreads();
    const int cq = F.tid & 15, kq = F.tid >> 4;
    for (int u = F.bid; u < 192; u += F.G) {
        const int n0 = u * 64 + cq * 4;
        float acc[4][4];
#pragma unroll
        for (int b = 0; b < 4; ++b)
#pragma unroll
            for (int j = 0; j < 4; ++j) acc[b][j] = 0.f;
        for (int k0 = kq; k0 < 2048; k0 += 256) {
            f32x4 wv[8];
#pragma unroll
            for (int q = 0; q < 8; ++q) wv[q] = __builtin_nontemporal_load((const f32x4*)(w + (size_t)(k0 + 32 * q) * 12288 + n0));
#pragma unroll
            for (int q = 0; q < 8; ++q)
#pragma unroll
                for (int b = 0; b < 4; ++b) { const float s = sc[b * 2048 + k0 + 32 * q];
#pragma unroll
                    for (int j = 0; j < 4; ++j) acc[b][j] += s * wv[q][j]; }
        }
#pragma unroll
        for (int b = 0; b < 4; ++b)
#pragma unroll
            for (int j = 0; j < 4; ++j) red[(kq * 16 + cq) * 16 + b * 4 + j] = acc[b][j];
        __syncthreads();
        if (F.tid < 256) {
            const int b = F.tid >> 6, col = F.tid & 63;
            float s = 0.f;
            for (int q = 0; q < 32; ++q) s += red[(q * 16 + (col >> 2)) * 16 + b * 4 + (col & 3)];
            F.modp()[b * 12288 + u * 64 + col] = s + bias[u * 64 + col];
        }
        __syncthreads();
    }
}

__device__ __forceinline__ void p_h1(const Frame& F) {
    const float* x = F.in[I_X]; const float* g = F.in[I_GMIX]; const float* mod = F.modp(); bf16_t* H1 = (bf16_t*)(F.ws + WS_H1);
    for (int t = F.bid * 8 + F.wave; t < TOK; t += F.G * 8) {
        const int b = t >> 11; const float* xr = x + (size_t)t * DM;
        f32x4 v[8]; float ss = 0.f;
#pragma unroll
        for (int i = 0; i < 8; ++i) { v[i] = *(const f32x4*)(xr + i * 256 + F.lane * 4); ss += v[i][0] * v[i][0] + v[i][1] * v[i][1] + v[i][2] * v[i][2] + v[i][3] * v[i][3]; }
        ss = wave_sum(ss);
        const float rstd = rsqrtf(ss * (1.0f / DM) + EPS);
#pragma unroll
        for (int i = 0; i < 8; ++i) { const int k = i * 256 + F.lane * 4;
            const f32x4 gv = *(const f32x4*)(g + k), sh = *(const f32x4*)(mod + b * 12288 + k), sc = *(const f32x4*)(mod + b * 12288 + 2048 + k);
            float o[4];
#pragma unroll
            for (int j = 0; j < 4; ++j) o[j] = (v[i][j] * rstd * gv[j]) * (1.0f + sc[j]) + sh[j];
            u32x2 w; w.x = pack2(o[0], o[1]); w.y = pack2(o[2], o[3]);
            *(u32x2*)(H1 + (size_t)t * DM + k) = w; }
    }
}

__device__ __forceinline__ void p_inproj_naive(const Frame& F) {
    const ARows A{(const bf16_t*)(F.ws + WS_H1), DM}; const BF32 Bm{F.in[I_WIN], DINP};
    const EpiInProj E{(bf16_t*)(F.ws + WS_UX), (bf16_t*)(F.ws + WS_Q), (bf16_t*)(F.ws + WS_K), (bf16_t*)(F.ws + WS_V)};
    const int nM = TOK / 128, nN = DINP / 64;
    for (int u = F.bid; u < nM * nN; u += F.G) gemm_naive_tile<ARows, BF32, EpiInProj, false>((float*)F.lds, A, Bm, E, (u / nN) * 128, (u % nN) * 64, DM);
}
__device__ __forceinline__ void p_glu_naive(const Frame& F) {
    const ARows A{(const bf16_t*)(F.ws + WS_ZB), 1024}; const BF32 Bm{F.in[I_WGLU], 1024};
    const EpiGlu E{(const bf16_t*)(F.ws + WS_ZB), F.in[I_BGLU], (bf16_t*)(F.ws + WS_YSSM)};
    const int nM = TOK / 128, nN = 1024 / 64;
    for (int u = F.bid; u < nM * nN; u += F.G) gemm_naive_tile<ARows, BF32, EpiGlu, false>((float*)F.lds, A, Bm, E, (u / nN) * 128, (u % nN) * 64, 1024);
}
__device__ __forceinline__ void p_outproj_naive(const Frame& F) {
    const ARows A{(const bf16_t*)(F.ws + WS_MIX), DM}; const BF32 Bm{F.in[I_WOUT], DM};
    const EpiOut E{F.in[I_X], F.modp(), (float*)(F.ws + WS_X1)};
    const int nM = TOK / 128, nN = DM / 64;
    for (int u = F.bid; u < nM * nN; u += F.G) gemm_naive_tile<ARows, BF32, EpiOut, false>((float*)F.lds, A, Bm, E, (u / nN) * 128, (u % nN) * 64, DM);
}
__device__ __forceinline__ void p_moe1_naive(const Frame& F) {
    const int nM = 1024 / 128, nN = DFF / 64;
    for (int u = F.bid; u < NE * nM * nN; u += F.G) {
        const int e = u / (nM * nN), r = u % (nM * nN);
        const AGather A{(const bf16_t*)(F.ws + WS_H2), (const int*)(F.ws + WS_IDX), e};
        const BF32Dual Bm{F.in[I_WGATE] + (size_t)e * DM * DFF, F.in[I_WUP] + (size_t)e * DM * DFF, DFF};
        const EpiMoe1 E{(bf16_t*)(F.ws + WS_HID) + (size_t)e * 1024 * DFF};
        gemm_naive_tile<AGather, BF32Dual, EpiMoe1, true>((float*)F.lds, A, Bm, E, (r / nN) * 128, (r % nN) * 64, DM);
    }
}
__device__ __forceinline__ void p_moe2_naive(const Frame& F) {
    const int nM = 1024 / 128, nN = DM / 64;
    for (int u = F.bid; u < NE * nM * nN; u += F.G) {
        const int e = u / (nM * nN), r = u % (nM * nN);
        const ARows A{(const bf16_t*)(F.ws + WS_HID) + (size_t)e * 1024 * DFF, DFF};
        const BF32 Bm{F.in[I_WDOWN] + (size_t)e * DFF * DM, DM};
        const EpiMoe2 E{(bf16_t*)(F.ws + WS_YE) + (size_t)e * 1024 * DM, (const float*)(F.ws + WS_WAFF), e};
        gemm_naive_tile<ARows, BF32, EpiMoe2, false>((float*)F.lds, A, Bm, E, (r / nN) * 128, (r % nN) * 64, DFF);
    }
}

__host__ __device__ __forceinline__ int lds_byte(int r, int c) { const int st = (r >> 4) * 2 + (c >> 5), rr = r & 15, cc = c & 31, ob = rr * 64 + cc * 2; return st * 1024 + (ob ^ (((ob >> 9) & 1) << 5)); }
__host__ __device__ __forceinline__ void stage_rc(int b, int& R, int& C) { const int st = b / 1024, sb = b % 1024, swz = sb ^ (((sb >> 9) & 1) << 5); R = (st >> 1) * 16 + swz / 64; C = (st & 1) * 32 + (swz % 64) / 2; }

struct BLF32 {
    const float* base; unsigned ld; static constexpr int NL = 8;
    unsigned loff, bw0, bw1; int wid;
    __device__ __forceinline__ void init(int lane, int wid_) { wid = wid_; loff = (unsigned)lane * 16u; bw0 = (unsigned)(wid * 512 + ((8 * lane) ^ ((wid & 3) * 32))); bw1 = bw0 ^ 128u; }
    __device__ __forceinline__ void load(int kt, f32x4 (&r)[8]) const {
#pragma unroll
        for (int i = 0; i < 8; ++i) { const char* rowb = (const char*)(base + (size_t)(kt * 64 + wid + 8 * i) * ld); r[i] = *(const f32x4*)(rowb + loff); } }
    __device__ __forceinline__ void write(LAS unsigned char* st, const f32x4 (&r)[8]) const {
#pragma unroll
        for (int i = 0; i < 8; ++i) { u32x2 w; w.x = pack2(r[i][0], r[i][1]); w.y = pack2(r[i][2], r[i][3]); *(LAS u32x2*)(st + ((i & 1) ? bw1 : bw0) + i * 4096) = w; } }
};
struct BLF32Dual {
    const float* g; const float* u; unsigned ld; static constexpr int NL = 8;
    unsigned loff, bw0, bw1; int wid;
    __device__ __forceinline__ void init(int lane, int wid_) { wid = wid_; loff = (unsigned)(lane >> 5) * ld * 4u + (unsigned)(lane & 31) * 16u;
        const int k = 2 * wid + (lane >> 5), slot = (k & 3) | ((k >> 1) & 4), x = 4 * (lane & 31), c = (x >> 5) * 64 + ((x >> 4) & 1) * 16 + (x & 15);
        bw0 = (unsigned)(k * 512 + ((2 * c) ^ (slot * 32))); bw1 = bw0 ^ 64u; }
    __device__ __forceinline__ void load(int kt, f32x4 (&r)[8]) const {
#pragma unroll
        for (int i = 0; i < 8; ++i) { const char* rowb = (const char*)(((i >> 2) ? u : g) + (size_t)(kt * 64 + 2 * wid + 16 * (i & 3)) * ld); r[i] = *(const f32x4*)(rowb + loff); } }
    __device__ __forceinline__ void write(LAS unsigned char* st, const f32x4 (&r)[8]) const {
#pragma unroll
        for (int i = 0; i < 8; ++i) { u32x2 w; w.x = pack2(r[i][0], r[i][1]); w.y = pack2(r[i][2], r[i][3]); *(LAS u32x2*)(st + ((i >> 2) ? bw1 : bw0) + (i & 3) * 8192) = w; } }
};
struct BLBf16 {
    const bf16_t* base; unsigned ld; static constexpr int NL = 4;
    unsigned loff, bw0; int wid;
    __device__ __forceinline__ void init(int lane, int wid_) { wid = wid_; loff = (unsigned)(lane >> 5) * ld * 2u + (unsigned)(lane & 31) * 16u;
        const int k = 2 * wid + (lane >> 5), slot = (k & 3) | ((k >> 1) & 4); bw0 = (unsigned)(k * 512 + ((16 * (lane & 31)) ^ (slot * 32))); }
    __device__ __forceinline__ void load(int kt, f32x4 (&r)[8]) const {
#pragma unroll
        for (int i = 0; i < 4; ++i) { const char* rowb = (const char*)(base + (size_t)(kt * 64 + 2 * wid + 16 * i) * ld); r[i] = *(const f32x4*)(rowb + loff); } }
    __device__ __forceinline__ void write(LAS unsigned char* st, const f32x4 (&r)[8]) const {
#pragma unroll
        for (int i = 0; i < 4; ++i) *(LAS f32x4*)(st + bw0 + i * 8192) = r[i]; }
};

__device__ __forceinline__ void glds16(const void* sbase, unsigned voff, unsigned lds_dst) {
    unsigned keep;
    asm volatile("s_nop 4\n\ts_mov_b32 %0, m0\n\ts_mov_b32 m0, %3\n\ts_nop 0\n\tglobal_load_lds_dwordx4 %1, %2\n\ts_mov_b32 m0, %0" : "=&s"(keep) : "v"(voff), "s"(sbase), "s"(lds_dst) : "memory");
}

template <class AF, class BL, class EF, bool DUAL>
__device__ __forceinline__ void gemm_mfma_tile(unsigned char* ldsg, const AF& A, BL Bl, const EF& E, int m0, int n0, int K) {
    LAS unsigned char* lds = (LAS unsigned char*)ldsg;
    const unsigned lds0 = (unsigned)(uintptr_t)lds;
    const int tid = threadIdx.x, lane = tid & 63, wid = __builtin_amdgcn_readfirstlane(tid >> 6), wr = wid >> 2, wc = wid & 3, fr = lane & 15, fq = lane >> 4;
    const int nt = K / 64;
    const bf16_t* abase = A.base;
    unsigned aso[2][2];
#pragma unroll
    for (int h = 0; h < 2; ++h)
#pragma unroll
        for (int i = 0; i < 2; ++i) { int R, C; stage_rc(tid * 16 + i * 8192, R, C); aso[h][i] = (A.off(m0 + h * 128 + R) + (unsigned)C) * 2u; }
    Bl.init(lane, wid);
    const unsigned aoff = (unsigned)(wr * 16384 + lds_byte(fr, fq * 8));
    unsigned boffn[4];
    { const int G = fq, q = fr >> 2, p = fr & 3, slot = q | ((G & 1) << 2);
#pragma unroll
      for (int ni = 0; ni < 4; ++ni) boffn[ni] = (unsigned)((8 * G + q) * 512 + (((wc * 128 + ni * 32) ^ (slot * 32)) + 8 * p)); }
    f32x4 acc[8][4];
#pragma unroll
    for (int mi = 0; mi < 8; ++mi)
#pragma unroll
        for (int ni = 0; ni < 4; ++ni) acc[mi][ni] = (f32x4){0.f, 0.f, 0.f, 0.f};

#define GM_STAGE_A(s, kt) do { _Pragma("unroll") for (int h_ = 0; h_ < 2; ++h_) _Pragma("unroll") for (int i_ = 0; i_ < 2; ++i_) \
        glds16(abase, aso[h_][i_] + (unsigned)(kt) * 128u, lds0 + (unsigned)((s) * 32768 + h_ * 16384 + i_ * 8192 + wid * 1024)); } while (0)
    f32x4 breg[8];

    GM_STAGE_A(0, 0); Bl.load(0, breg); Bl.write(lds + 65536, breg);
    asm volatile("s_waitcnt vmcnt(0)" ::: "memory");
    __syncthreads();
    for (int t = 0; t < nt; ++t) {
        const int cur = t & 1;
        if (t + 1 < nt) { GM_STAGE_A(cur ^ 1, t + 1); Bl.load(t + 1, breg); }
        LAS unsigned char* sa = lds + cur * 32768 + aoff;
        LAS unsigned char* sb = lds + 65536 + cur * 32768;
#pragma unroll
        for (int ks = 0; ks < 2; ++ks) {
            bf16x8 bf[4], af[8];
#pragma unroll
            for (int ni = 0; ni < 4; ++ni) {
                const s16x4 lo = __builtin_amdgcn_ds_read_tr16_b64_v4i16((LAS s16x4*)(sb + boffn[ni] + (ks * 32) * 512));
                const s16x4 hi = __builtin_amdgcn_ds_read_tr16_b64_v4i16((LAS s16x4*)(sb + boffn[ni] + (ks * 32 + 4) * 512));
                bf[ni] = (bf16x8){lo[0], lo[1], lo[2], lo[3], hi[0], hi[1], hi[2], hi[3]};
            }
#pragma unroll
            for (int mi = 0; mi < 8; ++mi) af[mi] = *(const LAS bf16x8*)(sa + mi * 2048 + ks * 1024);
#pragma unroll
            for (int mi = 0; mi < 8; ++mi)
#pragma unroll
                for (int ni = 0; ni < 4; ++ni) acc[mi][ni] = __builtin_amdgcn_mfma_f32_16x16x32_bf16(bf[ni], af[mi], acc[mi][ni], 0, 0, 0);
            if (ks == 0) __builtin_amdgcn_sched_group_barrier(0x020, 8, 0);
            __builtin_amdgcn_sched_group_barrier(0x100, 10, 0);
#pragma unroll
            for (int mi = 0; mi < 6; ++mi) { __builtin_amdgcn_sched_group_barrier(0x008, 4, 0); __builtin_amdgcn_sched_group_barrier(0x100, 1, 0); }
            __builtin_amdgcn_sched_group_barrier(0x008, 8, 0);
            __builtin_amdgcn_sched_barrier(0);
        }
        if (t + 1 < nt) { Bl.write(lds + 65536 + (cur ^ 1) * 32768, breg); }
        asm volatile("s_waitcnt vmcnt(0)" ::: "memory");
        __syncthreads();
    }
#undef GM_STAGE_A
    int fr2 = fr, fq2 = fq; asm volatile("" : "+v"(fr2), "+v"(fq2));
#pragma unroll
    for (int mi = 0; mi < 8; ++mi) {
        const int row = m0 + wr * 128 + mi * 16 + fr2;
        if constexpr (DUAL) {
#pragma unroll
            for (int ni = 0; ni < 2; ++ni) E.store4d(row, n0 + wc * 32 + ni * 16 + 4 * fq2, acc[mi][ni], acc[mi][ni + 2]);
        } else {
#pragma unroll
            for (int ni = 0; ni < 4; ++ni) E.store4(row, n0 + wc * 64 + ni * 16 + 4 * fq2, acc[mi][ni]);
        }
    }
}

__device__ __forceinline__ void gload16_asm(f32x4& dst, const void* sbase, unsigned voff) { asm volatile("global_load_dwordx4 %0, %1, %2" : "=v"(dst) : "v"(voff), "s"(sbase)); }
template <int N> __device__ __forceinline__ void wait_vm1(f32x4& r) { asm volatile("s_waitcnt vmcnt(%1)" : "+v"(r) : "n"(N)); }
template <int N> __device__ __forceinline__ void wait_vm8(f32x4 (&r)[8]) { asm volatile("s_waitcnt vmcnt(%8)" : "+v"(r[0]), "+v"(r[1]), "+v"(r[2]), "+v"(r[3]), "+v"(r[4]), "+v"(r[5]), "+v"(r[6]), "+v"(r[7]) : "n"(N)); }
__device__ __forceinline__ void glds16n(const void* sbase, unsigned voff, unsigned lds_dst) {
    unsigned keep;
    asm volatile("s_mov_b32 %0, m0\n\ts_mov_b32 m0, %3\n\ts_nop 0\n\tglobal_load_lds_dwordx4 %1, %2\n\ts_mov_b32 m0, %0" : "=&s"(keep) : "v"(voff), "s"(sbase), "s"(lds_dst));
}
struct B2F32 {
    const float* base; unsigned ld; static constexpr int NL = 8;
    unsigned loff, bw0, bw1; int wid;
    __device__ __forceinline__ void init(int lane, int wid_) { wid = wid_; loff = (unsigned)lane * 16u; bw0 = (unsigned)(wid * 512 + ((8 * lane) ^ ((wid & 3) * 32))); bw1 = bw0 ^ 128u; }
    __device__ __forceinline__ void issue(int kt, int i, f32x4& r) const { gload16_asm(r, base + (size_t)(kt * 64 + wid + 8 * i) * ld, loff); }
    __device__ __forceinline__ void write1(LAS unsigned char* st, int i, const f32x4& r) const { u32x2 w; w.x = pack2(r[0], r[1]); w.y = pack2(r[2], r[3]); *(LAS u32x2*)(st + ((i & 1) ? bw1 : bw0) + i * 4096) = w; }
};
struct B2F32Dual {
    const float* g; const float* u; unsigned ld; static constexpr int NL = 8;
    unsigned loff, bw0, bw1; int wid;
    __device__ __forceinline__ void init(int lane, int wid_) { wid = wid_; loff = (unsigned)(lane >> 5) * ld * 4u + (unsigned)(lane & 31) * 16u;
        const int k = 2 * wid + (lane >> 5), slot = (k & 3) | ((k >> 1) & 4), x = 4 * (lane & 31), c = (x >> 5) * 64 + ((x >> 4) & 1) * 16 + (x & 15);
        bw0 = (unsigned)(k * 512 + ((2 * c) ^ (slot * 32))); bw1 = bw0 ^ 64u; }
    __device__ __forceinline__ void issue(int kt, int i, f32x4& r) const { gload16_asm(r, ((i >> 2) ? u : g) + (size_t)(kt * 64 + 2 * wid + 16 * (i & 3)) * ld, loff); }
    __device__ __forceinline__ void write1(LAS unsigned char* st, int i, const f32x4& r) const { u32x2 w; w.x = pack2(r[0], r[1]); w.y = pack2(r[2], r[3]); *(LAS u32x2*)(st + ((i >> 2) ? bw1 : bw0) + (i & 3) * 8192) = w; }
};
struct B2Bf16 {
    const bf16_t* base; unsigned ld; static constexpr int NL = 4;
    unsigned loff, bw0; int wid;
    __device__ __forceinline__ void init(int lane, int wid_) { wid = wid_; loff = (unsigned)(lane >> 5) * ld * 2u + (unsigned)(lane & 31) * 16u;
        const int k = 2 * wid + (lane >> 5), slot = (k & 3) | ((k >> 1) & 4); bw0 = (unsigned)(k * 512 + ((16 * (lane & 31)) ^ (slot * 32))); }
    __device__ __forceinline__ void issue(int kt, int i, f32x4& r) const { gload16_asm(r, base + (size_t)(kt * 64 + 2 * wid + 16 * i) * ld, loff); }
    __device__ __forceinline__ void write1(LAS unsigned char* st, int i, const f32x4& r) const { *(LAS f32x4*)(st + bw0 + i * 8192) = r; }
};

template <class AF, class BL, class EF, bool DUAL>
__device__ __forceinline__ void gemm_tile2(unsigned char* ldsg, const AF& A, BL Bl, const EF& E, int m0, int n0, int K) {
    LAS unsigned char* lds = (LAS unsigned char*)ldsg;
    const unsigned lds0 = (unsigned)(uintptr_t)lds;
    const int tid = threadIdx.x, lane = tid & 63, wid = __builtin_amdgcn_readfirstlane(tid >> 6), wr = wid >> 2, wc = wid & 3, fr = lane & 15, fq = lane >> 4;
    const int nt = K / 64;
    constexpr int NL = BL::NL;
    const bf16_t* abase = A.base;
    unsigned aso[2][2];
#pragma unroll
    for (int h = 0; h < 2; ++h)
#pragma unroll
        for (int i = 0; i < 2; ++i) { int R, C; stage_rc(tid * 16 + i * 8192, R, C); aso[h][i] = (A.off(m0 + h * 128 + R) + (unsigned)C) * 2u; }
    Bl.init(lane, wid);
    const unsigned aoff = (unsigned)(wr * 16384 + lds_byte(fr, fq * 8));
    unsigned boffn[4];
    { const int G = fq, q = fr >> 2, p = fr & 3, slot = q | ((G & 1) << 2);
#pragma unroll
      for (int ni = 0; ni < 4; ++ni) boffn[ni] = (unsigned)((8 * G + q) * 512 + (((wc * 128 + ni * 32) ^ (slot * 32)) + 8 * p)); }
    f32x4 acc[8][4];
#pragma unroll
    for (int mi = 0; mi < 8; ++mi)
#pragma unroll
        for (int ni = 0; ni < 4; ++ni) acc[mi][ni] = (f32x4){0.f, 0.f, 0.f, 0.f};
    f32x4 breg[8];
#define G2_DMA(piece, soff, kt) glds16n(abase, aso[(piece) >> 1][(piece) & 1] + (unsigned)(kt) * 128u, lds0 + (unsigned)(soff) + (unsigned)(((piece) >> 1) * 16384 + ((piece) & 1) * 8192 + wid * 1024))
#define G2_RDB(dst, sbp, ni, ks) do { const s16x4 lo_ = __builtin_amdgcn_ds_read_tr16_b64_v4i16((LAS s16x4*)((sbp) + boffn[ni] + ((ks) * 32) * 512)); \
        const s16x4 hi_ = __builtin_amdgcn_ds_read_tr16_b64_v4i16((LAS s16x4*)((sbp) + boffn[ni] + ((ks) * 32 + 4) * 512)); \
        dst = (bf16x8){lo_[0], lo_[1], lo_[2], lo_[3], hi_[0], hi_[1], hi_[2], hi_[3]}; } while (0)
#define G2_RDA(sap, mi, ks) (*(const LAS bf16x8*)((sap) + (mi) * 2048 + (ks) * 1024))
#define G2_MMA(mi, afr, bfr) do { _Pragma("unroll") for (int ni_ = 0; ni_ < 4; ++ni_) acc[mi][ni_] = __builtin_amdgcn_mfma_f32_16x16x32_bf16(bfr[ni_], afr, acc[mi][ni_], 0, 0, 0); } while (0)
#pragma unroll
    for (int p = 0; p < 4; ++p) G2_DMA(p, 0, 0);
#pragma unroll
    for (int i = 0; i < NL; ++i) Bl.issue(0, i, breg[i]);
#pragma unroll
    for (int p = 0; p < 4; ++p) G2_DMA(p, 32768, 1);
    wait_vm8<4>(breg);
#pragma unroll
    for (int i = 0; i < NL; ++i) Bl.write1(lds + 98304, i, breg[i]);
#pragma unroll
    for (int i = 0; i < NL; ++i) Bl.issue(1, i, breg[i]);
    asm volatile("s_waitcnt lgkmcnt(0)" ::: "memory"); __builtin_amdgcn_s_barrier(); asm volatile("" ::: "memory");
    int sa_cur = 0, sa_nn = 65536;
#define G2_S0(MODE, t, mi) do { \
            if ((mi) + 2 < 8) a_[(mi) + 2] = G2_RDA(sap, (mi) + 2, 0); else a_[(mi) + 2] = G2_RDA(sap, (mi) - 6, 1); \
            if ((mi) >= 4) G2_RDB(b1[((mi) - 4) & 3], sbp, ((mi) - 4) & 3, 1); \
            if (MODE == 0 && (mi) < 4) G2_DMA((mi) & 3, sa_nn, (t) + 2); \
            G2_MMA(mi, a_[mi], b0); \
            __builtin_amdgcn_sched_barrier(0); } while (0)
#define G2_S1(MODE, t, mi) do { \
            if ((mi) + 2 < 8) a_[(mi) + 2] = G2_RDA(sap, (mi) + 2, 1); \
            if (MODE <= 1 && (mi) < NL) { if (MODE == 0) wait_vm1<NL + 3>(breg[mi]); else wait_vm1<((NL - 1 - (mi)) > 0 ? (NL - 1 - (mi)) : 0)>(breg[mi]); \
                Bl.write1(sbn, mi, breg[mi]); if (MODE == 0) Bl.issue((t) + 2, mi, breg[mi]); } \
            G2_MMA(mi, a_[mi], b1); \
            __builtin_amdgcn_sched_barrier(0); } while (0)
#define G2_KTILE(MODE, t) do { \
        LAS unsigned char* sap = lds + sa_cur + aoff; LAS unsigned char* sbp = lds + 98304 + ((t) & 1) * 32768; LAS unsigned char* sbn = lds + 98304 + (((t) + 1) & 1) * 32768; \
        bf16x8 b0[4], b1[4], a_[10]; \
        G2_RDB(b0[0], sbp, 0, 0); G2_RDB(b0[1], sbp, 1, 0); G2_RDB(b0[2], sbp, 2, 0); G2_RDB(b0[3], sbp, 3, 0); \
        a_[0] = G2_RDA(sap, 0, 0); a_[1] = G2_RDA(sap, 1, 0); \
        G2_S0(MODE, t, 0); G2_S0(MODE, t, 1); G2_S0(MODE, t, 2); G2_S0(MODE, t, 3); G2_S0(MODE, t, 4); G2_S0(MODE, t, 5); G2_S0(MODE, t, 6); G2_S0(MODE, t, 7); \
        a_[0] = a_[8]; a_[1] = a_[9]; \
        G2_S1(MODE, t, 0); G2_S1(MODE, t, 1); G2_S1(MODE, t, 2); G2_S1(MODE, t, 3); G2_S1(MODE, t, 4); G2_S1(MODE, t, 5); G2_S1(MODE, t, 6); G2_S1(MODE, t, 7); \
        asm volatile("s_waitcnt lgkmcnt(0)" ::: "memory"); __builtin_amdgcn_s_barrier(); asm volatile("" ::: "memory"); \
        sa_cur = (sa_cur == 65536) ? 0 : sa_cur + 32768; sa_nn = (sa_nn == 65536) ? 0 : sa_nn + 32768; } while (0)
    int t = 0;
    for (; t < nt - 2; ++t) G2_KTILE(0, t);
    G2_KTILE(1, t); ++t;
    G2_KTILE(2, t);
#undef G2_KTILE
#undef G2_S0
#undef G2_S1
#undef G2_DMA
#undef G2_RDB
#undef G2_RDA
#undef G2_MMA
    int fr2 = fr, fq2 = fq; asm volatile("" : "+v"(fr2), "+v"(fq2));
#pragma unroll
    for (int mi = 0; mi < 8; ++mi) {
        const int row = m0 + wr * 128 + mi * 16 + fr2;
        if constexpr (DUAL) {
#pragma unroll
            for (int ni = 0; ni < 2; ++ni) E.store4d(row, n0 + wc * 32 + ni * 16 + 4 * fq2, acc[mi][ni], acc[mi][ni + 2]);
        } else {
#pragma unroll
            for (int ni = 0; ni < 4; ++ni) E.store4(row, n0 + wc * 64 + ni * 16 + 4 * fq2, acc[mi][ni]);
        }
    }
}
__device__ __forceinline__ int unit_of(const Frame& F, int round) { return (F.G % 8 == 0) ? round * F.G + (F.bid & 7) * (F.G >> 3) + (F.bid >> 3) : round * F.G + F.bid; }
__device__ __forceinline__ void tile_of(int v, int nN, int& pm, int& pn) { const int gid = v >> 5, loc = v & 31, gn = nN >> 2; pm = (gid / gn) * 8 + (loc & 7); pn = (gid % gn) * 4 + (loc >> 3); }

__device__ __forceinline__ void p_inproj_fast(const Frame& F) {
    const ARows A{(const bf16_t*)(F.ws + WS_H1), DM};
    const EpiInProj E{(bf16_t*)(F.ws + WS_UX), (bf16_t*)(F.ws + WS_Q), (bf16_t*)(F.ws + WS_K), (bf16_t*)(F.ws + WS_V)};
    for (int r = 0;; ++r) { const int v = unit_of(F, r); if (v >= 32 * 16) break; int pm, pn; tile_of(v, 16, pm, pn);
        B2F32 Bl; Bl.base = F.in[I_WIN] + pn * 256; Bl.ld = DINP;
        gemm_tile2<ARows, B2F32, EpiInProj, false>(F.lds, A, Bl, E, pm * 256, pn * 256, DM); }
}
__device__ __forceinline__ void p_glu_fast(const Frame& F) {
    const ARows A{(const bf16_t*)(F.ws + WS_ZB), 1024};
    const EpiGlu E{(const bf16_t*)(F.ws + WS_ZB), F.in[I_BGLU], (bf16_t*)(F.ws + WS_YSSM)};
    for (int r = 0;; ++r) { const int v = unit_of(F, r); if (v >= 32 * 4) break; int pm, pn; tile_of(v, 4, pm, pn);
        B2F32 Bl; Bl.base = F.in[I_WGLU] + pn * 256; Bl.ld = 1024;
        gemm_tile2<ARows, B2F32, EpiGlu, false>(F.lds, A, Bl, E, pm * 256, pn * 256, 1024); }
}
__device__ __forceinline__ void p_outproj_fast(const Frame& F) {
    const ARows A{(const bf16_t*)(F.ws + WS_MIX), DM};
    const EpiOut E{F.in[I_X], F.modp(), (float*)(F.ws + WS_X1)};
    for (int r = 0;; ++r) { const int v = unit_of(F, r); if (v >= 32 * 8) break; int pm, pn; tile_of(v, 8, pm, pn);
        B2F32 Bl; Bl.base = F.in[I_WOUT] + pn * 256; Bl.ld = DM;
        gemm_tile2<ARows, B2F32, EpiOut, false>(F.lds, A, Bl, E, pm * 256, pn * 256, DM); }
}
__device__ __forceinline__ void p_moe1_fast(const Frame& F) {
    for (int r = 0;; ++r) { const int v = unit_of(F, r); if (v >= NE * 22 * 4) break; const int pm = v & 3, pn = (v >> 2) % 22, e = (v >> 2) / 22;
        const AGather A{(const bf16_t*)(F.ws + WS_H2), (const int*)(F.ws + WS_IDX), e};
        B2F32Dual Bl; Bl.g = F.in[I_WGATE] + (size_t)e * DM * DFF + pn * 128; Bl.u = F.in[I_WUP] + (size_t)e * DM * DFF + pn * 128; Bl.ld = DFF;
        const EpiMoe1 E{(bf16_t*)(F.ws + WS_HID) + (size_t)e * 1024 * DFF};
        gemm_tile2<AGather, B2F32Dual, EpiMoe1, true>(F.lds, A, Bl, E, pm * 256, pn * 128, DM); }
}
__device__ __forceinline__ void p_moe2_fast(const Frame& F) {
    for (int r = 0;; ++r) { const int v = unit_of(F, r); if (v >= NE * 8 * 4) break; const int pm = v & 3, pn = (v >> 2) & 7, e = v >> 5;
        const ARows A{(const bf16_t*)(F.ws + WS_HID) + (size_t)e * 1024 * DFF, DFF};
        B2F32 Bl; Bl.base = F.in[I_WDOWN] + (size_t)e * DFF * DM + pn * 256; Bl.ld = DM;
        const EpiMoe2 E{(bf16_t*)(F.ws + WS_YE) + (size_t)e * 1024 * DM, (const float*)(F.ws + WS_WAFF), e};
        gemm_tile2<ARows, B2F32, EpiMoe2, false>(F.lds, A, Bl, E, pm * 256, pn * 256, DFF); }
}


__device__ __forceinline__ void p_ssm_prep(const Frame& F, int g) {
    float* lam = (float*)F.lds;
    float* bb = lam + 2 * 64 * 17 * 2;
    float* cc = bb + 2 * 64 * 16 * 2;
    float* Tt = cc + 2 * 16 * 64 * 2;
    const int tid = F.tid;
    if (tid < 128) {
        const int dir = tid >> 6, p = tid & 63, pg = dir * 64 + g;
        const double dt = exp((double)F.in[I_LOGDT][pg]);
        const double lr = (double)F.in[I_ARE][pg * 64 + p], li = (double)F.in[I_AIM][pg * 64 + p];
        const double rho = lr * dt, th = li * dt;
        for (int m = 0; m <= 16; ++m) { const double mg = exp(rho * m); lam[((dir * 64 + p) * 17 + m) * 2 + 0] = (float)(mg * cos(th * m)); lam[((dir * 64 + p) * 17 + m) * 2 + 1] = (float)(mg * sin(th * m)); }
        const double lbr = exp(rho) * cos(th), lbi = exp(rho) * sin(th), den = lr * lr + li * li, nr = lbr - 1.0;
        const double fr = (nr * lr + lbi * li) / den, fi = (lbi * lr - nr * li) / den;
        for (int h = 0; h < 16; ++h) { const double br = (double)F.in[I_BRE][(size_t)(pg * 64 + p) * 16 + h], bi = (double)F.in[I_BIM][(size_t)(pg * 64 + p) * 16 + h];
            bb[((dir * 64 + p) * 16 + h) * 2 + 0] = (float)(fr * br - fi * bi); bb[((dir * 64 + p) * 16 + h) * 2 + 1] = (float)(fr * bi + fi * br); }
        float* LAM = (float*)(F.ws + WS_LAM);
        const double m16 = exp(rho * 16.0); LAM[((dir * 64 + g) * 64 + p) * 2 + 0] = (float)(m16 * cos(th * 16.0)); LAM[((dir * 64 + g) * 64 + p) * 2 + 1] = (float)(m16 * sin(th * 16.0));
    }
    for (int i = tid; i < 2048; i += NT) { const int dir = i >> 10, h = (i >> 6) & 15, p = i & 63;
        cc[i * 2 + 0] = F.in[I_CRE][(size_t)((dir * 64 + g) * 16 + h) * 64 + p]; cc[i * 2 + 1] = F.in[I_CIM][(size_t)((dir * 64 + g) * 16 + h) * 64 + p]; }
    __syncthreads();
    for (int i = tid; i < 31 * 256; i += NT) {
        const int ti = i >> 8, hp = (i >> 4) & 15, h = i & 15, tau = ti - 15;
        float s = 0.f;
        if (tau >= 0) { const int m = tau;
            for (int p = 0; p < 64; ++p) { const float cr = cc[((0 * 16 + hp) * 64 + p) * 2], ci = cc[((0 * 16 + hp) * 64 + p) * 2 + 1], lr = lam[((0 * 64 + p) * 17 + m) * 2], li = lam[((0 * 64 + p) * 17 + m) * 2 + 1];
                const float br = bb[((0 * 64 + p) * 16 + h) * 2], bi = bb[((0 * 64 + p) * 16 + h) * 2 + 1]; const float mr = cr * lr - ci * li, mi = cr * li + ci * lr; s += mr * br - mi * bi; } }
        if (tau <= 0) { const int m = -tau;
            for (int p = 0; p < 64; ++p) { const float cr = cc[((1 * 16 + hp) * 64 + p) * 2], ci = cc[((1 * 16 + hp) * 64 + p) * 2 + 1], lr = lam[((1 * 64 + p) * 17 + m) * 2], li = lam[((1 * 64 + p) * 17 + m) * 2 + 1];
                const float br = bb[((1 * 64 + p) * 16 + h) * 2], bi = bb[((1 * 64 + p) * 16 + h) * 2 + 1]; const float mr = cr * lr - ci * li, mi = cr * li + ci * lr; s += mr * br - mi * bi; } }
        if (tau == 0 && hp == h) s += F.in[I_SSMD][g * 16 + h];
        Tt[i] = s;
    }
    __syncthreads();
    bf16_t* BM = (bf16_t*)(F.ws + WS_BMAT) + (size_t)g * 256 * 256;
    for (int i = tid; i < 256 * 128; i += NT) { const int k = i >> 7, n0 = (i & 127) * 2, j = k >> 4, h = k & 15; float v[2];
#pragma unroll
        for (int q = 0; q < 2; ++q) { const int n = n0 + q, dir = n >> 7, ri = (n >> 6) & 1, p = n & 63, m = dir ? j : 15 - j;
            const float lr = lam[((dir * 64 + p) * 17 + m) * 2], li = lam[((dir * 64 + p) * 17 + m) * 2 + 1], br = bb[((dir * 64 + p) * 16 + h) * 2], bi = bb[((dir * 64 + p) * 16 + h) * 2 + 1];
            v[q] = ri ? (lr * bi + li * br) : (lr * br - li * bi); }
        *(unsigned*)(BM + (size_t)k * 256 + n0) = pack2(v[0], v[1]); }
    bf16_t* KC = (bf16_t*)(F.ws + WS_KCMAT) + (size_t)g * 512 * 256;
    for (int i = tid; i < 512 * 128; i += NT) { const int k = i >> 7, n0 = (i & 127) * 2; float v[2];
#pragma unroll
        for (int q = 0; q < 2; ++q) { const int n = n0 + q, ii = n >> 4, hp = n & 15;
            if (k < 256) { const int j = k >> 4, h = k & 15; v[q] = Tt[((ii - j + 15) * 16 + hp) * 16 + h]; }
            else { const int kk = k - 256, dir = kk >> 7, ri = (kk >> 6) & 1, p = kk & 63, m = dir ? 16 - ii : ii + 1;
                const float cr = cc[((dir * 16 + hp) * 64 + p) * 2], ci = cc[((dir * 16 + hp) * 64 + p) * 2 + 1], lr = lam[((dir * 64 + p) * 17 + m) * 2], li = lam[((dir * 64 + p) * 17 + m) * 2 + 1];
                v[q] = ri ? -(cr * li + ci * lr) : (cr * lr - ci * li); } }
        *(unsigned*)(KC + (size_t)k * 256 + n0) = pack2(v[0], v[1]); }
    __syncthreads();
}
struct EpiS { float* SS;
    __device__ __forceinline__ void store4(int r, int n, f32x4 v) const { *(f32x4*)(SS + (size_t)r * 256 + n) = v; } };
struct EpiY { bf16_t* ZB; int g;
    __device__ __forceinline__ void store4(int r, int n, f32x4 v) const { const int b = r >> 7, c = r & 127, i = n >> 4, hp = n & 15; const size_t t = (size_t)b * SEQ + c * 16 + i;
        u32x2 w; w.x = pack2(gelu_tanh(v[0]), gelu_tanh(v[1])); w.y = pack2(gelu_tanh(v[2]), gelu_tanh(v[3])); *(u32x2*)(ZB + t * 1024 + g * 16 + hp) = w; } };
__device__ __forceinline__ void p_ssm_sgemm(const Frame& F) {
    for (int r = 0;; ++r) { const int v = unit_of(F, r); if (v >= 128) break; const int g = v >> 1, pm = v & 1;
        const ARows A{(const bf16_t*)(F.ws + WS_UX) + (size_t)g * 512 * 512, 512};
        B2Bf16 Bl; Bl.base = (const bf16_t*)(F.ws + WS_BMAT) + (size_t)g * 256 * 256; Bl.ld = 256;
        const EpiS E{(float*)(F.ws + WS_SS) + (size_t)g * 512 * 256};
        gemm_tile2<ARows, B2Bf16, EpiS, false>(F.lds, A, Bl, E, pm * 256, 0, 256); }
}
__device__ __forceinline__ void p_ssm_ygemm(const Frame& F) {
    for (int r = 0;; ++r) { const int v = unit_of(F, r); if (v >= 128) break; const int g = v >> 1, pm = v & 1;
        const ARows A{(const bf16_t*)(F.ws + WS_UX) + (size_t)g * 512 * 512, 512};
        B2Bf16 Bl; Bl.base = (const bf16_t*)(F.ws + WS_KCMAT) + (size_t)g * 512 * 256; Bl.ld = 256;
        const EpiY E{(bf16_t*)(F.ws + WS_ZB), g};
        gemm_tile2<ARows, B2Bf16, EpiY, false>(F.lds, A, Bl, E, pm * 256, 0, 512); }
}
__device__ __forceinline__ void p_ssm_scan(const Frame& F) {
    const float* SS = (const float*)(F.ws + WS_SS); bf16_t* UX = (bf16_t*)(F.ws + WS_UX); const float* LAM = (const float*)(F.ws + WS_LAM);
    for (int w = F.bid + F.G * F.wave; w < NG * NB * 2; w += F.G * 8) {
        const int dir = w & 1, b = (w >> 1) & 3, g = w >> 3, p = F.lane;
        const float l16r = LAM[((dir * 64 + g) * 64 + p) * 2], l16i = LAM[((dir * 64 + g) * 64 + p) * 2 + 1];
        float xr = 0.f, xi = 0.f;
        for (int c0 = 0; c0 < 128; c0 += 8) {
            float sr[8], si[8];
#pragma unroll
            for (int q = 0; q < 8; ++q) { const int c = dir ? 127 - (c0 + q) : c0 + q; const float* sp = SS + ((size_t)g * 512 + b * 128 + c) * 256 + dir * 128 + p; sr[q] = sp[0]; si[q] = sp[64]; }
#pragma unroll
            for (int q = 0; q < 8; ++q) { const int c = dir ? 127 - (c0 + q) : c0 + q; bf16_t* xp = UX + ((size_t)g * 512 + b * 128 + c) * 512 + 256 + dir * 128 + p;
                xp[0] = f2bf(xr); xp[64] = f2bf(xi);
                const float nr = l16r * xr - l16i * xi + sr[q], ni = l16r * xi + l16i * xr + si[q]; xr = nr; xi = ni; }
        }
    }
}


__device__ __forceinline__ void p_attn_fast(const Frame& F) {
    LAS unsigned char* lds = (LAS unsigned char*)F.lds;
    LAS float* rp = (LAS float*)(lds + 73728);
    const bf16_t* Q = (const bf16_t*)(F.ws + WS_Q); const bf16_t* Kb = (const bf16_t*)(F.ws + WS_K); const bf16_t* Vb = (const bf16_t*)(F.ws + WS_V);
    bf16_t* Y = (bf16_t*)(F.ws + WS_YATT); const float* rpb = F.in[I_RPB];
    const int lane = F.lane, wave = F.wave, q = lane & 15, G = lane >> 4;
    for (int pu = F.bid; pu < NB * NH * 16; pu += F.G) {
        const int b = pu >> 8, h = (pu >> 4) & 15, i2 = pu & 15, r0 = 2 * i2;
        int rs0 = r0 - 4; rs0 = rs0 < 0 ? 0 : (rs0 > 24 ? 24 : rs0);
        const int base = rs0 < 23 ? rs0 : 23;
        for (int c = F.tid; c < 9 * 64 * 8; c += NT) { const int key = c >> 3, chunk = c & 7;
            const u32x4 v = *(const u32x4*)(Vb + (size_t)(b * SEQ + base * 64 + key) * 1024 + h * 64 + chunk * 8);
            const int phys = key * 128 + (((((chunk >> 1) ^ ((key >> 1) & 3)) << 1) | (chunk & 1)) << 4);
            *(LAS u32x4*)(lds + phys) = v; }
        if (F.tid < 465) rp[F.tid] = rpb[h * 465 + F.tid];
        __syncthreads();
        {
            const int r = r0 + (wave >> 2), qb = wave & 3;
            int rs = r - 4; rs = rs < 0 ? 0 : (rs > 24 ? 24 : rs);
            const int c0 = (qb == 0) ? 0 : (qb == 1) ? 8 : (qb == 2) ? 24 : 32;
            const int wq = 16 * qb + q;
            int cs = wq - 8; cs = cs < 0 ? 0 : (cs > 48 ? 48 : cs);
            const bf16_t* qp = Q + (size_t)(b * SEQ + r * 64 + wq) * 1024 + h * 64 + 8 * G;
            const bf16x8 qf0 = *(const bf16x8*)qp, qf1 = *(const bf16x8*)(qp + 32);
            f32x4 s[16];
#pragma unroll
            for (int t = 0; t < 16; ++t) {
                const bf16_t* kp = Kb + (size_t)(b * SEQ + (rs + (t >> 1)) * 64 + c0 + 16 * (t & 1) + q) * 1024 + h * 64 + 8 * G;
                const bf16x8 k0 = *(const bf16x8*)kp, k1 = *(const bf16x8*)(kp + 32);
                f32x4 a = (f32x4){0.f, 0.f, 0.f, 0.f};
                a = __builtin_amdgcn_mfma_f32_16x16x32_bf16(k0, qf0, a, 0, 0, 0);
                a = __builtin_amdgcn_mfma_f32_16x16x32_bf16(k1, qf1, a, 0, 0, 0);
                s[t] = a;
            }
            float mx = -1e30f;
#pragma unroll
            for (int t = 0; t < 16; ++t) {
                const int dr = rs + (t >> 1) - r + 7;
#pragma unroll
                for (int e = 0; e < 4; ++e) { const int wk = c0 + 16 * (t & 1) + 4 * G + e; const bool valid = (wk >= cs) && (wk < cs + 16);
                    int dc = wk - wq + 15; dc = dc < 0 ? 0 : (dc > 30 ? 30 : dc);
                    const float v = valid ? s[t][e] + rp[dr * 31 + dc] : -1e30f; s[t][e] = v; mx = fmaxf(mx, v); }
            }
            mx = fmaxf(mx, __shfl_xor(mx, 16)); mx = fmaxf(mx, __shfl_xor(mx, 32));
            float lsum = 0.f;
#pragma unroll
            for (int t = 0; t < 16; ++t)
#pragma unroll
                for (int e = 0; e < 4; ++e) { const float p = __expf(s[t][e] - mx); s[t][e] = p; lsum += p; }
            lsum += __shfl_xor(lsum, 16); lsum += __shfl_xor(lsum, 32);
            f32x4 o[4];
#pragma unroll
            for (int dt = 0; dt < 4; ++dt) o[dt] = (f32x4){0.f, 0.f, 0.f, 0.f};
#pragma unroll
            for (int kk = 0; kk < 8; ++kk) {
                union { bf16x8 v; unsigned u[4]; } pf;
                pf.u[0] = pack2(s[2 * kk][0], s[2 * kk][1]); pf.u[1] = pack2(s[2 * kk][2], s[2 * kk][3]);
                pf.u[2] = pack2(s[2 * kk + 1][0], s[2 * kk + 1][1]); pf.u[3] = pack2(s[2 * kk + 1][2], s[2 * kk + 1][3]);
                const int keyA = (rs + kk - base) * 64 + c0 + 4 * G + (q >> 2), keyB = keyA + 16;
#pragma unroll
                for (int dt = 0; dt < 4; ++dt) {
                    const int aA = keyA * 128 + ((dt ^ ((keyA >> 1) & 3)) << 5) + 8 * (q & 3), aB = keyB * 128 + ((dt ^ ((keyB >> 1) & 3)) << 5) + 8 * (q & 3);
                    const s16x4 lo = __builtin_amdgcn_ds_read_tr16_b64_v4i16((LAS s16x4*)(lds + aA));
                    const s16x4 hi = __builtin_amdgcn_ds_read_tr16_b64_v4i16((LAS s16x4*)(lds + aB));
                    const bf16x8 vf = (bf16x8){lo[0], lo[1], lo[2], lo[3], hi[0], hi[1], hi[2], hi[3]};
                    o[dt] = __builtin_amdgcn_mfma_f32_16x16x32_bf16(vf, pf.v, o[dt], 0, 0, 0);
                }
            }
            const float inv = 1.0f / lsum;
            bf16_t* yp = Y + (size_t)(b * SEQ + r * 64 + wq) * 1024 + h * 64 + 4 * G;
#pragma unroll
            for (int dt = 0; dt < 4; ++dt) { u32x2 w; w.x = pack2(o[dt][0] * inv, o[dt][1] * inv); w.y = pack2(o[dt][2] * inv, o[dt][3] * inv); *(u32x2*)(yp + 16 * dt) = w; }
        }
        __syncthreads();
    }
}

__device__ __forceinline__ void p_ssm_naive(const Frame& F) {
    if (F.wave != 0) return;
    const bf16_t* UX = (const bf16_t*)(F.ws + WS_UX); float* ybuf = (float*)(F.ws + WS_SS); bf16_t* ZB = (bf16_t*)(F.ws + WS_ZB);
    const int lane = F.lane;
    for (int u = F.bid; u < NB * NG; u += F.G) {
        const int b = u >> 6, g = u & 63;
        for (int dir = 0; dir < 2; ++dir) {
            const int pg = dir * 64 + g;
            const float dt = expf(F.in[I_LOGDT][pg]);
            const float lr = F.in[I_ARE][pg * 64 + lane], li = F.in[I_AIM][pg * 64 + lane];
            const float mag = expf(lr * dt); const float lbr = mag * cosf(li * dt), lbi = mag * sinf(li * dt);
            const float den = lr * lr + li * li, nr = lbr - 1.0f;
            const float fr = (nr * lr + lbi * li) / den, fi = (lbi * lr - nr * li) / den;
            float bbr[16], bbi[16], cr[16], ci[16];
#pragma unroll
            for (int h = 0; h < 16; ++h) { const float br = F.in[I_BRE][(size_t)(pg * 64 + lane) * 16 + h], bi = F.in[I_BIM][(size_t)(pg * 64 + lane) * 16 + h];
                bbr[h] = fr * br - fi * bi; bbi[h] = fr * bi + fi * br;
                cr[h] = F.in[I_CRE][(size_t)(pg * 16 + h) * 64 + lane]; ci[h] = F.in[I_CIM][(size_t)(pg * 16 + h) * 64 + lane]; }
            const float dsk = F.in[I_SSMD][g * 16 + (lane & 15)];
            float xr = 0.f, xi = 0.f;
            for (int s = 0; s < SEQ; ++s) {
                const int l = dir ? (SEQ - 1 - s) : s;
                const bf16_t* up = UX + (size_t)(g * 512 + b * 128 + (l >> 4)) * 512 + (l & 15) * 16;
                const float uval = bf2f(up[lane & 15]);
                float bur = 0.f, bui = 0.f;
#pragma unroll
                for (int h = 0; h < 16; ++h) { const float uh = __shfl(uval, h); bur += bbr[h] * uh; bui += bbi[h] * uh; }
                const float nxr = lbr * xr - lbi * xi + bur, nxi = lbr * xi + lbi * xr + bui; xr = nxr; xi = nxi;
                float myy = 0.f;
#pragma unroll
                for (int h = 0; h < 16; ++h) { const float v = wave_sum(cr[h] * xr - ci[h] * xi); if (lane == h) myy = v; }
                const size_t o = (size_t)(b * SEQ + l) * 1024 + g * 16;
                if (lane < 16) {
                    if (dir == 0) ybuf[o + lane] = myy;
                    else { const float y = ybuf[o + lane] + myy + dsk * uval; ZB[o + lane] = f2bf(gelu_tanh(y)); }
                }
            }
        }
    }
}

__device__ __forceinline__ void p_attn_naive(const Frame& F) {
    const bf16_t* Q = (const bf16_t*)(F.ws + WS_Q); const bf16_t* Kb = (const bf16_t*)(F.ws + WS_K); const bf16_t* Vb = (const bf16_t*)(F.ws + WS_V);
    bf16_t* Y = (bf16_t*)(F.ws + WS_YATT); const float* rpb = F.in[I_RPB];
    for (int id = F.bid * NT + F.tid; id < TOK * NH; id += F.G * NT) {
        const int t = id >> 4, h = id & 15, b = t >> 11, l = t & 2047, r = l >> 6, w = l & 63;
        int rs = r - 4; rs = rs < 0 ? 0 : (rs > 24 ? 24 : rs);
        int cs = w - 8; cs = cs < 0 ? 0 : (cs > 48 ? 48 : cs);
        float q[64], acc[64];
        const u32x4* qp = (const u32x4*)(Q + (size_t)t * 1024 + h * 64);
#pragma unroll
        for (int i = 0; i < 8; ++i) { const u32x4 v = qp[i]; q[i * 8 + 0] = bflo(v.x); q[i * 8 + 1] = bfhi(v.x); q[i * 8 + 2] = bflo(v.y); q[i * 8 + 3] = bfhi(v.y);
            q[i * 8 + 4] = bflo(v.z); q[i * 8 + 5] = bfhi(v.z); q[i * 8 + 6] = bflo(v.w); q[i * 8 + 7] = bfhi(v.w); }
#pragma unroll
        for (int d = 0; d < 64; ++d) acc[d] = 0.f;
        float m = -1e30f, lsum = 0.f;
        for (int j = 0; j < 8; ++j) {
            const int kr = rs + j, dr = kr - r + 7;
            for (int kk = 0; kk < 16; ++kk) {
                const int wk = cs + kk, dc = wk - w + 15;
                const size_t kt = (size_t)(b * SEQ + kr * 64 + wk) * 1024 + h * 64;
                const u32x4* kp = (const u32x4*)(Kb + kt);
                float s = 0.f;
#pragma unroll
                for (int i = 0; i < 8; ++i) { const u32x4 v = kp[i];
                    s += q[i * 8 + 0] * bflo(v.x) + q[i * 8 + 1] * bfhi(v.x) + q[i * 8 + 2] * bflo(v.y) + q[i * 8 + 3] * bfhi(v.y)
                       + q[i * 8 + 4] * bflo(v.z) + q[i * 8 + 5] * bfhi(v.z) + q[i * 8 + 6] * bflo(v.w) + q[i * 8 + 7] * bfhi(v.w); }
                s += rpb[(h * 15 + dr) * 31 + dc];
                const float mn = fmaxf(m, s); const float corr = __expf(m - mn), p = __expf(s - mn);
                lsum = lsum * corr + p; m = mn;
                const u32x4* vp = (const u32x4*)(Vb + kt);
#pragma unroll
                for (int i = 0; i < 8; ++i) { const u32x4 v = vp[i];
                    acc[i * 8 + 0] = acc[i * 8 + 0] * corr + p * bflo(v.x); acc[i * 8 + 1] = acc[i * 8 + 1] * corr + p * bfhi(v.x);
                    acc[i * 8 + 2] = acc[i * 8 + 2] * corr + p * bflo(v.y); acc[i * 8 + 3] = acc[i * 8 + 3] * corr + p * bfhi(v.y);
                    acc[i * 8 + 4] = acc[i * 8 + 4] * corr + p * bflo(v.z); acc[i * 8 + 5] = acc[i * 8 + 5] * corr + p * bfhi(v.z);
                    acc[i * 8 + 6] = acc[i * 8 + 6] * corr + p * bflo(v.w); acc[i * 8 + 7] = acc[i * 8 + 7] * corr + p * bfhi(v.w); }
            }
        }
        const float inv = 1.0f / lsum;
        u32x4* yp = (u32x4*)(Y + (size_t)t * 1024 + h * 64);
#pragma unroll
        for (int i = 0; i < 8; ++i) { u32x4 o; o.x = pack2(acc[i * 8 + 0] * inv, acc[i * 8 + 1] * inv); o.y = pack2(acc[i * 8 + 2] * inv, acc[i * 8 + 3] * inv);
            o.z = pack2(acc[i * 8 + 4] * inv, acc[i * 8 + 5] * inv); o.w = pack2(acc[i * 8 + 6] * inv, acc[i * 8 + 7] * inv); yp[i] = o; }
    }
}

__device__ __forceinline__ void p_normcat(const Frame& F) {
    const bf16_t* YS = (const bf16_t*)(F.ws + WS_YSSM); const bf16_t* YA = (const bf16_t*)(F.ws + WS_YATT); bf16_t* MIX = (bf16_t*)(F.ws + WS_MIX);
    for (int t = F.bid * 8 + F.wave; t < TOK; t += F.G * 8) {
#pragma unroll
        for (int half = 0; half < 2; ++half) {
            const bf16_t* src = (half ? YA : YS) + (size_t)t * 1024; const float* g = F.in[half ? I_GATT : I_GSSM];
            float v[16]; float ss = 0.f;
#pragma unroll
            for (int i = 0; i < 2; ++i) { const u32x4 w = *(const u32x4*)(src + i * 512 + F.lane * 8);
                v[i * 8 + 0] = bflo(w.x); v[i * 8 + 1] = bfhi(w.x); v[i * 8 + 2] = bflo(w.y); v[i * 8 + 3] = bfhi(w.y); v[i * 8 + 4] = bflo(w.z); v[i * 8 + 5] = bfhi(w.z); v[i * 8 + 6] = bflo(w.w); v[i * 8 + 7] = bfhi(w.w); }
#pragma unroll
            for (int i = 0; i < 16; ++i) ss += v[i] * v[i];
            ss = wave_sum(ss);
            const float rstd = rsqrtf(ss * (1.0f / 1024.0f) + EPS);
#pragma unroll
            for (int i = 0; i < 2; ++i) { const int k = i * 512 + F.lane * 8; const f32x4 g0 = *(const f32x4*)(g + k), g1 = *(const f32x4*)(g + k + 4);
                u32x4 o; o.x = pack2(v[i * 8 + 0] * rstd * g0[0], v[i * 8 + 1] * rstd * g0[1]); o.y = pack2(v[i * 8 + 2] * rstd * g0[2], v[i * 8 + 3] * rstd * g0[3]);
                o.z = pack2(v[i * 8 + 4] * rstd * g1[0], v[i * 8 + 5] * rstd * g1[1]); o.w = pack2(v[i * 8 + 6] * rstd * g1[2], v[i * 8 + 7] * rstd * g1[3]);
                *(u32x4*)(MIX + (size_t)t * DM + half * 1024 + k) = o; }
        }
    }
}

template <int N> __device__ __forceinline__ void h2_step(float (&lg)[32], int lane, int m) {
    const bool hi = (lane & m) != 0;
#pragma unroll
    for (int j = 0; j < N; ++j) { float a = lg[j], b = lg[j + N]; asm volatile("" : "+v"(a), "+v"(b));
        const float keep = hi ? b : a, give = hi ? a : b; lg[j] = keep + __shfl_xor(give, m); }
}
__device__ __forceinline__ void p_h2(const Frame& F) {
    const float* X1 = (const float*)(F.ws + WS_X1); const float* g = F.in[I_GFFN]; const float* mod = F.modp(); const float* wr = F.in[I_WROUTER];
    bf16_t* H2 = (bf16_t*)(F.ws + WS_H2); float* AFF = (float*)(F.ws + WS_AFF);
    float* wt = (float*)F.lds;
    for (int idx = F.tid; idx < 2048 * 16; idx += NT) wt[(idx & 15) * 2052 + (idx >> 4)] = wr[idx];
    __syncthreads();
    const int lane = F.lane;
    for (int tp = F.bid * 8 + F.wave; tp < TOK / 2; tp += F.G * 8) {
        const int t0 = 2 * tp, b = t0 >> 11, l0 = t0 & 2047; const float* xr = X1 + (size_t)t0 * DM;
        float ss0 = 0.f, ss1 = 0.f;
#pragma unroll
        for (int i = 0; i < 8; ++i) { const f32x4 a0 = *(const f32x4*)(xr + i * 256 + lane * 4), a1 = *(const f32x4*)(xr + DM + i * 256 + lane * 4);
            ss0 += a0[0] * a0[0] + a0[1] * a0[1] + a0[2] * a0[2] + a0[3] * a0[3];
            ss1 += a1[0] * a1[0] + a1[1] * a1[1] + a1[2] * a1[2] + a1[3] * a1[3]; }
        __builtin_amdgcn_sched_barrier(0);
        ss0 = wave_sum(ss0); ss1 = wave_sum(ss1);
        const float r0 = rsqrtf(ss0 * (1.0f / DM) + EPS), r1 = rsqrtf(ss1 * (1.0f / DM) + EPS);
        float lg[32];
#pragma unroll
        for (int e = 0; e < 32; ++e) lg[e] = 0.f;
#pragma unroll
        for (int i = 0; i < 8; ++i) { const int k = i * 256 + lane * 4;
            const f32x4 gv = *(const f32x4*)(g + k), sh = *(const f32x4*)(mod + b * 12288 + 6144 + k), sc = *(const f32x4*)(mod + b * 12288 + 8192 + k);
            const f32x4 a0 = *(const f32x4*)(xr + k), a1 = *(const f32x4*)(xr + DM + k);
            f32x4 o0, o1;
#pragma unroll
            for (int j = 0; j < 4; ++j) { const float gs = gv[j] * (1.0f + sc[j]); o0[j] = (a0[j] * r0) * gs + sh[j]; o1[j] = (a1[j] * r1) * gs + sh[j]; }
            u32x2 w; w.x = pack2(o0[0], o0[1]); w.y = pack2(o0[2], o0[3]); *(u32x2*)(H2 + (size_t)t0 * DM + k) = w;
            w.x = pack2(o1[0], o1[1]); w.y = pack2(o1[2], o1[3]); *(u32x2*)(H2 + (size_t)(t0 + 1) * DM + k) = w;
#pragma unroll
            for (int e = 0; e < 16; ++e) { const f32x4 wv = *(const f32x4*)(wt + e * 2052 + k);
                lg[e] += o0[0] * wv[0] + o0[1] * wv[1] + o0[2] * wv[2] + o0[3] * wv[3];
                lg[16 + e] += o1[0] * wv[0] + o1[1] * wv[1] + o1[2] * wv[2] + o1[3] * wv[3];
                if ((e & 3) == 3) __builtin_amdgcn_sched_barrier(0); }
        }
h2_step<16>(lg, lane, 32); h2_step<8>(lg, lane, 16); h2_step<4>(lg, lane, 8); h2_step<2>(lg, lane, 4); h2_step<1>(lg, lane, 2);
        float z = lg[0] + __shfl_xor(lg[0], 1);
        float mx = z;
#pragma unroll
        for (int m = 2; m <= 16; m <<= 1) mx = fmaxf(mx, __shfl_xor(mx, m));
        const float ex = expf(z - mx); float den = ex;
#pragma unroll
        for (int m = 2; m <= 16; m <<= 1) den += __shfl_xor(den, m);
        if ((lane & 1) == 0) AFF[(size_t)(b * NE + ((lane >> 1) & 15)) * SEQ + l0 + (lane >> 5)] = ex / den;
    }
}

__device__ __forceinline__ void p_topk(const Frame& F) {
    unsigned long long* key = (unsigned long long*)F.lds;
    const float* AFF = (const float*)(F.ws + WS_AFF); int* IDX = (int*)(F.ws + WS_IDX); float* WAFF = (float*)(F.ws + WS_WAFF); int* SLOT = (int*)(F.ws + WS_SLOT);
    for (int u = F.bid; u < NB * NE; u += F.G) {
        for (int i = F.tid; i < SEQ; i += NT) key[i] = ((unsigned long long)__float_as_uint(AFF[(size_t)u * SEQ + i]) << 32) | (unsigned)(0xFFFFFFFFu - (unsigned)i);
        __syncthreads();
        for (int k = 2; k <= SEQ; k <<= 1)
            for (int j = k >> 1; j > 0; j >>= 1) {
                for (int i = F.tid; i < SEQ; i += NT) { const int ixj = i ^ j;
                    if (ixj > i) { const unsigned long long a = key[i], c = key[ixj]; const bool desc = ((i & k) == 0);
                        if (desc ? (a < c) : (a > c)) { key[i] = c; key[ixj] = a; } } }
                __syncthreads();
            }
        for (int i = F.tid; i < SEQ; i += NT) { const unsigned long long kv = key[i]; const int tok = (int)(0xFFFFFFFFu - (unsigned)(kv & 0xFFFFFFFFull));
            if (i < CAP) { IDX[u * CAP + i] = tok; WAFF[u * CAP + i] = __uint_as_float((unsigned)(kv >> 32)); }
            SLOT[(size_t)u * SEQ + tok] = (i < CAP) ? i : -1; }
        __syncthreads();
    }
}

__device__ __forceinline__ void p_final(const Frame& F) {
    const float* X1 = (const float*)(F.ws + WS_X1); const float* mod = F.modp(); const float* g = F.in[I_GFINAL];
    const bf16_t* YE = (const bf16_t*)(F.ws + WS_YE); const int* SLOT = (const int*)(F.ws + WS_SLOT);
    for (int t = F.bid * 8 + F.wave; t < TOK; t += F.G * 8) {
        const int b = t >> 11, l = t & 2047; const float* xr = X1 + (size_t)t * DM;
        f32x4 mo[8];
#pragma unroll
        for (int i = 0; i < 8; ++i) mo[i] = (f32x4){0.f, 0.f, 0.f, 0.f};
        for (int e = 0; e < NE; ++e) {
            const int s = SLOT[(size_t)(b * NE + e) * SEQ + l];
            if (s >= 0) { const bf16_t* yr = YE + ((size_t)e * 1024 + b * 256 + s) * DM;
#pragma unroll
                for (int i = 0; i < 8; ++i) { const u32x2 w = *(const u32x2*)(yr + i * 256 + F.lane * 4); mo[i][0] += bflo(w.x); mo[i][1] += bfhi(w.x); mo[i][2] += bflo(w.y); mo[i][3] += bfhi(w.y); } }
        }
        f32x4 v[8]; float ss = 0.f;
#pragma unroll
        for (int i = 0; i < 8; ++i) { const int k = i * 256 + F.lane * 4; const f32x4 xv = *(const f32x4*)(xr + k), gt = *(const f32x4*)(mod + b * 12288 + 10240 + k);
            v[i] = xv + gt * mo[i]; ss += v[i][0] * v[i][0] + v[i][1] * v[i][1] + v[i][2] * v[i][2] + v[i][3] * v[i][3]; }
        ss = wave_sum(ss);
        const float rstd = rsqrtf(ss * (1.0f / DM) + EPS);
#pragma unroll
        for (int i = 0; i < 8; ++i) { const int k = i * 256 + F.lane * 4; const f32x4 gv = *(const f32x4*)(g + k);
            *(f32x4*)(F.out + (size_t)t * DM + k) = v[i] * rstd * gv; }
    }
}

constexpr int N_PHASES = 14;
__global__ void __launch_bounds__(NT, 2) fwd(Args args) {
    extern __shared__ __attribute__((aligned(16))) unsigned char lds[];
    Frame F;
#pragma unroll
    for (int i = 0; i < 26; ++i) F.in[i] = args.in[i];
    F.out = args.out; F.ws = args.ws; F.lds = lds;
    F.tid = threadIdx.x; F.lane = F.tid & 63; F.wave = __builtin_amdgcn_readfirstlane(F.tid >> 6); F.G = gridDim.x; F.bid = blockIdx.x;
    const int lo = args.ph_lo, hi = args.ph_hi;
    XcdBarrier bar; bar.bar = (unsigned*)(F.ws + WS_CTL); bar.x = 0; bar.nloc = 0u; bar.nx = 0u;
    if (hi - lo > 1) bar = xcd_barrier_post((unsigned*)(F.ws + WS_CTL));
#define IN(k) (lo <= (k) && (k) < hi)
#define SEAM(k) do { if (IN(k) && IN((k) + 1)) xcd_barrier(bar); } while (0)
    if (IN(0)) { for (int rep_ = 0; rep_ <= REPS(0); ++rep_) { p_ada(F); if (FAST_SSM) { for (int g = F.G - 1 - F.bid; g < NG; g += F.G) p_ssm_prep(F, g); } __syncthreads(); } } SEAM(0);
    if (IN(1)) { for (int rep_ = 0; rep_ <= REPS(1); ++rep_) { p_h1(F); __syncthreads(); } } SEAM(1);
    if (IN(2)) { for (int rep_ = 0; rep_ <= REPS(2); ++rep_) { if (FAST_INPROJ) p_inproj_fast(F); else p_inproj_naive(F); __syncthreads(); } } SEAM(2);
    if (IN(3)) { for (int rep_ = 0; rep_ <= REPS(3); ++rep_) { if (FAST_SSM) p_ssm_sgemm(F); else p_ssm_naive(F); __syncthreads(); if (FAST_ATTN) p_attn_fast(F); else p_attn_naive(F); __syncthreads(); } } SEAM(3);
    if (IN(4)) { for (int rep_ = 0; rep_ <= REPS(4); ++rep_) { if (FAST_SSM) p_ssm_scan(F); __syncthreads(); } } SEAM(4);
    if (IN(5)) { for (int rep_ = 0; rep_ <= REPS(5); ++rep_) { if (FAST_SSM) p_ssm_ygemm(F); __syncthreads(); } } SEAM(5);
    if (IN(6)) { for (int rep_ = 0; rep_ <= REPS(6); ++rep_) { if (FAST_GLU) p_glu_fast(F); else p_glu_naive(F); __syncthreads(); } } SEAM(6);
    if (IN(7)) { for (int rep_ = 0; rep_ <= REPS(7); ++rep_) { p_normcat(F); __syncthreads(); } } SEAM(7);
    if (IN(8)) { for (int rep_ = 0; rep_ <= REPS(8); ++rep_) { if (FAST_OUT) p_outproj_fast(F); else p_outproj_naive(F); __syncthreads(); } } SEAM(8);
    if (IN(9)) { for (int rep_ = 0; rep_ <= REPS(9); ++rep_) { p_h2(F); __syncthreads(); } } SEAM(9);
    if (IN(10)) { for (int rep_ = 0; rep_ <= REPS(10); ++rep_) { p_topk(F); __syncthreads(); } } SEAM(10);
    if (IN(11)) { for (int rep_ = 0; rep_ <= REPS(11); ++rep_) { if (FAST_MOE1) p_moe1_fast(F); else p_moe1_naive(F); __syncthreads(); } } SEAM(11);
    if (IN(12)) { for (int rep_ = 0; rep_ <= REPS(12); ++rep_) { if (FAST_MOE2) p_moe2_fast(F); else p_moe2_naive(F); __syncthreads(); } } SEAM(12);
    if (IN(13)) { for (int rep_ = 0; rep_ <= REPS(13); ++rep_) { p_final(F); __syncthreads(); } }
#undef IN
#undef SEAM
}

extern "C" void kernel_launch(void* const* d_in, const int* in_sizes, int n_in, void* d_out, int out_size, void* d_ws, size_t ws_size, hipStream_t stream) {
    static int grid = 0;
    if (grid == 0) {
        if (n_in != 26 || out_size != TOK * DM || ws_size < WS_END) { fprintf(stderr, "kernel_launch: unexpected problem (n_in %d out %d ws %zu need %zu)\n", n_in, out_size, ws_size, (size_t)WS_END); grid = -1; return; }
        int dev = 0, cus = 0, per_cu = 0;
        if (hipGetDevice(&dev) != hipSuccess || hipDeviceGetAttribute(&cus, hipDeviceAttributeMultiprocessorCount, dev) != hipSuccess) { grid = -1; return; }
        if (hipFuncSetAttribute((const void*)fwd, hipFuncAttributeMaxDynamicSharedMemorySize, LDS_BYTES) != hipSuccess) { fprintf(stderr, "kernel_launch: hipFuncSetAttribute failed\n"); grid = -1; return; }
        if (hipOccupancyMaxActiveBlocksPerMultiprocessor(&per_cu, (const void*)fwd, NT, LDS_BYTES) != hipSuccess || per_cu < 1) { fprintf(stderr, "kernel_launch: occupancy query says %d\n", per_cu); }
        (void)hipGetLastError();
        grid = cus;
    }
    if (grid < 0) return;
    (void)hipMemsetAsync((char*)d_ws + WS_CTL, 0, CTL_BYTES, stream);
    Args a{};
    for (int i = 0; i < 26; ++i) a.in[i] = (const float*)d_in[i];
    a.out = (float*)d_out; a.ws = (unsigned char*)d_ws;
#if N_LAUNCH_MODE == 1
    a.ph_lo = 0; a.ph_hi = N_PHASES;
    hipLaunchKernelGGL(fwd, dim3(grid), dim3(NT), LDS_BYTES, stream, a);
#else
    for (int p = 0; p < N_PHASES; ++p) {
        if (p == 4 || p == 5) continue;
        a.ph_lo = p; a.ph_hi = p + 1;
        hipLaunchKernelGGL(fwd, dim3(grid), dim3(NT), LDS_BYTES, stream, a);
    }
#endif
}
```

```cpp
#include <hip/hip_runtime.h>
#include <stdint.h>
#include <stdio.h>

#ifndef N_LAUNCH_MODE
#define N_LAUNCH_MODE 1
#endif

#ifndef PROBE_MASK
#define PROBE_MASK 0
#endif
#define REPS(k) ((PROBE_MASK >> (k)) & 1)
#define FAST_INPROJ 1
#define FAST_GLU 1
#define FAST_OUT 1
#define FAST_MOE1 1
#define FAST_MOE2 1
#define FAST_SSM 1
#define FAST_ATTN 1
#define LAS __attribute__((address_space(3)))
typedef unsigned short bf16_t;
typedef float f32x4 __attribute__((ext_vector_type(4)));
typedef float f32x2 __attribute__((ext_vector_type(2)));
typedef short bf16x8 __attribute__((ext_vector_type(8)));
typedef short s16x4 __attribute__((ext_vector_type(4)));
typedef unsigned u32x2 __attribute__((ext_vector_type(2)));
typedef unsigned u32x4 __attribute__((ext_vector_type(4)));

constexpr int NT = 512;
constexpr int TOK = 8192, DM = 2048, NB = 4, SEQ = 2048;
constexpr int DSSM = 1024, DATT = 1024, NH = 16, HD = 64, DINP = 4096;
constexpr int NE = 16, CAP = 256, DFF = 2816;
constexpr int NG = 64, NP = 64, GH = 16;
constexpr float EPS = 1e-6f;

constexpr size_t al256(size_t x) { return (x + 255) & ~(size_t)255; }
constexpr size_t WS_CTL   = 0;
constexpr size_t CTL_BYTES = 32768;
constexpr size_t WS_MOD   = WS_CTL + CTL_BYTES;
constexpr size_t WS_H1    = al256(WS_MOD + (size_t)NB * 12288 * 4);
constexpr size_t WS_UX    = al256(WS_H1 + (size_t)TOK * DM * 2);
constexpr size_t WS_Q     = al256(WS_UX + (size_t)64 * 512 * 512 * 2);
constexpr size_t WS_K     = al256(WS_Q + (size_t)TOK * 1024 * 2);
constexpr size_t WS_V     = al256(WS_K + (size_t)TOK * 1024 * 2);
constexpr size_t WS_SS    = al256(WS_V + (size_t)TOK * 1024 * 2);
constexpr size_t WS_ZB    = al256(WS_SS + (size_t)64 * 512 * 256 * 4);
constexpr size_t WS_YSSM  = al256(WS_ZB + (size_t)TOK * 1024 * 2);
constexpr size_t WS_SQS   = WS_YSSM;
constexpr size_t WS_SQA   = WS_YSSM + (size_t)TOK * 4 * 4;
constexpr size_t WS_YATT  = al256(WS_YSSM + (size_t)TOK * 1024 * 2);
constexpr size_t WS_MIX   = al256(WS_YATT + (size_t)TOK * 1024 * 2);
constexpr size_t WS_X1    = al256(WS_MIX + (size_t)TOK * DM * 2);
constexpr size_t WS_H2    = al256(WS_X1 + (size_t)TOK * DM * 4);
constexpr size_t WS_AFF   = al256(WS_H2 + (size_t)TOK * DM * 2);
constexpr size_t WS_IDX   = al256(WS_AFF + (size_t)NB * NE * SEQ * 4);
constexpr size_t WS_WAFF  = al256(WS_IDX + (size_t)NB * NE * CAP * 4);
constexpr size_t WS_SLOT  = al256(WS_WAFF + (size_t)NB * NE * CAP * 4);
constexpr size_t WS_HID   = al256(WS_SLOT + (size_t)NB * NE * SEQ * 4);
constexpr size_t WS_YE    = al256(WS_HID + (size_t)NE * 1024 * DFF * 2);
constexpr size_t WS_BMAT  = al256(WS_YE + (size_t)NE * 1024 * DM * 2);
constexpr size_t WS_KCMAT = al256(WS_BMAT + (size_t)64 * 256 * 256 * 2);
constexpr size_t WS_LAM   = al256(WS_KCMAT + (size_t)64 * 512 * 256 * 2);
constexpr size_t WS_WINB  = al256(WS_LAM + (size_t)2 * 64 * 64 * 2 * 4);
constexpr size_t WS_WGLUB = al256(WS_WINB + (size_t)DM * DINP * 2);
constexpr size_t WS_WOUTB = al256(WS_WGLUB + (size_t)1024 * 1024 * 2);
constexpr size_t WS_END   = al256(WS_WOUTB + (size_t)DM * DM * 2);

constexpr int LDS_BYTES = 163840;

typedef __bf16 bf16x2_t __attribute__((ext_vector_type(2)));
__device__ __forceinline__ bf16_t f2bf(float f) { return __builtin_bit_cast(bf16_t, (__bf16)f); }
__device__ __forceinline__ float bf2f(bf16_t b) { return __uint_as_float(((unsigned)b) << 16); }
__device__ __forceinline__ float bflo(unsigned w) { return __uint_as_float(w << 16); }
__device__ __forceinline__ float bfhi(unsigned w) { return __uint_as_float(w & 0xffff0000u); }
__device__ __forceinline__ unsigned pack2(float lo, float hi) { const f32x2 f = {lo, hi}; return __builtin_bit_cast(unsigned, __builtin_convertvector(f, bf16x2_t)); }
__device__ __forceinline__ float wave_sum(float v) {
#pragma unroll
    for (int m = 32; m >= 1; m >>= 1) v += __shfl_xor(v, m);
    return v;
}
__device__ __forceinline__ float silu_f(float v) { return v / (1.0f + __expf(-v)); }
__device__ __forceinline__ float sigmoid_f(float v) { return 1.0f / (1.0f + __expf(-v)); }
__device__ __forceinline__ float gelu_tanh(float y) { const float t = 1.5957691216057308f * (y + 0.044715f * y * y * y); return y / (1.0f + __expf(-t)); }

#define XB_TMO      128
#define XB_XCNT(j)  (256  + 64 * (j))
#define XB_XSUB(j)  (1280 + 64 * (j))
#define XB_XGEN(j)  (2304 + 64 * (j))
#define XB_TOP      3328
#define XB_TOPGEN   3392
#define XCD_BAR_WORDS 3456
#define XB_SPIN_CAP (1u << 18)
__device__ __forceinline__ unsigned xb_ld(unsigned* p)              { return __hip_atomic_load(p, __ATOMIC_RELAXED, __HIP_MEMORY_SCOPE_AGENT); }
__device__ __forceinline__ unsigned xb_add(unsigned* p, unsigned v) { return __hip_atomic_fetch_add(p, v, __ATOMIC_RELAXED, __HIP_MEMORY_SCOPE_AGENT); }
__device__ __forceinline__ unsigned xb_xcc_id() { return (unsigned)__builtin_amdgcn_s_getreg((3 << 11) | 20) & 0xFu; }
#define XB_SPIN(cond, bar) do { unsigned _sp = 0; while (cond) { __builtin_amdgcn_s_sleep(1); \
    if ((++_sp & 255u) == 0u) { if (xb_ld(&(bar)[XB_TMO])) break; if (_sp > XB_SPIN_CAP) { atomicAdd(&(bar)[XB_TMO], 1u); break; } } } } while (0)
struct XcdBarrier { unsigned* bar; unsigned x; unsigned nloc, nx; };
__device__ __forceinline__ XcdBarrier xcd_barrier_post(unsigned* bar) {
    XcdBarrier b; b.bar = bar; b.x = xb_xcc_id(); b.nloc = 0u; b.nx = 0u;
    if (threadIdx.x == 0) (void)xb_add(&bar[XB_XCNT(b.x)], 1u);
    return b;
}
__device__ __forceinline__ void xcd_barrier_complete(unsigned* bar, unsigned x, unsigned& nloc, unsigned& nx) {
    const unsigned G = gridDim.x * gridDim.y * gridDim.z;
    unsigned sum, cnt, mine, sp = 0u;
    for (;;) {
        sum = 0u; cnt = 0u; mine = 0u;
#pragma unroll
        for (unsigned j = 0; j < 16; ++j) { const unsigned c = xb_ld(&bar[XB_XCNT(j)]); sum += c; cnt += (c > 0u) ? 1u : 0u; mine = (j == x) ? c : mine; }
        if (sum == G) break;
        __builtin_amdgcn_s_sleep(1);
        if ((++sp & 255u) == 0u) { if (xb_ld(&bar[XB_TMO])) break; if (sp > XB_SPIN_CAP) { atomicAdd(&bar[XB_TMO], 1u); break; } }
    }
    nloc = mine > 0u ? mine : 1u; nx = cnt > 0u ? cnt : 1u;
}
__device__ __forceinline__ void xcd_barrier_setup(XcdBarrier& b) {
    if (__builtin_amdgcn_readfirstlane(threadIdx.x >> 6) == 0) { unsigned nloc, nx; xcd_barrier_complete(b.bar, b.x, nloc, nx);
        b.nloc = (unsigned)__builtin_amdgcn_readfirstlane((int)nloc); b.nx = (unsigned)__builtin_amdgcn_readfirstlane((int)nx); }
}
__device__ __forceinline__ void xcd_barrier(XcdBarrier& b) {
    asm volatile("s_waitcnt vmcnt(0)" ::: "memory");
    __syncthreads();
    if (threadIdx.x == 0) {
        unsigned* bar = b.bar;
        __builtin_amdgcn_s_waitcnt(0);
        const unsigned nloc = b.nloc, nx = b.nx;
        const unsigned old = xb_add(&bar[XB_XSUB(b.x)], 1u);
        const unsigned gen = old / nloc;
        if (old + 1u == (gen + 1u) * nloc) {
            __builtin_amdgcn_fence(__ATOMIC_RELEASE, "agent");
            asm volatile("s_waitcnt vmcnt(0)" ::: "memory");
            const unsigned og = xb_add(&bar[XB_TOP], 1u);
            const unsigned tg = og / nx;
            if (og + 1u == (tg + 1u) * nx) xb_add(&bar[XB_TOPGEN], 1u);
            else XB_SPIN(xb_ld(&bar[XB_TOPGEN]) == tg, bar);
            __builtin_amdgcn_fence(__ATOMIC_ACQUIRE, "agent");
            xb_add(&bar[XB_XGEN(b.x)], 1u);
            asm volatile("s_waitcnt vmcnt(0)" ::: "memory");
        } else {
            XB_SPIN(xb_ld(&bar[XB_XGEN(b.x)]) == gen, bar);
            __builtin_amdgcn_fence(__ATOMIC_ACQUIRE, "agent");
            asm volatile("s_waitcnt vmcnt(0)" ::: "memory");
        }
    }
    __syncthreads();
}

struct Args { const float* in[26]; float* out; unsigned char* ws; int ph_lo, ph_hi; };
enum { I_X = 0, I_C, I_WADA, I_BADA, I_GMIX, I_WIN, I_ARE, I_AIM, I_LOGDT, I_BRE, I_BIM, I_CRE, I_CIM, I_SSMD, I_WGLU, I_BGLU, I_RPB,
       I_GSSM, I_GATT, I_WOUT, I_GFFN, I_WROUTER, I_WGATE, I_WUP, I_WDOWN, I_GFINAL };

struct ARows { const bf16_t* base; size_t ld; __device__ __forceinline__ const bf16_t* ptr(int r) const { return base + (size_t)r * ld; }
    __device__ __forceinline__ unsigned off(int r) const { return (unsigned)r * (unsigned)ld; } };
struct AGather { const bf16_t* base; const int* idx; int e; unsigned koff;
    __device__ __forceinline__ const bf16_t* ptr(int r) const { const int b = r >> 8; return base + (size_t)(b * SEQ + idx[(b * NE + e) * CAP + (r & 255)]) * DM; }
    __device__ __forceinline__ unsigned off(int r) const { const int b = r >> 8; return (unsigned)(b * SEQ + idx[(b * NE + e) * CAP + (r & 255)]) * (unsigned)DM + koff; } };
struct BF32 { const float* base; size_t ld; __device__ __forceinline__ float get(int k, int n) const { return base[(size_t)k * ld + n]; }
    __device__ __forceinline__ float get2(int, int) const { return 0.f; } };
struct BF32Dual { const float* g; const float* u; size_t ld; __device__ __forceinline__ float get(int k, int n) const { return g[(size_t)k * ld + n]; }
    __device__ __forceinline__ float get2(int k, int n) const { return u[(size_t)k * ld + n]; } };

constexpr float QSCALE = 0.125f * 1.44269504088896f;
struct EpiInProj { bf16_t* UX; bf16_t* Q; bf16_t* K; bf16_t* V;
    __device__ __forceinline__ void store(int t, int n, float v) const {
        if (n < 1024) { const int g = n >> 4, h = n & 15, b = t >> 11, l = t & 2047; UX[(size_t)(g * 512 + b * 128 + (l >> 4)) * 512 + (l & 15) * 16 + h] = f2bf(v); }
        else if (n < 2048) Q[(size_t)t * 1024 + (n - 1024)] = f2bf(v * QSCALE);
        else if (n < 3072) K[(size_t)t * 1024 + (n - 2048)] = f2bf(v);
        else V[(size_t)t * 1024 + (n - 3072)] = f2bf(v);
    }
    __device__ __forceinline__ void store2(int, int, float, float) const {}
    __device__ __forceinline__ void store4(int t, int n, f32x4 v) const {
        u32x2 w;
        if (n < 1024) { const int g = n >> 4, h = n & 15, b = t >> 11, l = t & 2047; w.x = pack2(v[0], v[1]); w.y = pack2(v[2], v[3]);
            *(u32x2*)(UX + (size_t)(g * 512 + b * 128 + (l >> 4)) * 512 + (l & 15) * 16 + h) = w; }
        else if (n < 2048) { w.x = pack2(v[0] * QSCALE, v[1] * QSCALE); w.y = pack2(v[2] * QSCALE, v[3] * QSCALE); *(u32x2*)(Q + (size_t)t * 1024 + (n - 1024)) = w; }
        else if (n < 3072) { w.x = pack2(v[0], v[1]); w.y = pack2(v[2], v[3]); *(u32x2*)(K + (size_t)t * 1024 + (n - 2048)) = w; }
        else { w.x = pack2(v[0], v[1]); w.y = pack2(v[2], v[3]); *(u32x2*)(V + (size_t)t * 1024 + (n - 3072)) = w; }
    }
    static constexpr bool ROWSTORE = true; static constexpr int TILE_COLS = 256;
    __device__ __forceinline__ bool use_rows(int n0) const { return n0 >= 1024; }
    __device__ __forceinline__ u32x2 pack4(int, int n, f32x4 v) const { const float s = (n < 2048) ? QSCALE : 1.0f; u32x2 w; w.x = pack2(v[0] * s, v[1] * s); w.y = pack2(v[2] * s, v[3] * s); return w; }
    __device__ __forceinline__ bf16_t* rowptr(int r, int n0) const { return (n0 < 2048 ? Q + (n0 - 1024) : (n0 < 3072 ? K + (n0 - 2048) : V + (n0 - 3072))) + (size_t)r * 1024; } };
struct EpiGlu { const bf16_t* Z; const float* bglu; bf16_t* Y; float* SQS;
    __device__ __forceinline__ void store(int t, int n, float v) const { const float gate = v + bglu[n]; const float z = bf2f(Z[(size_t)t * 1024 + n]); Y[(size_t)t * DM + n] = f2bf(z * sigmoid_f(gate)); }
    __device__ __forceinline__ void store2(int, int, float, float) const {}
    __device__ __forceinline__ void store4(int t, int n, f32x4 v) const {
        const f32x4 bb = *(const f32x4*)(bglu + n); const u32x2 zw = *(const u32x2*)(Z + (size_t)t * 1024 + n);
        u32x2 w; w.x = pack2(bflo(zw.x) * sigmoid_f(v[0] + bb[0]), bfhi(zw.x) * sigmoid_f(v[1] + bb[1])); w.y = pack2(bflo(zw.y) * sigmoid_f(v[2] + bb[2]), bfhi(zw.y) * sigmoid_f(v[3] + bb[3]));
        *(u32x2*)(Y + (size_t)t * DM + n) = w; }
    static constexpr bool ROWSTORE = true, ROWSQ = true; static constexpr int TILE_COLS = 256;
    __device__ __forceinline__ bool use_rows(int) const { return true; }
    __device__ __forceinline__ void rowsq(int r, int n0, float ss) const { SQS[(size_t)r * 4 + (n0 >> 8)] = ss; }
    __device__ __forceinline__ u32x2 pack4(int t, int n, f32x4 v) const { const f32x4 bb = *(const f32x4*)(bglu + n); const u32x2 zw = *(const u32x2*)(Z + (size_t)t * 1024 + n);
        u32x2 w; w.x = pack2(bflo(zw.x) * sigmoid_f(v[0] + bb[0]), bfhi(zw.x) * sigmoid_f(v[1] + bb[1])); w.y = pack2(bflo(zw.y) * sigmoid_f(v[2] + bb[2]), bfhi(zw.y) * sigmoid_f(v[3] + bb[3])); return w; }
    __device__ __forceinline__ bf16_t* rowptr(int r, int n0) const { return Y + (size_t)r * DM + n0; } };
struct EpiOut { const float* x; const float* mod; bf16_t* X1; const float* SQS; const float* SQA;
    static constexpr int MIDK = 16;
    __device__ __forceinline__ void row_factors(int row, float& mid, float& end) const {
        const f32x4* ap = (const f32x4*)(SQA + (size_t)row * 16); const f32x4 a0 = ap[0], a1 = ap[1], a2 = ap[2], a3 = ap[3], s4 = *(const f32x4*)(SQS + (size_t)row * 4);
        const float att = (((a0[0] + a0[1]) + (a0[2] + a0[3])) + ((a1[0] + a1[1]) + (a1[2] + a1[3]))) + (((a2[0] + a2[1]) + (a2[2] + a2[3])) + ((a3[0] + a3[1]) + (a3[2] + a3[3])));
        const float ssm = (s4[0] + s4[1]) + (s4[2] + s4[3]);
        const float am = att * (1.0f / 1024.0f) + EPS; end = rsqrtf(am); mid = rsqrtf(ssm * (1.0f / 1024.0f) + EPS) * sqrtf(am); }
    __device__ __forceinline__ void store(int t, int n, float v) const { const int b = t >> 11; X1[(size_t)t * DM + n] = f2bf(x[(size_t)t * DM + n] + mod[b * 12288 + 4096 + n] * v); }
    __device__ __forceinline__ void store2(int, int, float, float) const {}
    __device__ __forceinline__ u32x2 pack4(int t, int n, f32x4 v) const { const int b = t >> 11;
        const f32x4 xv = *(const f32x4*)(x + (size_t)t * DM + n), gt = *(const f32x4*)(mod + b * 12288 + 4096 + n); const f32x4 r = xv + gt * v;
        u32x2 w; w.x = pack2(r[0], r[1]); w.y = pack2(r[2], r[3]); return w; }
    __device__ __forceinline__ void store4(int t, int n, f32x4 v) const { *(u32x2*)(X1 + (size_t)t * DM + n) = pack4(t, n, v); }
    static constexpr bool ROWSTORE = true; static constexpr int TILE_COLS = 256;
    __device__ __forceinline__ bool use_rows(int) const { return true; }
    __device__ __forceinline__ bf16_t* rowptr(int r, int n0) const { return X1 + (size_t)r * DM + n0; } };
struct EpiMoe1 { bf16_t* HID;
    __device__ __forceinline__ void store(int, int, float) const {}
    __device__ __forceinline__ void store2(int r, int n, float g, float u) const { HID[(size_t)r * DFF + n] = f2bf(silu_f(g) * u); }
    __device__ __forceinline__ void store4d(int r, int n, f32x4 g, f32x4 u) const { u32x2 w; w.x = pack2(silu_f(g[0]) * u[0], silu_f(g[1]) * u[1]); w.y = pack2(silu_f(g[2]) * u[2], silu_f(g[3]) * u[3]);
        *(u32x2*)(HID + (size_t)r * DFF + n) = w; }
    static constexpr bool ROWSTORE = true; static constexpr int TILE_COLS = 128;
    __device__ __forceinline__ bool use_rows(int) const { return true; }
    __device__ __forceinline__ u32x2 pack4d(int, int, f32x4 g, f32x4 u) const { u32x2 w; w.x = pack2(silu_f(g[0]) * u[0], silu_f(g[1]) * u[1]); w.y = pack2(silu_f(g[2]) * u[2], silu_f(g[3]) * u[3]); return w; }
    __device__ __forceinline__ bf16_t* rowptr(int r, int n0) const { return HID + (size_t)r * DFF + n0; } };
struct EpiMoe2 { bf16_t* YE; const float* waff; int e;
    __device__ __forceinline__ void store(int r, int n, float v) const { const int b = r >> 8; YE[(size_t)r * DM + n] = f2bf(v * waff[(b * NE + e) * CAP + (r & 255)]); }
    __device__ __forceinline__ void store2(int, int, float, float) const {}
    __device__ __forceinline__ void store4(int r, int n, f32x4 v) const { const int b = r >> 8; const float a = waff[(b * NE + e) * CAP + (r & 255)];
        u32x2 w; w.x = pack2(v[0] * a, v[1] * a); w.y = pack2(v[2] * a, v[3] * a); *(u32x2*)(YE + (size_t)r * DM + n) = w; }
    static constexpr bool ROWSTORE = true; static constexpr int TILE_COLS = 256;
    __device__ __forceinline__ bool use_rows(int) const { return true; }
    __device__ __forceinline__ u32x2 pack4(int r, int, f32x4 v) const { const int b = r >> 8; const float a = waff[(b * NE + e) * CAP + (r & 255)]; u32x2 w; w.x = pack2(v[0] * a, v[1] * a); w.y = pack2(v[2] * a, v[3] * a); return w; }
    __device__ __forceinline__ bf16_t* rowptr(int r, int n0) const { return YE + (size_t)r * DM + n0; } };

template <class AF, class BF, class EF, bool DUAL>
__device__ __forceinline__ void gemm_naive_tile(float* lds, const AF& A, const BF& Bm, const EF& E, int m0, int n0, int K) {
    float* As = lds;
    float* Bs = lds + 16 * 132;
    float* Bs2 = Bs + 16 * 68;
    float acc[4][4], acc2[4][4];
#pragma unroll
    for (int i = 0; i < 4; ++i)
#pragma unroll
        for (int j = 0; j < 4; ++j) { acc[i][j] = 0.f; acc2[i][j] = 0.f; }
    const int tid = threadIdx.x, tm = tid >> 4, tn = tid & 15;
    const int ar = tid >> 2, ak = (tid & 3) * 4;
    const bf16_t* ap = A.ptr(m0 + ar);
    const int bk = tid >> 5, bc = (tid & 31) * 2;
    for (int k0 = 0; k0 < K; k0 += 16) {
        const u32x2 av = *(const u32x2*)(ap + k0 + ak);
        As[(ak + 0) * 132 + ar] = bflo(av.x); As[(ak + 1) * 132 + ar] = bfhi(av.x); As[(ak + 2) * 132 + ar] = bflo(av.y); As[(ak + 3) * 132 + ar] = bfhi(av.y);
        Bs[bk * 68 + bc] = Bm.get(k0 + bk, n0 + bc); Bs[bk * 68 + bc + 1] = Bm.get(k0 + bk, n0 + bc + 1);
        if (DUAL) { Bs2[bk * 68 + bc] = Bm.get2(k0 + bk, n0 + bc); Bs2[bk * 68 + bc + 1] = Bm.get2(k0 + bk, n0 + bc + 1); }
        __syncthreads();
#pragma unroll
        for (int kk = 0; kk < 16; ++kk) {
            const f32x4 a4 = *(const f32x4*)(As + kk * 132 + tm * 4);
            const f32x4 b4 = *(const f32x4*)(Bs + kk * 68 + tn * 4);
#pragma unroll
            for (int i = 0; i < 4; ++i)
#pragma unroll
                for (int j = 0; j < 4; ++j) acc[i][j] += a4[i] * b4[j];
            if (DUAL) {
                const f32x4 c4 = *(const f32x4*)(Bs2 + kk * 68 + tn * 4);
#pragma unroll
                for (int i = 0; i < 4; ++i)
#pragma unroll
                    for (int j = 0; j < 4; ++j) acc2[i][j] += a4[i] * c4[j];
            }
        }
        __syncthreads();
    }
#pragma unroll
    for (int i = 0; i < 4; ++i)
#pragma unroll
        for (int j = 0; j < 4; ++j) { if (DUAL) E.store2(m0 + tm * 4 + i, n0 + tn * 4 + j, acc[i][j], acc2[i][j]); else E.store(m0 + tm * 4 + i, n0 + tn * 4 + j, acc[i][j]); }
}

struct Frame {
    const float* in[26]; float* out; unsigned char* ws; unsigned char* lds;
    int tid, lane, wave, G, bid;
    __device__ __forceinline__ float* modp() const { return (float*)(ws + WS_MOD); }
};

__device__ __forceinline__ void p_ada(const Frame& F, int u_first, int u_step, int u_end) {
    float* sc = (float*)F.lds;
    float* red = sc + 4 * 2048;
    const float* c = F.in[I_C]; const float* w = F.in[I_WADA]; const float* bias = F.in[I_BADA];
    for (int i = F.tid; i < 4 * 2048; i += NT) sc[i] = silu_f(c[i]);
    __syncthreads();
    const int cq = F.tid & 7, kq = F.tid >> 3;
    f32x4 wv[16];
#define ADA_LOAD(u_) do { const int kh_ = (u_) & 1, n0_ = ((u_) >> 1) * 32 + cq * 4, kb_ = kh_ * 1024 + kq; \
        _Pragma("unroll") for (int q = 0; q < 16; ++q) wv[q] = __builtin_nontemporal_load((const f32x4*)(w + (size_t)(kb_ + 64 * q) * 12288 + n0_)); } while (0)
    if (u_first < u_end) ADA_LOAD(u_first);
    for (int u = u_first; u < u_end; u += u_step) {
        const int kh = u & 1, kb = kh * 1024 + kq;
        float acc[4][4];
#pragma unroll
        for (int b = 0; b < 4; ++b)
#pragma unroll
            for (int j = 0; j < 4; ++j) acc[b][j] = 0.f;
#pragma unroll
        for (int q = 0; q < 16; ++q)
#pragma unroll
            for (int b = 0; b < 4; ++b) { const float s = sc[b * 2048 + kb + 64 * q];
#pragma unroll
                for (int j = 0; j < 4; ++j) acc[b][j] += s * wv[q][j]; }
        if (u + u_step < u_end) ADA_LOAD(u + u_step);
#pragma unroll
        for (int b = 0; b < 4; ++b)
#pragma unroll
            for (int j = 0; j < 4; ++j) red[(kq * 8 + cq) * 16 + b * 4 + j] = acc[b][j];
        __syncthreads();
        if (F.tid < 128) {
            const int b = F.tid >> 5, col = F.tid & 31;
            float s = 0.f;
            for (int q = 0; q < 64; ++q) s += red[(q * 8 + (col >> 2)) * 16 + b * 4 + (col & 3)];
            const int n = (u >> 1) * 32 + col;
            atomicAdd(F.modp() + b * 12288 + n, kh == 0 ? s + bias[n] : s);
        }
        __syncthreads();
    }
#undef ADA_LOAD
}

template <bool SCALE> __device__ __forceinline__ void wconv_range(const f32x4* s, u32x4* d, int n, int start, int stride, const float* gs, const float* ga) {
    for (int i = start; i < n; i += 4 * stride) {
        f32x4 a[4], b[4];
#pragma unroll
        for (int j = 0; j < 4; ++j) { int ii = i + j * stride; ii = ii < n ? ii : n - 1; a[j] = __builtin_nontemporal_load(s + 2 * ii); b[j] = __builtin_nontemporal_load(s + 2 * ii + 1); }
#pragma unroll
        for (int j = 0; j < 4; ++j) { const int ii = i + j * stride;
            if (ii < n) { float g = 1.0f; if (SCALE) { const int k = ii >> 8; g = k < 1024 ? gs[k] : ga[k - 1024]; }
                u32x4 w; w.x = pack2(a[j][0] * g, a[j][1] * g); w.y = pack2(a[j][2] * g, a[j][3] * g); w.z = pack2(b[j][0] * g, b[j][1] * g); w.w = pack2(b[j][2] * g, b[j][3] * g); d[ii] = w; } }
    }
}
__device__ __forceinline__ void p_wconv(const Frame& F, int rank, int nblk) {
    wconv_range<false>((const f32x4*)F.in[I_WIN], (u32x4*)(F.ws + WS_WINB), DM * DINP / 8, rank * NT + F.tid, nblk * NT, nullptr, nullptr);
    wconv_range<false>((const f32x4*)F.in[I_WGLU], (u32x4*)(F.ws + WS_WGLUB), 1024 * 1024 / 8, rank * NT + F.tid, nblk * NT, nullptr, nullptr);
    wconv_range<true>((const f32x4*)F.in[I_WOUT], (u32x4*)(F.ws + WS_WOUTB), DM * DM / 8, rank * NT + F.tid, nblk * NT, F.in[I_GSSM], F.in[I_GATT]);
}
__device__ __forceinline__ void p_h1(const Frame& F) {
    const float* x = F.in[I_X]; const float* g = F.in[I_GMIX]; const float* mod = F.modp(); bf16_t* H1 = (bf16_t*)(F.ws + WS_H1);
    for (int c = F.bid * 8 + F.wave; c < TOK / 4; c += F.G * 8) {
        const int t0 = 4 * c, b = t0 >> 11;
        f32x4 xr[4][8];
#pragma unroll
        for (int i = 0; i < 8; ++i) xr[0][i] = __builtin_nontemporal_load((const f32x4*)(x + (size_t)t0 * DM + i * 256 + F.lane * 4));
        f32x4 ga[8], sb[8];
#pragma unroll
        for (int i = 0; i < 8; ++i) { const int k = i * 256 + F.lane * 4;
            const f32x4 gv = *(const f32x4*)(g + k), sc = *(const f32x4*)(mod + b * 12288 + 2048 + k); sb[i] = *(const f32x4*)(mod + b * 12288 + k);
#pragma unroll
            for (int j = 0; j < 4; ++j) ga[i][j] = gv[j] * (1.0f + sc[j]); }
#pragma unroll
        for (int r = 1; r < 4; ++r)
#pragma unroll
            for (int i = 0; i < 8; ++i) xr[r][i] = __builtin_nontemporal_load((const f32x4*)(x + (size_t)(t0 + r) * DM + i * 256 + F.lane * 4));
#pragma unroll
        for (int r = 0; r < 4; ++r) {
            float ss = 0.f;
#pragma unroll
            for (int i = 0; i < 8; ++i) ss += xr[r][i][0] * xr[r][i][0] + xr[r][i][1] * xr[r][i][1] + xr[r][i][2] * xr[r][i][2] + xr[r][i][3] * xr[r][i][3];
            ss = wave_sum(ss);
            const float rstd = rsqrtf(ss * (1.0f / DM) + EPS);
#pragma unroll
            for (int i = 0; i < 8; ++i) { const int k = i * 256 + F.lane * 4;
                float o[4];
#pragma unroll
                for (int j = 0; j < 4; ++j) o[j] = (xr[r][i][j] * rstd) * ga[i][j] + sb[i][j];
                u32x2 w; w.x = pack2(o[0], o[1]); w.y = pack2(o[2], o[3]);
                *(u32x2*)(H1 + (size_t)(t0 + r) * DM + k) = w; }
        }
    }
}

__device__ __forceinline__ void p_inproj_naive(const Frame& F) {
    const ARows A{(const bf16_t*)(F.ws + WS_H1), DM}; const BF32 Bm{F.in[I_WIN], DINP};
    const EpiInProj E{(bf16_t*)(F.ws + WS_UX), (bf16_t*)(F.ws + WS_Q), (bf16_t*)(F.ws + WS_K), (bf16_t*)(F.ws + WS_V)};
    const int nM = TOK / 128, nN = DINP / 64;
    for (int u = F.bid; u < nM * nN; u += F.G) gemm_naive_tile<ARows, BF32, EpiInProj, false>((float*)F.lds, A, Bm, E, (u / nN) * 128, (u % nN) * 64, DM);
}
__device__ __forceinline__ void p_glu_naive(const Frame& F) {
    const ARows A{(const bf16_t*)(F.ws + WS_ZB), 1024}; const BF32 Bm{F.in[I_WGLU], 1024};
    const EpiGlu E{(const bf16_t*)(F.ws + WS_ZB), F.in[I_BGLU], (bf16_t*)(F.ws + WS_MIX), (float*)(F.ws + WS_SQS)};
    const int nM = TOK / 128, nN = 1024 / 64;
    for (int u = F.bid; u < nM * nN; u += F.G) gemm_naive_tile<ARows, BF32, EpiGlu, false>((float*)F.lds, A, Bm, E, (u / nN) * 128, (u % nN) * 64, 1024);
}
__device__ __forceinline__ void p_outproj_naive(const Frame& F) {
    const ARows A{(const bf16_t*)(F.ws + WS_MIX), DM}; const BF32 Bm{F.in[I_WOUT], DM};
    const EpiOut E{F.in[I_X], F.modp(), (bf16_t*)(F.ws + WS_X1)};
    const int nM = TOK / 128, nN = DM / 64;
    for (int u = F.bid; u < nM * nN; u += F.G) gemm_naive_tile<ARows, BF32, EpiOut, false>((float*)F.lds, A, Bm, E, (u / nN) * 128, (u % nN) * 64, DM);
}
__device__ __forceinline__ void p_moe1_naive(const Frame& F) {
    const int nM = 1024 / 128, nN = DFF / 64;
    for (int u = F.bid; u < NE * nM * nN; u += F.G) {
        const int e = u / (nM * nN), r = u % (nM * nN);
        const AGather A{(const bf16_t*)(F.ws + WS_H2), (const int*)(F.ws + WS_IDX), e, 0u};
        const BF32Dual Bm{F.in[I_WGATE] + (size_t)e * DM * DFF, F.in[I_WUP] + (size_t)e * DM * DFF, DFF};
        const EpiMoe1 E{(bf16_t*)(F.ws + WS_HID) + (size_t)e * 1024 * DFF};
        gemm_naive_tile<AGather, BF32Dual, EpiMoe1, true>((float*)F.lds, A, Bm, E, (r / nN) * 128, (r % nN) * 64, DM);
    }
}
__device__ __forceinline__ void p_moe2_naive(const Frame& F) {
    const int nM = 1024 / 128, nN = DM / 64;
    for (int u = F.bid; u < NE * nM * nN; u += F.G) {
        const int e = u / (nM * nN), r = u % (nM * nN);
        const ARows A{(const bf16_t*)(F.ws + WS_HID) + (size_t)e * 1024 * DFF, DFF};
        const BF32 Bm{F.in[I_WDOWN] + (size_t)e * DFF * DM, DM};
        const EpiMoe2 E{(bf16_t*)(F.ws + WS_YE) + (size_t)e * 1024 * DM, (const float*)(F.ws + WS_WAFF), e};
        gemm_naive_tile<ARows, BF32, EpiMoe2, false>((float*)F.lds, A, Bm, E, (r / nN) * 128, (r % nN) * 64, DFF);
    }
}

__host__ __device__ __forceinline__ int lds_byte(int r, int c) { const int st = (r >> 4) * 2 + (c >> 5), rr = r & 15, cc = c & 31, ob = rr * 64 + cc * 2; return st * 1024 + (ob ^ (((ob >> 9) & 1) << 5)); }
__host__ __device__ __forceinline__ void stage_rc(int b, int& R, int& C) { const int st = b / 1024, sb = b % 1024, swz = sb ^ (((sb >> 9) & 1) << 5); R = (st >> 1) * 16 + swz / 64; C = (st & 1) * 32 + (swz % 64) / 2; }


template <class T, class = void> struct epi_rowstore { static constexpr bool value = false; };
template <class T> struct epi_rowstore<T, decltype((void)T::ROWSTORE)> { static constexpr bool value = true; };
template <class T, class = void> struct epi_rowsq { static constexpr bool value = false; };
template <class T> struct epi_rowsq<T, decltype((void)T::ROWSQ)> { static constexpr bool value = true; };
template <class T, class = void> struct epi_mid { static constexpr bool value = false; };
template <class T> struct epi_mid<T, decltype((void)T::MIDK)> { static constexpr bool value = true; };
struct EpiMoe1Part { float* part;
    __device__ __forceinline__ void store4d(int r, int n, f32x4 g, f32x4 u) const { *(f32x4*)(part + (size_t)(r & 255) * 128 + (n & 127)) = g; *(f32x4*)(part + 32768 + (size_t)(r & 255) * 128 + (n & 127)) = u; } };
struct EpiMoe1Comb { bf16_t* HID; const float* part; unsigned* flag; unsigned* tmo;
    __device__ __forceinline__ void store4d(int r, int n, f32x4 g, f32x4 u) const {
        const f32x4 pg = *(const f32x4*)(part + (size_t)(r & 255) * 128 + (n & 127)), pu = *(const f32x4*)(part + 32768 + (size_t)(r & 255) * 128 + (n & 127));
        g += pg; u += pu;
        u32x2 w; w.x = pack2(silu_f(g[0]) * u[0], silu_f(g[1]) * u[1]); w.y = pack2(silu_f(g[2]) * u[2], silu_f(g[3]) * u[3]);
        *(u32x2*)(HID + (size_t)r * DFF + n) = w; } };
template <class EF> __device__ __forceinline__ void epi_pre(const EF&) {}
__device__ __forceinline__ void epi_pre(const EpiMoe1Comb& E) {
    if (threadIdx.x == 0) { unsigned sp = 0;
        while (__hip_atomic_load(E.flag, __ATOMIC_RELAXED, __HIP_MEMORY_SCOPE_AGENT) == 0u) { __builtin_amdgcn_s_sleep(2);
            if ((++sp & 255u) == 0u) { if (__hip_atomic_load(E.tmo, __ATOMIC_RELAXED, __HIP_MEMORY_SCOPE_AGENT)) break; if (sp > (1u << 20)) { atomicAdd(E.tmo, 1u); break; } } }
        __builtin_amdgcn_fence(__ATOMIC_ACQUIRE, "agent"); asm volatile("s_waitcnt vmcnt(0)" ::: "memory"); }
    __syncthreads();
}
__device__ __forceinline__ void gload16_asm(f32x4& dst, const void* sbase, unsigned voff) { asm volatile("global_load_dwordx4 %0, %1, %2" : "=v"(dst) : "v"(voff), "s"(sbase)); }
template <int N> __device__ __forceinline__ void wait_vm1(f32x4& r) { asm volatile("s_waitcnt vmcnt(%1)" : "+v"(r) : "n"(N)); }
template <int N> __device__ __forceinline__ void wait_vm8(f32x4 (&r)[8]) { asm volatile("s_waitcnt vmcnt(%8)" : "+v"(r[0]), "+v"(r[1]), "+v"(r[2]), "+v"(r[3]), "+v"(r[4]), "+v"(r[5]), "+v"(r[6]), "+v"(r[7]) : "n"(N)); }
__device__ __forceinline__ void glds16n(const void* sbase, unsigned voff, unsigned lds_dst) {
    unsigned keep;
    asm volatile("s_mov_b32 %0, m0\n\ts_mov_b32 m0, %3\n\ts_nop 0\n\tglobal_load_lds_dwordx4 %1, %2\n\ts_mov_b32 m0, %0" : "=&s"(keep) : "v"(voff), "s"(sbase), "s"(lds_dst));
}
struct B2F32 {
    const float* base; unsigned ld; static constexpr int NL = 8;
    unsigned loff, bw0, bw1; int wid;
    __device__ __forceinline__ void init(int lane, int wid_) { wid = wid_; loff = (unsigned)lane * 16u; bw0 = (unsigned)(wid * 512 + ((8 * lane) ^ ((wid & 3) * 32))); bw1 = bw0 ^ 128u; }
    __device__ __forceinline__ void issue(int kt, int i, f32x4& r) const { gload16_asm(r, base + (size_t)(kt * 64 + wid + 8 * i) * ld, loff); }
    __device__ __forceinline__ void write1(LAS unsigned char* st, int i, const f32x4& r) const { u32x2 w; w.x = pack2(r[0], r[1]); w.y = pack2(r[2], r[3]); *(LAS u32x2*)(st + ((i & 1) ? bw1 : bw0) + i * 4096) = w; }
};
struct B2F32Dual {
    const float* g; const float* u; unsigned ld; static constexpr int NL = 8;
    unsigned loff, bw0, bw1; int wid;
    __device__ __forceinline__ void init(int lane, int wid_) { wid = wid_; loff = (unsigned)(lane >> 5) * ld * 4u + (unsigned)(lane & 31) * 16u;
        const int k = 2 * wid + (lane >> 5), slot = (k & 3) | ((k >> 1) & 4);
        bw0 = (unsigned)(k * 512 + ((8 * (lane & 31)) ^ (slot * 32))); bw1 = bw0 ^ 256u; }
    __device__ __forceinline__ void issue(int kt, int i, f32x4& r) const { gload16_asm(r, ((i >> 2) ? u : g) + (size_t)(kt * 64 + 2 * wid + 16 * (i & 3)) * ld, loff); }
    __device__ __forceinline__ void write1(LAS unsigned char* st, int i, const f32x4& r) const { u32x2 w; w.x = pack2(r[0], r[1]); w.y = pack2(r[2], r[3]); *(LAS u32x2*)(st + ((i >> 2) ? bw1 : bw0) + (i & 3) * 8192) = w; }
};
struct B2Bf16 {
    const bf16_t* base; unsigned ld; static constexpr int NL = 4;
    unsigned loff, bw0; int wid;
    __device__ __forceinline__ void init(int lane, int wid_) { wid = wid_; loff = (unsigned)(lane >> 5) * ld * 2u + (unsigned)(lane & 31) * 16u;
        const int k = 2 * wid + (lane >> 5), slot = (k & 3) | ((k >> 1) & 4); bw0 = (unsigned)(k * 512 + ((16 * (lane & 31)) ^ (slot * 32))); }
    __device__ __forceinline__ void issue(int kt, int i, f32x4& r) const { gload16_asm(r, base + (size_t)(kt * 64 + 2 * wid + 16 * i) * ld, loff); }
    __device__ __forceinline__ void write1(LAS unsigned char* st, int i, const f32x4& r) const { *(LAS f32x4*)(st + bw0 + i * 8192) = r; }
};

struct NoPf { __device__ __forceinline__ void issue(float (&)[3]) const {} __device__ __forceinline__ void retire(float (&)[3]) const {} };
struct PfLines { const void* a; const float* b0; const float* b1; bool on;
    __device__ __forceinline__ void issue(float (&v)[3]) const { if (on) { v[0] = *(const float*)a; v[1] = *b0; v[2] = *b1; } }
    __device__ __forceinline__ void retire(float (&v)[3]) const { asm volatile("" :: "v"(v[0]), "v"(v[1]), "v"(v[2])); } };
template <class AF, class BL, class EF, bool DUAL, int ABL = 0, class PF = NoPf>
__device__ __forceinline__ void gemm_tile2(unsigned char* ldsg, const AF& A, BL Bl, const EF& E, int m0, int n0, int K, const PF pf = PF()) {
    LAS unsigned char* lds = (LAS unsigned char*)ldsg;
    const unsigned lds0 = (unsigned)(uintptr_t)lds;
    const int tid = threadIdx.x, lane = tid & 63, wid = __builtin_amdgcn_readfirstlane(tid >> 6), wr = wid >> 2, wc = wid & 3, fr = lane & 15, fq = lane >> 4;
    const int nt = K / 64;
    constexpr int NL = BL::NL;
    const bf16_t* abase = A.base;
    unsigned aso[4];
#pragma unroll
    for (int p = 0; p < 4; ++p) { const int row = p * 64 + (tid >> 3), ch = (tid & 7) ^ ((row >> 1) & 7); aso[p] = (A.off(m0 + row) + (unsigned)(ch * 8)) * 2u; }
    Bl.init(lane, wid);
    const unsigned ao0 = (unsigned)((wr * 128 + fr) * 128 + (((0 + fq) ^ ((fr >> 1) & 7)) << 4));
    const unsigned ao1 = (unsigned)((wr * 128 + fr) * 128 + (((4 + fq) ^ ((fr >> 1) & 7)) << 4));
    unsigned boffn[4];
    { const int G = fq, q = fr >> 2, p = fr & 3, slot = q | ((G & 1) << 2);
#pragma unroll
      for (int ni = 0; ni < 4; ++ni) { const int colb = DUAL ? (ni >> 1) * 256 + wc * 64 + (ni & 1) * 32 : wc * 128 + ni * 32;
          boffn[ni] = (unsigned)((8 * G + q) * 512 + ((colb ^ (slot * 32)) + 8 * p)); } }
    f32x4 acc[8][4];
#pragma unroll
    for (int mi = 0; mi < 8; ++mi)
#pragma unroll
        for (int ni = 0; ni < 4; ++ni) acc[mi][ni] = (f32x4){0.f, 0.f, 0.f, 0.f};
    f32x4 breg[8];
#define G2_DMA(piece, soff, kt) if (ABL != 4 && ABL != 5) glds16n(abase, aso[piece] + (unsigned)(kt) * 128u, lds0 + (unsigned)(soff) + (unsigned)((piece) * 8192 + wid * 1024))
#define G2_RDB(dst, sbp, ni, ks) do { if (ABL == 3) { asm volatile("" : "+v"(dst)); break; } const s16x4 lo_ = __builtin_amdgcn_ds_read_tr16_b64_v4i16((LAS s16x4*)((sbp) + boffn[ni] + ((ks) * 32) * 512)); \
        const s16x4 hi_ = __builtin_amdgcn_ds_read_tr16_b64_v4i16((LAS s16x4*)((sbp) + boffn[ni] + ((ks) * 32 + 4) * 512)); \
        dst = (bf16x8){lo_[0], lo_[1], lo_[2], lo_[3], hi_[0], hi_[1], hi_[2], hi_[3]}; } while (0)
#define G2_RDA(sap, mi, ks) (ABL == 3 ? a_[9] : *(const LAS bf16x8*)((sap) + ((ks) ? ao1 : ao0) + (mi) * 2048))
#define G2_MMA(mi, afr, bfr) do { if (ABL == 1) { asm volatile("" :: "v"(afr), "v"(bfr[0]), "v"(bfr[1]), "v"(bfr[2]), "v"(bfr[3])); } else { _Pragma("unroll") for (int ni_ = 0; ni_ < 4; ++ni_) acc[mi][ni_] = __builtin_amdgcn_mfma_f32_16x16x32_bf16(bfr[ni_], afr, acc[mi][ni_], 0, 0, 0); } } while (0)
#pragma unroll
    for (int p = 0; p < 4; ++p) G2_DMA(p, 0, 0);
#pragma unroll
    for (int i = 0; i < NL; ++i) { if (ABL != 2 && ABL != 5) Bl.issue(0, i, breg[i]); }
#pragma unroll
    for (int p = 0; p < 4; ++p) G2_DMA(p, 32768, 1);
    float rf_mid0 = 1.f, rf_mid1 = 1.f, rf_end0 = 1.f, rf_end1 = 1.f;
    if constexpr (epi_mid<EF>::value) { E.row_factors(m0 + wr * 128 + fq * 16 + fr, rf_mid0, rf_end0); E.row_factors(m0 + wr * 128 + 64 + fq * 16 + fr, rf_mid1, rf_end1);
        asm volatile("" : "+v"(rf_mid0), "+v"(rf_mid1), "+v"(rf_end0), "+v"(rf_end1)); }
    wait_vm8<4>(breg);
#pragma unroll
    for (int i = 0; i < NL; ++i) Bl.write1(lds + 98304, i, breg[i]);
#pragma unroll
    for (int i = 0; i < NL; ++i) { if (ABL != 2 && ABL != 5) Bl.issue(1, i, breg[i]); }
    asm volatile("s_waitcnt lgkmcnt(0)" ::: "memory"); __builtin_amdgcn_s_barrier(); asm volatile("" ::: "memory");
    int sa_cur = 0, sa_nn = 65536;
#define G2_S0(MODE, t, mi) do { \
            if ((mi) + 2 < 8) a_[(mi) + 2] = G2_RDA(sap, (mi) + 2, 0); else a_[(mi) + 2] = G2_RDA(sap, (mi) - 6, 1); \
            if ((mi) >= 4) G2_RDB(b1[((mi) - 4) & 3], sbp, ((mi) - 4) & 3, 1); \
            if (MODE == 0 && (mi) < 4) G2_DMA((mi) & 3, sa_nn, (t) + 2); \
            if (NL == 8 && MODE <= 1 && (mi) >= 4) { if (MODE == 0) wait_vm1<NL + 3>(breg[((mi) - 4) & 7]); else wait_vm1<((NL - 1 - ((mi) - 4)) > 0 ? (NL - 1 - ((mi) - 4)) : 0)>(breg[((mi) - 4) & 7]); \
                Bl.write1(sbn, ((mi) - 4) & 7, breg[((mi) - 4) & 7]); if (MODE == 0 && ABL != 2 && ABL != 5) Bl.issue((t) + 2, ((mi) - 4) & 7, breg[((mi) - 4) & 7]); } \
            G2_MMA(mi, a_[mi], b0); \
            __builtin_amdgcn_sched_barrier(0); } while (0)
#define G2_S1(MODE, t, mi) do { \
            if ((mi) + 2 < 8) a_[(mi) + 2] = G2_RDA(sap, (mi) + 2, 1); \
            if (NL == 4 && MODE <= 1 && (mi) < NL) { if (MODE == 0) wait_vm1<NL + 3>(breg[mi]); else wait_vm1<((NL - 1 - (mi)) > 0 ? (NL - 1 - (mi)) : 0)>(breg[mi]); \
                Bl.write1(sbn, mi, breg[mi]); if (MODE == 0 && ABL != 2 && ABL != 5) Bl.issue((t) + 2, mi, breg[mi]); } \
            if (NL == 8 && MODE <= 1 && (mi) < 4) { if (MODE == 0) wait_vm1<NL + 3>(breg[(mi) + 4]); else wait_vm1<((NL - 1 - ((mi) + 4)) > 0 ? (NL - 1 - ((mi) + 4)) : 0)>(breg[(mi) + 4]); \
                Bl.write1(sbn, (mi) + 4, breg[(mi) + 4]); if (MODE == 0 && ABL != 2 && ABL != 5) Bl.issue((t) + 2, (mi) + 4, breg[(mi) + 4]); } \
            G2_MMA(mi, a_[mi], b1); \
            __builtin_amdgcn_sched_barrier(0); } while (0)
#define G2_KTILE(MODE, t) do { \
        LAS unsigned char* sap = lds + sa_cur; LAS unsigned char* sbp = lds + 98304 + ((t) & 1) * 32768; LAS unsigned char* sbn = lds + 98304 + (((t) + 1) & 1) * 32768; \
        bf16x8 b0[4], b1[4], a_[10]; if (ABL == 3) { _Pragma("unroll") for (int z_ = 0; z_ < 10; ++z_) a_[z_] = (bf16x8){0,0,0,0,0,0,0,0}; _Pragma("unroll") for (int z_ = 0; z_ < 4; ++z_) { b0[z_] = a_[0]; b1[z_] = a_[0]; } } \
        G2_RDB(b0[0], sbp, 0, 0); G2_RDB(b0[1], sbp, 1, 0); G2_RDB(b0[2], sbp, 2, 0); G2_RDB(b0[3], sbp, 3, 0); \
        a_[0] = G2_RDA(sap, 0, 0); a_[1] = G2_RDA(sap, 1, 0); \
        G2_S0(MODE, t, 0); G2_S0(MODE, t, 1); G2_S0(MODE, t, 2); G2_S0(MODE, t, 3); G2_S0(MODE, t, 4); G2_S0(MODE, t, 5); G2_S0(MODE, t, 6); G2_S0(MODE, t, 7); \
        a_[0] = a_[8]; a_[1] = a_[9]; \
        G2_S1(MODE, t, 0); G2_S1(MODE, t, 1); G2_S1(MODE, t, 2); G2_S1(MODE, t, 3); G2_S1(MODE, t, 4); G2_S1(MODE, t, 5); G2_S1(MODE, t, 6); G2_S1(MODE, t, 7); \
        asm volatile("s_waitcnt lgkmcnt(0)" ::: "memory"); __builtin_amdgcn_s_barrier(); asm volatile("" ::: "memory"); \
        sa_cur = (sa_cur == 65536) ? 0 : sa_cur + 32768; sa_nn = (sa_nn == 65536) ? 0 : sa_nn + 32768; } while (0)
    int t = 0;
    if constexpr (epi_mid<EF>::value) {
        for (; t < EF::MIDK; ++t) G2_KTILE(0, t);
#pragma unroll
        for (int mi = 0; mi < 8; ++mi) { const float sc = __shfl(mi < 4 ? rf_mid0 : rf_mid1, (mi & 3) * 16 + fr);
#pragma unroll
            for (int ni = 0; ni < 4; ++ni) acc[mi][ni] *= sc; }
    }
    for (; t < nt - 2; ++t) G2_KTILE(0, t);
    G2_KTILE(1, t); ++t;
    G2_KTILE(2, t);
#undef G2_KTILE
#undef G2_S0
#undef G2_S1
#undef G2_DMA
#undef G2_RDB
#undef G2_RDA
#undef G2_MMA
    epi_pre(E);
    float pfv[3] = {0.f, 0.f, 0.f}; pf.issue(pfv);
    int fr2 = fr, fq2 = fq; asm volatile("" : "+v"(fr2), "+v"(fq2));
    if constexpr (epi_mid<EF>::value) {
#pragma unroll
        for (int mi = 0; mi < 8; ++mi) { const float sc = __shfl(mi < 4 ? rf_end0 : rf_end1, (mi & 3) * 16 + fr2);
#pragma unroll
            for (int ni = 0; ni < 4; ++ni) acc[mi][ni] *= sc; }
    }
    if constexpr (epi_rowstore<EF>::value) { if (E.use_rows(n0)) {
        constexpr int RB = EF::TILE_COLS * 2, RS = RB + 16;
#pragma unroll
        for (int mi = 0; mi < 8; ++mi) { const int rl = wr * 128 + mi * 16 + fr2, row = m0 + rl;
            if constexpr (DUAL) {
#pragma unroll
                for (int ni = 0; ni < 2; ++ni) { const int cl = wc * 32 + ni * 16 + 4 * fq2; *(LAS u32x2*)(lds + rl * RS + cl * 2) = E.pack4d(row, n0 + cl, acc[mi][ni], acc[mi][ni + 2]); }
            } else {
#pragma unroll
                for (int ni = 0; ni < 4; ++ni) { const int cl = wc * 64 + ni * 16 + 4 * fq2; *(LAS u32x2*)(lds + rl * RS + cl * 2) = E.pack4(row, n0 + cl, acc[mi][ni]); }
            } }
        asm volatile("s_waitcnt lgkmcnt(0)" ::: "memory"); __builtin_amdgcn_s_barrier(); asm volatile("" ::: "memory");
        constexpr int LPR = RB / 16, RPI = 64 / LPR;
#pragma unroll
        for (int it = 0; it < 32 / RPI; ++it) { const int rl = wid * 32 + it * RPI + lane / LPR, ch = lane % LPR;
            const u32x4 w = *(const LAS u32x4*)(lds + rl * RS + ch * 16);
            *(u32x4*)(E.rowptr(m0 + rl, n0) + ch * 8) = w;
            if constexpr (epi_rowsq<EF>::value) {
                float ss = bflo(w.x) * bflo(w.x) + bfhi(w.x) * bfhi(w.x) + bflo(w.y) * bflo(w.y) + bfhi(w.y) * bfhi(w.y) + bflo(w.z) * bflo(w.z) + bfhi(w.z) * bfhi(w.z) + bflo(w.w) * bflo(w.w) + bfhi(w.w) * bfhi(w.w);
#pragma unroll
                for (int m = 1; m < LPR; m <<= 1) ss += __shfl_xor(ss, m);
                if (ch == 0) E.rowsq(m0 + rl, n0, ss); } }
        asm volatile("s_waitcnt lgkmcnt(0)" ::: "memory"); __builtin_amdgcn_s_barrier(); asm volatile("" ::: "memory");
        pf.retire(pfv);
        return;
    } }
#pragma unroll
    for (int mi = 0; mi < 8; ++mi) {
        const int row = m0 + wr * 128 + mi * 16 + fr2;
        if constexpr (DUAL) {
#pragma unroll
            for (int ni = 0; ni < 2; ++ni) E.store4d(row, n0 + wc * 32 + ni * 16 + 4 * fq2, acc[mi][ni], acc[mi][ni + 2]);
        } else {
#pragma unroll
            for (int ni = 0; ni < 4; ++ni) E.store4(row, n0 + wc * 64 + ni * 16 + 4 * fq2, acc[mi][ni]);
        }
    }
    pf.retire(pfv);
}


namespace pg8 {
#define PG8_LAS __attribute__((address_space(3)))
typedef unsigned short bf16_t;
typedef short bf16x8 __attribute__((ext_vector_type(8)));
typedef float f32x4 __attribute__((ext_vector_type(4)));
typedef unsigned u32x4 __attribute__((ext_vector_type(4)));
constexpr int BM = 256, BK = 64, HALF = 128, HTB = HALF * BK * 2  , STAGE_BYTES = 8 * HTB, NXCD = 8, WGM = 8;

__host__ __device__ __forceinline__ int lds_byte(int r, int c) { const int st = (r >> 4) * 2 + (c >> 5), rr = r & 15, cc = c & 31, ob = rr * 64 + cc * 2; return st * 1024 + (ob ^ (((ob >> 9) & 1) << 5)); }
__host__ __device__ __forceinline__ void stage_rc(int b, int& R, int& C) { const int st = b / 1024, sb = b % 1024, swz = sb ^ (((sb >> 9) & 1) << 5); R = (st >> 1) * 16 + swz / 64; C = (st & 1) * 32 + (swz % 64) / 2; }
__host__ __device__ __forceinline__ int perm32(int rho) { const int n = rho >> 4, i = rho & 15; return 8 * (i >> 2) + 4 * n + (i & 3); }

struct Unit { int pm, pn; };
struct Gemm { const bf16_t* A; const bf16_t* Bt; int M, N, K; };

struct StaticOrder {
    int nM, nN, nwg, G, c;
    __host__ __device__ void init(int M, int N, int G_, int c_) { nM = M / BM; nN = N / BM; nwg = nM * nN; G = G_; c = c_; }
    __host__ __device__ bool next(int i, Unit& u) const {
        const long L = (long)i * G + c; if (L >= nwg) return false;
        int wgid = (int)L; { const int q = nwg / NXCD, r = nwg % NXCD, xcd = wgid % NXCD, off = wgid / NXCD; wgid = (xcd < r ? xcd * (q + 1) : r * (q + 1) + (xcd - r) * q) + off; }
        const int nig = WGM * nN, gid = wgid / nig, fm = gid * WGM, gsz = (nM - fm) < WGM ? (nM - fm) : WGM;
        u.pm = fm + ((wgid % nig) % gsz); u.pn = (wgid % nig) / gsz; return true;
    }
    __device__ __forceinline__ void a_ready(const Unit&) const {}
    __device__ __forceinline__ void done(const Unit&) const {}
};

template <class Epi, class Sched, bool STAMP = false>
__device__ __forceinline__ void gemm_phase(PG8_LAS unsigned char* lds, const Gemm g, const Sched& S, const Epi& E, unsigned long long* stamps) {
    const int tid = threadIdx.x, wid = __builtin_amdgcn_readfirstlane(tid >> 6), lane = tid & 63, wr = wid >> 2, wc = wid & 3, fr = lane & 15, fq = lane >> 4;
    const int K = g.K, nt = K / BK;
    int ts_lo = 0, ts_hi = 0, nts = 0; const unsigned long long rt_entry = STAMP ? (unsigned long long)wall_clock64() : 0ull;
#define PG8_STAMP() do { if (STAMP && wid == 0 && nts < 64) { const unsigned long long _c = (unsigned long long)clock64(); \
        ts_lo = (lane == nts) ? (int)(unsigned)_c : ts_lo; ts_hi = (lane == nts) ? (int)(unsigned)(_c >> 32) : ts_hi; ++nts; } } while (0)
    PG8_STAMP();
    unsigned voffA[2], voffB[2];
#pragma unroll
    for (int i = 0; i < 2; ++i) { int R, C; stage_rc(tid * 16 + i * 8192, R, C); const int Rb = Epi::PERM ? ((R & ~31) + perm32(R & 31)) : R;
        voffA[i] = (unsigned)(R * K + C) * 2u; voffB[i] = (unsigned)(Rb * K + C) * 2u; }
    const size_t kstep = (size_t)(BK * 2);
    const size_t hstep = (size_t)HALF * K * 2;
    const size_t tstep = 2 * hstep;
    const unsigned ldsw = (unsigned)wid * 1024u;
    const int aoff = lds_byte(wr * 64 + fr, fq * 8), boff = lds_byte(wc * 32 + fr, fq * 8);
#define PG8_SA(b, h) (((b) * 2 + (h)) * HTB)
#define PG8_SB(b, h) ((4 + (b) * 2 + (h)) * HTB)
#define PG8_STAGE(bufoff, gbase, voff) do { _Pragma("unroll") for (int _i = 0; _i < 2; ++_i) \
        __builtin_amdgcn_global_load_lds((const unsigned*)((const char*)(gbase) + (voff)[_i]), (PG8_LAS unsigned*)(lds + (bufoff) + ldsw + _i * 8192), 16, 0, 0); } while (0)
#define PG8_LDA(dst, b, h) do { _Pragma("unroll") for (int m = 0; m < 4; ++m) _Pragma("unroll") for (int k = 0; k < 2; ++k) dst[m][k] = *(const PG8_LAS bf16x8*)(lds + PG8_SA(b, h) + aoff + m * 2048 + k * 1024); } while (0)
#define PG8_LDB(dst, b, h) do { _Pragma("unroll") for (int n = 0; n < 2; ++n) _Pragma("unroll") for (int k = 0; k < 2; ++k) dst[n][k] = *(const PG8_LAS bf16x8*)(lds + PG8_SB(b, h) + boff + n * 2048 + k * 1024); } while (0)
#define PG8_MMA(ai, bj, At, Bt) do { __builtin_amdgcn_s_setprio(1); _Pragma("unroll") for (int m = 0; m < 4; ++m) _Pragma("unroll") for (int n = 0; n < 2; ++n) _Pragma("unroll") for (int k = 0; k < 2; ++k) \
        acc[ai][bj][m][n] = __builtin_amdgcn_mfma_f32_16x16x32_bf16(Bt[n][k], At[m][k], acc[ai][bj][m][n], 0, 0, 0); __builtin_amdgcn_s_setprio(0); } while (0)
#define PG8_WAIT_V(n) asm volatile("s_waitcnt vmcnt(" #n ")" ::: "memory")
#define PG8_WAIT_L(n) asm volatile("s_waitcnt lgkmcnt(" #n ")" ::: "memory")
#define PG8_BAR __builtin_amdgcn_s_barrier()
#define PG8_SCHED __builtin_amdgcn_sched_barrier(0)
    Unit cur, nxt; int ui = 0;
    if (!S.next(0, cur)) return;
    f32x4 acc[2][2][4][2];
#pragma unroll
    for (int a = 0; a < 2; ++a)
#pragma unroll
        for (int b = 0; b < 2; ++b)
#pragma unroll
            for (int m = 0; m < 4; ++m)
#pragma unroll
                for (int n = 0; n < 2; ++n) acc[a][b][m][n] = (f32x4){0.f, 0.f, 0.f, 0.f};
    bf16x8 At[4][2], B0[2][2], B1[2][2];
    const char* cA = (const char*)g.A + (size_t)cur.pm * tstep; const char* cB = (const char*)g.Bt + (size_t)cur.pn * tstep;
    S.a_ready(cur);
    PG8_STAGE(PG8_SB(0, 0), cB, voffB); PG8_STAGE(PG8_SA(0, 0), cA, voffA); PG8_STAGE(PG8_SB(0, 1), cB + hstep, voffB); PG8_STAGE(PG8_SA(0, 1), cA + hstep, voffA);
    if (wr == 1) PG8_BAR;
    PG8_WAIT_V(4); PG8_BAR;
    PG8_STAGE(PG8_SB(1, 0), cB + kstep, voffB); PG8_STAGE(PG8_SA(1, 0), cA + kstep, voffA); PG8_STAGE(PG8_SB(1, 1), cB + hstep + kstep, voffB);
    PG8_WAIT_V(6); PG8_BAR;
    PG8_STAMP();
    for (;;) {
        const bool has_next = S.next(ui + 1, nxt);
        const char* nA = has_next ? (const char*)g.A + (size_t)nxt.pm * tstep : cA; const char* nB = has_next ? (const char*)g.Bt + (size_t)nxt.pn * tstep : cB;
        for (int t = 0; t < nt; t += 2) {
            const bool last = (t == nt - 2);
            const char* a1 = cA + (size_t)(t + 1) * kstep;
            const char* a2 = last ? nA : cA + (size_t)(t + 2) * kstep; const char* b2 = last ? nB : cB + (size_t)(t + 2) * kstep;
            const char* a3 = a2 + kstep; const char* b3 = b2 + kstep;
            if (last && has_next) S.a_ready(nxt);
            PG8_LDB(B0, 0, 0); PG8_SCHED; PG8_LDA(At, 0, 0); PG8_STAGE(PG8_SA(1, 1), a1 + hstep, voffA);
            PG8_WAIT_L(8); PG8_BAR; PG8_WAIT_L(0); PG8_MMA(0, 0, At, B0); PG8_BAR; PG8_SCHED;
            PG8_LDB(B1, 0, 1); PG8_STAGE(PG8_SB(0, 0), b2, voffB);
            PG8_BAR; PG8_WAIT_L(0); PG8_MMA(0, 1, At, B1); PG8_BAR;
            PG8_LDA(At, 0, 1); PG8_STAGE(PG8_SA(0, 0), a2, voffA);
            PG8_BAR; PG8_WAIT_L(0); PG8_MMA(1, 0, At, B0); PG8_BAR; PG8_SCHED;
            PG8_STAGE(PG8_SB(0, 1), b2 + hstep, voffB);
            PG8_WAIT_V(6); PG8_BAR; PG8_MMA(1, 1, At, B1); PG8_BAR;
            PG8_LDB(B0, 1, 0); PG8_SCHED; PG8_LDA(At, 1, 0); PG8_STAGE(PG8_SA(0, 1), a2 + hstep, voffA);
            PG8_WAIT_L(8); PG8_BAR; PG8_WAIT_L(0); PG8_MMA(0, 0, At, B0); PG8_BAR; PG8_SCHED;
            PG8_LDB(B1, 1, 1); PG8_STAGE(PG8_SB(1, 0), b3, voffB);
            PG8_BAR; PG8_WAIT_L(0); PG8_MMA(0, 1, At, B1); PG8_BAR;
            PG8_LDA(At, 1, 1); PG8_STAGE(PG8_SA(1, 0), a3, voffA);
            PG8_BAR; PG8_WAIT_L(0); PG8_MMA(1, 0, At, B0); PG8_BAR; PG8_SCHED;
            PG8_STAGE(PG8_SB(1, 1), b3 + hstep, voffB);
            PG8_WAIT_V(6); PG8_BAR; PG8_MMA(1, 1, At, B1); PG8_BAR;
        }
        PG8_STAMP();
        if constexpr (!Epi::AFTER_DRAIN) { E(acc, cur, wr, wc, fr, fq); S.done(cur); }
        PG8_STAMP();
        if (!has_next) break;
#pragma unroll
        for (int a = 0; a < 2; ++a)
#pragma unroll
            for (int b = 0; b < 2; ++b)
#pragma unroll
                for (int m = 0; m < 4; ++m)
#pragma unroll
                    for (int n = 0; n < 2; ++n) acc[a][b][m][n] = (f32x4){0.f, 0.f, 0.f, 0.f};
        cur = nxt; cA = nA; cB = nB; ++ui;
    }
    PG8_WAIT_V(0);
    if (wr == 0) PG8_BAR;
    PG8_BAR;
    if constexpr (Epi::AFTER_DRAIN) { E.fused(acc, cur, wr, wc, fr, fq, lds, wid, lane); S.done(cur); }
    PG8_STAMP();
    if (STAMP && wid == 0) { stamps[lane] = lane < nts ? (((unsigned long long)(unsigned)ts_hi << 32) | (unsigned)ts_lo) : 0ull;
        if (lane == 62) stamps[62] = rt_entry; if (lane == 63) stamps[63] = (unsigned long long)wall_clock64(); }
#undef PG8_STAMP
#undef PG8_SA
#undef PG8_SB
#undef PG8_STAGE
#undef PG8_LDA
#undef PG8_LDB
#undef PG8_MMA
#undef PG8_WAIT_V
#undef PG8_WAIT_L
#undef PG8_BAR
#undef PG8_SCHED
}
}

template <class EF> struct Pg8Epi { static constexpr bool PERM = false, AFTER_DRAIN = false; EF e;
    __device__ __forceinline__ void operator()(const pg8::f32x4 (&acc)[2][2][4][2], const pg8::Unit& u, int wr, int wc, int fr, int fq) const {
        int fr2 = fr, fq2 = fq; asm volatile("" : "+v"(fr2), "+v"(fq2));
#pragma unroll
        for (int ai = 0; ai < 2; ++ai)
#pragma unroll
            for (int m = 0; m < 4; ++m) { const int row = u.pm * 256 + ai * 128 + wr * 64 + m * 16 + fr2;
#pragma unroll
                for (int bj = 0; bj < 2; ++bj)
#pragma unroll
                    for (int n = 0; n < 2; ++n) e.store4(row, u.pn * 256 + bj * 128 + wc * 32 + n * 16 + 4 * fq2, acc[ai][bj][m][n]); }
    } };
__device__ __forceinline__ int unit_of(const Frame& F, int round) { return (F.G % 8 == 0) ? round * F.G + (F.bid & 7) * (F.G >> 3) + (F.bid >> 3) : round * F.G + F.bid; }
__device__ __forceinline__ void tile_of(int v, int nN, int& pm, int& pn) { const int gid = v >> 5, loc = v & 31, gn = nN >> 2; pm = (gid / gn) * 8 + (loc & 7); pn = (gid % gn) * 4 + (loc >> 3); }

__device__ __forceinline__ void p_inproj_fast(const Frame& F) {
    const ARows A{(const bf16_t*)(F.ws + WS_H1), DM};
    const EpiInProj E{(bf16_t*)(F.ws + WS_UX), (bf16_t*)(F.ws + WS_Q), (bf16_t*)(F.ws + WS_K), (bf16_t*)(F.ws + WS_V)};
    for (int r = 0;; ++r) { const int v = unit_of(F, r); if (v >= 32 * 16) break; int pm, pn; tile_of(v, 16, pm, pn);
        B2Bf16 Bl; Bl.base = (const bf16_t*)(F.ws + WS_WINB) + pn * 256; Bl.ld = DINP;
        gemm_tile2<ARows, B2Bf16, EpiInProj, false>(F.lds, A, Bl, E, pm * 256, pn * 256, DM); }
}
__device__ __forceinline__ void p_glu_fast(const Frame& F) {
    const ARows A{(const bf16_t*)(F.ws + WS_ZB), 1024};
    const EpiGlu E{(const bf16_t*)(F.ws + WS_ZB), F.in[I_BGLU], (bf16_t*)(F.ws + WS_MIX), (float*)(F.ws + WS_SQS)};
    for (int r = 0;; ++r) { const int v = unit_of(F, r); if (v >= 32 * 4) break; int pm, pn; tile_of(v, 4, pm, pn);
        B2Bf16 Bl; Bl.base = (const bf16_t*)(F.ws + WS_WGLUB) + pn * 256; Bl.ld = 1024;
        gemm_tile2<ARows, B2Bf16, EpiGlu, false>(F.lds, A, Bl, E, pm * 256, pn * 256, 1024); }
}
__device__ __forceinline__ void p_outproj_fast(const Frame& F) {
    const ARows A{(const bf16_t*)(F.ws + WS_MIX), DM};
    const EpiOut E{F.in[I_X], F.modp(), (bf16_t*)(F.ws + WS_X1), (const float*)(F.ws + WS_SQS), (const float*)(F.ws + WS_SQA)};
    for (int r = 0;; ++r) { const int v = unit_of(F, r); if (v >= 32 * 8) break; int pm, pn; tile_of(v, 8, pm, pn);
        B2Bf16 Bl; Bl.base = (const bf16_t*)(F.ws + WS_WOUTB) + pn * 256; Bl.ld = DM;
        gemm_tile2<ARows, B2Bf16, EpiOut, false>(F.lds, A, Bl, E, pm * 256, pn * 256, DM);
        if (F.G == 256) {
            asm volatile("s_waitcnt vmcnt(0)" ::: "memory"); __syncthreads();
            if (F.tid == 0) { __builtin_amdgcn_fence(__ATOMIC_RELEASE, "agent"); __hip_atomic_fetch_add((unsigned*)(F.ws + WS_CTL + 25088) + pm * 16, 1u, __ATOMIC_RELAXED, __HIP_MEMORY_SCOPE_AGENT); } } }
}
__device__ __forceinline__ void p_moe1_fast(const Frame& F) {
    constexpr int NU = NE * 22 * 4;
    const bool split_tail = (F.G == 256);
    for (int r = 0;; ++r) {
        int v = unit_of(F, r); bool helper = false;
        if (split_tail && r == 5) { helper = (F.bid & 7) >= 4; if (helper) v -= 4 * 32; }
        if (v >= NU) break;
        const int pm = v & 3, pn = (v >> 2) % 22, e = (v >> 2) / 22;
        B2F32Dual Bl; Bl.g = F.in[I_WGATE] + (size_t)e * DM * DFF + pn * 128; Bl.u = F.in[I_WUP] + (size_t)e * DM * DFF + pn * 128; Bl.ld = DFF;
        PfLines pf; pf.on = false; pf.a = nullptr; pf.b0 = nullptr; pf.b1 = nullptr;
        if (split_tail && r < 5) {
            int vn = unit_of(F, r + 1); unsigned kst = 0u; if (r + 1 == 5 && (F.bid & 7) >= 4) { vn -= 4 * 32; kst = 1024u; }
            const int pmn = vn & 3, pnn = (vn >> 2) % 22, en = (vn >> 2) / 22;
            const AGather An{(const bf16_t*)(F.ws + WS_H2), (const int*)(F.ws + WS_IDX), en, kst};
            pf.a = An.base + An.off(pmn * 256 + (F.tid >> 1)) + (F.tid & 1) * 64;
            const int id0 = 2 * F.tid, k0 = id0 >> 3, rem0 = id0 & 7;
            const float* bb = ((rem0 >> 2) ? F.in[I_WUP] : F.in[I_WGATE]) + (size_t)en * DM * DFF + (size_t)(kst + k0) * DFF + pnn * 128 + (rem0 & 3) * 32;
            pf.b0 = bb; pf.b1 = bb + 32; pf.on = true; }
        if (split_tail && r == 5) {
            const int pair = v - 5 * 256;
            float* part = (float*)(F.ws + WS_SS) + (size_t)pair * 65536;
            unsigned* flag = (unsigned*)(F.ws + WS_CTL + 16384) + pair * 16; unsigned* tmo = (unsigned*)(F.ws + WS_CTL) + XB_TMO;
            if (helper) {
                const AGather A{(const bf16_t*)(F.ws + WS_H2), (const int*)(F.ws + WS_IDX), e, 1024u};
                Bl.g += (size_t)1024 * DFF; Bl.u += (size_t)1024 * DFF;
                const EpiMoe1Part E{part};
                gemm_tile2<AGather, B2F32Dual, EpiMoe1Part, true>(F.lds, A, Bl, E, pm * 256, pn * 128, 1024);
                asm volatile("s_waitcnt vmcnt(0)" ::: "memory"); __syncthreads();
                if (F.tid == 0) { __builtin_amdgcn_fence(__ATOMIC_RELEASE, "agent"); asm volatile("s_waitcnt vmcnt(0)" ::: "memory"); __hip_atomic_store(flag, 1u, __ATOMIC_RELAXED, __HIP_MEMORY_SCOPE_AGENT); }
                { const int v2 = unit_of(F, 0), pn2 = (v2 >> 2) & 7, e2 = v2 >> 5; float tv_[4];
#pragma unroll
                  for (int j = 0; j < 4; ++j) { const int id = F.tid * 4 + j; tv_[j] = (F.in[I_WDOWN] + (size_t)e2 * DFF * DM + (size_t)(id >> 3) * DM + pn2 * 256 + (id & 7) * 32)[0]; }
                  asm volatile("" :: "v"(tv_[0]), "v"(tv_[1]), "v"(tv_[2]), "v"(tv_[3])); }
            } else {
                const AGather A{(const bf16_t*)(F.ws + WS_H2), (const int*)(F.ws + WS_IDX), e, 0u};
                const EpiMoe1Comb E{(bf16_t*)(F.ws + WS_HID) + (size_t)e * 1024 * DFF, part, flag, tmo};
                gemm_tile2<AGather, B2F32Dual, EpiMoe1Comb, true>(F.lds, A, Bl, E, pm * 256, pn * 128, 1024);
            }
            break;
        }
        const AGather A{(const bf16_t*)(F.ws + WS_H2), (const int*)(F.ws + WS_IDX), e, 0u};
        const EpiMoe1 E{(bf16_t*)(F.ws + WS_HID) + (size_t)e * 1024 * DFF};
        gemm_tile2<AGather, B2F32Dual, EpiMoe1, true, 0, PfLines>(F.lds, A, Bl, E, pm * 256, pn * 128, DM, pf); }
}
__device__ __forceinline__ void p_moe2_fast(const Frame& F) {
    for (int r = 0;; ++r) { const int v = unit_of(F, r); if (v >= NE * 8 * 4) break; const int pm = v & 3, pn = (v >> 2) & 7, e = v >> 5;
        const ARows A{(const bf16_t*)(F.ws + WS_HID) + (size_t)e * 1024 * DFF, DFF};
        B2F32 Bl; Bl.base = F.in[I_WDOWN] + (size_t)e * DFF * DM + pn * 256; Bl.ld = DM;
        const EpiMoe2 E{(bf16_t*)(F.ws + WS_YE) + (size_t)e * 1024 * DM, (const float*)(F.ws + WS_WAFF), e};
        PfLines pf; pf.on = false; pf.a = nullptr; pf.b0 = nullptr; pf.b1 = nullptr;
        { const int vn = unit_of(F, r + 1);
          if (vn < NE * 8 * 4) { const int pmn = vn & 3, pnn = (vn >> 2) & 7, en = vn >> 5;
            pf.a = (const bf16_t*)(F.ws + WS_HID) + (size_t)en * 1024 * DFF + (size_t)(pmn * 256 + (F.tid >> 1)) * DFF + (F.tid & 1) * 64;
            const int id0 = 2 * F.tid;
            const float* bb = F.in[I_WDOWN] + (size_t)en * DFF * DM + (size_t)(id0 >> 3) * DM + pnn * 256 + (id0 & 7) * 32;
            pf.b0 = bb; pf.b1 = bb + 32; pf.on = true; } }
        gemm_tile2<ARows, B2F32, EpiMoe2, false, 0, PfLines>(F.lds, A, Bl, E, pm * 256, pn * 256, DFF, pf); }
}


__device__ __forceinline__ void p_ssm_prep(const Frame& F, int g, int part, int nparts) {
    float* lam = (float*)F.lds;
    float* bb = lam + 4352;
    float* cc = bb + 4096;
    float* Tt = cc + 4160;
    const int tid = F.tid;
    if (tid < 128) {
        const int dir = tid >> 6, p = tid & 63, pg = dir * 64 + g;
        const double dt = exp((double)F.in[I_LOGDT][pg]);
        const double lr = (double)F.in[I_ARE][pg * 64 + p], li = (double)F.in[I_AIM][pg * 64 + p];
        const double mg = exp(lr * dt), lbr = mg * cos(li * dt), lbi = mg * sin(li * dt);
        double pr = 1.0, pi = 0.0;
        for (int m = 0; m <= 16; ++m) { lam[((dir * 64 + p) * 17 + m) * 2 + 0] = (float)pr; lam[((dir * 64 + p) * 17 + m) * 2 + 1] = (float)pi;
            if (m == 16 && part == 0) { float* LAM = (float*)(F.ws + WS_LAM); LAM[((dir * 64 + g) * 64 + p) * 2 + 0] = (float)pr; LAM[((dir * 64 + g) * 64 + p) * 2 + 1] = (float)pi; }
            const double nr_ = pr * lbr - pi * lbi, ni_ = pr * lbi + pi * lbr; pr = nr_; pi = ni_; }
        const double den = lr * lr + li * li, nr = lbr - 1.0;
        const double fr = (nr * lr + lbi * li) / den, fi = (lbi * lr - nr * li) / den;
        const f32x4* bre = (const f32x4*)(F.in[I_BRE] + (size_t)(pg * 64 + p) * 16); const f32x4* bim = (const f32x4*)(F.in[I_BIM] + (size_t)(pg * 64 + p) * 16);
#pragma unroll
        for (int q = 0; q < 4; ++q) { const f32x4 br4 = bre[q], bi4 = bim[q];
#pragma unroll
            for (int j = 0; j < 4; ++j) { const double br = br4[j], bi = bi4[j]; const int h = q * 4 + j;
                bb[((dir * 64 + p) * 16 + h) * 2 + 0] = (float)(fr * br - fi * bi); bb[((dir * 64 + p) * 16 + h) * 2 + 1] = (float)(fr * bi + fi * br); } }
    }
    for (int i = tid; i < 2048; i += NT) { const int dir = i >> 10, h = (i >> 6) & 15, p = i & 63;
        cc[((dir * 16 + h) * 65 + p) * 2 + 0] = F.in[I_CRE][(size_t)((dir * 64 + g) * 16 + h) * 64 + p]; cc[((dir * 16 + h) * 65 + p) * 2 + 1] = F.in[I_CIM][(size_t)((dir * 64 + g) * 16 + h) * 64 + p]; }
    __syncthreads();
    {
        const int slot = tid >> 4, hp = tid & 15;
        const int dir = slot < 16 ? 1 : 0, m = slot < 16 ? 15 - slot : slot - 16;
        float s[16];
#pragma unroll
        for (int h = 0; h < 16; ++h) s[h] = 0.f;
        for (int p = 0; p < 64; ++p) { const f32x2 c = *(const f32x2*)(cc + ((dir * 16 + hp) * 65 + p) * 2), l = *(const f32x2*)(lam + ((dir * 64 + p) * 17 + m) * 2);
            const float mr = c[0] * l[0] - c[1] * l[1], mi = c[0] * l[1] + c[1] * l[0];
            const f32x4* bp = (const f32x4*)(bb + (dir * 64 + p) * 32);
#pragma unroll
            for (int q = 0; q < 8; ++q) { const f32x4 bv = bp[q]; s[2 * q] += mr * bv[0] - mi * bv[1]; s[2 * q + 1] += mr * bv[2] - mi * bv[3]; } }
        float* red0 = Tt + 31 * 264;
        if (slot == 15) {
#pragma unroll
            for (int h = 0; h < 16; ++h) red0[h * 16 + hp] = s[h]; }
        __syncthreads();
        if (slot != 15) { const int ti = slot < 15 ? slot : slot - 1;
            if (slot == 16) {
#pragma unroll
                for (int h = 0; h < 16; ++h) s[h] += red0[h * 16 + hp] + ((h == hp) ? F.in[I_SSMD][g * 16 + hp] : 0.f); }
#pragma unroll
            for (int h = 0; h < 16; ++h) Tt[ti * 264 + h * 16 + hp] = s[h]; }
    }
    __syncthreads();
    bf16_t* BM = (bf16_t*)(F.ws + WS_BMAT) + (size_t)g * 256 * 256;
    for (int i = part * NT + tid; i < 256 * 32; i += nparts * NT) { const int k = i >> 5, nc = i & 31, j = k >> 4, h = k & 15, dir = nc >> 4, ri = (nc >> 3) & 1, p0 = (nc & 7) * 8, m = dir ? j : 15 - j; float v[8];
#pragma unroll
        for (int q = 0; q < 8; ++q) { const f32x2 l = *(const f32x2*)(lam + ((dir * 64 + p0 + q) * 17 + m) * 2), bv = *(const f32x2*)(bb + ((dir * 64 + p0 + q) * 16 + h) * 2);
            v[q] = ri ? (l[0] * bv[1] + l[1] * bv[0]) : (l[0] * bv[0] - l[1] * bv[1]); }
        u32x4 w; w.x = pack2(v[0], v[1]); w.y = pack2(v[2], v[3]); w.z = pack2(v[4], v[5]); w.w = pack2(v[6], v[7]);
        *(u32x4*)(BM + (size_t)k * 256 + nc * 8) = w; }
    bf16_t* KC = (bf16_t*)(F.ws + WS_KCMAT) + (size_t)g * 512 * 256;
    for (int i = part * NT + tid; i < 512 * 32; i += nparts * NT) { const int k = i >> 5, nc = i & 31, ii = nc >> 1, hp0 = (nc & 1) * 8; float v[8];
        if (k < 256) { const int j = k >> 4, h = k & 15; const f32x4* tp = (const f32x4*)(Tt + (ii - j + 15) * 264 + h * 16 + hp0); const f32x4 t0 = tp[0], t1 = tp[1];
            v[0] = t0[0]; v[1] = t0[1]; v[2] = t0[2]; v[3] = t0[3]; v[4] = t1[0]; v[5] = t1[1]; v[6] = t1[2]; v[7] = t1[3]; }
        else { const int kk = k - 256, dir = kk >> 7, ri = (kk >> 6) & 1, p = kk & 63, m = dir ? 16 - ii : ii + 1; const f32x2 l = *(const f32x2*)(lam + ((dir * 64 + p) * 17 + m) * 2);
#pragma unroll
            for (int q = 0; q < 8; ++q) { const f32x2 c = *(const f32x2*)(cc + ((dir * 16 + hp0 + q) * 65 + p) * 2); v[q] = ri ? -(c[0] * l[1] + c[1] * l[0]) : (c[0] * l[0] - c[1] * l[1]); } }
        u32x4 w; w.x = pack2(v[0], v[1]); w.y = pack2(v[2], v[3]); w.z = pack2(v[4], v[5]); w.w = pack2(v[6], v[7]);
        *(u32x4*)(KC + (size_t)k * 256 + nc * 8) = w; }
    __syncthreads();
}
struct EpiS { float* SS;
    __device__ __forceinline__ void store4(int r, int n, f32x4 v) const { *(f32x4*)(SS + (size_t)r * 256 + n) = v; } };
struct EpiSLds { LAS unsigned char* img;
    static constexpr int RS = 528;
    __device__ __forceinline__ void store4(int r, int n, f32x4 v) const { u32x2 w; w.x = pack2(v[0], v[1]); w.y = pack2(v[2], v[3]); *(LAS u32x2*)(img + (r & 255) * RS + n * 2) = w; } };
struct EpiY { bf16_t* ZB; int g;
    __device__ __forceinline__ void store4(int r, int n, f32x4 v) const { const int b = r >> 7, c = r & 127, i = n >> 4, hp = n & 15; const size_t t = (size_t)b * SEQ + c * 16 + i;
        u32x2 w; w.x = pack2(gelu_tanh(v[0]), gelu_tanh(v[1])); w.y = pack2(gelu_tanh(v[2]), gelu_tanh(v[3])); *(u32x2*)(ZB + t * 1024 + g * 16 + hp) = w; } };
__device__ __forceinline__ void p_ssm_sgemm(const Frame& F) {
    for (int r = 0;; ++r) { const int v = unit_of(F, r); if (v >= 128) break; const int g = v >> 1, pm = v & 1;
        const ARows A{(const bf16_t*)(F.ws + WS_UX) + (size_t)g * 512 * 512, 512};
        B2Bf16 Bl; Bl.base = (const bf16_t*)(F.ws + WS_BMAT) + (size_t)g * 256 * 256; Bl.ld = 256;
        const EpiS E{(float*)(F.ws + WS_SS) + (size_t)g * 512 * 256};
        gemm_tile2<ARows, B2Bf16, EpiS, false>(F.lds, A, Bl, E, pm * 256, 0, 256); }
}
__device__ __forceinline__ void p_ssm_ygemm(const Frame& F) {
    for (int r = 0;; ++r) { const int v = unit_of(F, r); if (v >= 128) break; const int g = v >> 1, pm = v & 1;
        const ARows A{(const bf16_t*)(F.ws + WS_UX) + (size_t)g * 512 * 512, 512};
        B2Bf16 Bl; Bl.base = (const bf16_t*)(F.ws + WS_KCMAT) + (size_t)g * 512 * 256; Bl.ld = 256;
        const EpiY E{(bf16_t*)(F.ws + WS_ZB), g};
        gemm_tile2<ARows, B2Bf16, EpiY, false>(F.lds, A, Bl, E, pm * 256, 0, 512); }
}
__device__ __forceinline__ void p_ssm_scan(const Frame& F) {
    const float* SS = (const float*)(F.ws + WS_SS); bf16_t* UX = (bf16_t*)(F.ws + WS_UX); const float* LAM = (const float*)(F.ws + WS_LAM);
    for (int w = F.bid + F.G * F.wave; w < NG * NB * 2; w += F.G * 8) {
        const int dir = w & 1, b = (w >> 1) & 3, g = w >> 3, p = F.lane;
        const float l16r = LAM[((dir * 64 + g) * 64 + p) * 2], l16i = LAM[((dir * 64 + g) * 64 + p) * 2 + 1];
        float xr = 0.f, xi = 0.f;
        for (int c0 = 0; c0 < 128; c0 += 8) {
            float sr[8], si[8];
#pragma unroll
            for (int q = 0; q < 8; ++q) { const int c = dir ? 127 - (c0 + q) : c0 + q; const float* sp = SS + ((size_t)g * 512 + b * 128 + c) * 256 + dir * 128 + p; sr[q] = sp[0]; si[q] = sp[64]; }
#pragma unroll
            for (int q = 0; q < 8; ++q) { const int c = dir ? 127 - (c0 + q) : c0 + q; bf16_t* xp = UX + ((size_t)g * 512 + b * 128 + c) * 512 + 256 + dir * 128 + p;
                xp[0] = f2bf(xr); xp[64] = f2bf(xi);
                const float nr = l16r * xr - l16i * xi + sr[q], ni = l16r * xi + l16i * xr + si[q]; xr = nr; xi = ni; }
        }
    }
}


struct AttnStage { u32x4 vv[9], kv[9]; bf16x8 q0, q1; float rpv; };
__device__ __forceinline__ void attn_prefetch(const Frame& F, int pu, AttnStage& st) {
    const bf16_t* Kb = (const bf16_t*)(F.ws + WS_K); const bf16_t* Vb = (const bf16_t*)(F.ws + WS_V);
    const int b = pu >> 8, h = (pu >> 4) & 15, i2 = pu & 15, r0 = 2 * i2;
    int rs0 = r0 - 4; rs0 = rs0 < 0 ? 0 : (rs0 > 24 ? 24 : rs0);
    const int base = rs0 < 23 ? rs0 : 23;
#pragma unroll
    for (int i = 0; i < 9; ++i) { const int c = F.tid + i * NT, key = c >> 3, chunk = c & 7; const size_t go = (size_t)(b * SEQ + base * 64 + key) * 1024 + h * 64 + chunk * 8;
        st.vv[i] = *(const u32x4*)(Vb + go); st.kv[i] = *(const u32x4*)(Kb + go); }
    { const int r = r0 + (F.wave >> 2), wq = 16 * (F.wave & 3) + (F.lane & 15);
      const bf16_t* qp = (const bf16_t*)(F.ws + WS_Q) + (size_t)(b * SEQ + r * 64 + wq) * 1024 + h * 64 + 8 * (F.lane >> 4);
      st.q0 = *(const bf16x8*)qp; st.q1 = *(const bf16x8*)(qp + 32); }
    st.rpv = (F.tid < 465) ? F.in[I_RPB][h * 465 + F.tid] : 0.f;
}
__device__ __forceinline__ void attn_pair_unit(const Frame& F, int pu, int pu_next, AttnStage& st) {
    LAS unsigned char* lds = (LAS unsigned char*)F.lds;
    LAS float* rp = (LAS float*)(lds + 147456);
    const bf16_t* Q = (const bf16_t*)(F.ws + WS_Q); const bf16_t* Kb = (const bf16_t*)(F.ws + WS_K); const bf16_t* Vb = (const bf16_t*)(F.ws + WS_V);
    bf16_t* Y = (bf16_t*)(F.ws + WS_MIX) + 1024; float* SQA = (float*)(F.ws + WS_SQA); const float* rpb = F.in[I_RPB];
    const int lane = F.lane, wave = F.wave, q = lane & 15, G = lane >> 4;
    {
        const int b = pu >> 8, h = (pu >> 4) & 15, i2 = pu & 15, r0 = 2 * i2;
        int rs0 = r0 - 4; rs0 = rs0 < 0 ? 0 : (rs0 > 24 ? 24 : rs0);
        const int base = rs0 < 23 ? rs0 : 23;
        {
#pragma unroll
          for (int i = 0; i < 9; ++i) { const int c = F.tid + i * NT, key = c >> 3, chunk = c & 7;
              *(LAS u32x4*)(lds + key * 128 + (((((chunk >> 1) ^ ((key >> 1) & 3)) << 1) | (chunk & 1)) << 4)) = st.vv[i];
              *(LAS u32x4*)(lds + 73728 + key * 128 + ((chunk ^ ((key >> 1) & 7)) << 4)) = st.kv[i]; } }
        if (F.tid < 465) rp[(F.tid / 31) * 32 + (F.tid % 31)] = st.rpv * 1.44269504088896f; else if (F.tid >= 480 && F.tid < 495) rp[(F.tid - 480) * 32 + 31] = -1e30f;
        const bf16x8 qf0 = st.q0, qf1 = st.q1;
        __syncthreads();
        {
            const int r = r0 + (wave >> 2), qb = wave & 3;
            int rs = r - 4; rs = rs < 0 ? 0 : (rs > 24 ? 24 : rs);
            const int c0 = (qb == 0) ? 0 : (qb == 1) ? 8 : (qb == 2) ? 24 : 32;
            const int wq = 16 * qb + q;
            int cs = wq - 8; cs = cs < 0 ? 0 : (cs > 48 ? 48 : cs);
            const LAS float* rpl = rp + (rs - r + 7) * 32;
            int bo[2][4];
#pragma unroll
            for (int hf = 0; hf < 2; ++hf)
#pragma unroll
                for (int e = 0; e < 4; ++e) { const int wk = c0 + 16 * hf + 4 * G + e; const bool valid = (wk >= cs) && (wk < cs + 16); bo[hf][e] = valid ? wk - wq + 15 : 31; }
            f32x4 s[16];
            bf16x8 k0r[4], k1r[4]; f32x4 bir[4];
#define QK_LOAD(t_) do { const int kk_ = (rs + ((t_) >> 1) - base) * 64 + c0 + 16 * ((t_) & 1) + q;         \
                k0r[(t_) & 3] = *(const LAS bf16x8*)(lds + 73728 + kk_ * 128 + ((G ^ ((kk_ >> 1) & 7)) << 4)); k1r[(t_) & 3] = *(const LAS bf16x8*)(lds + 73728 + kk_ * 128 + (((4 + G) ^ ((kk_ >> 1) & 7)) << 4)); \
                bir[(t_) & 3] = (f32x4){rpl[((t_) >> 1) * 32 + bo[(t_) & 1][0]], rpl[((t_) >> 1) * 32 + bo[(t_) & 1][1]], rpl[((t_) >> 1) * 32 + bo[(t_) & 1][2]], rpl[((t_) >> 1) * 32 + bo[(t_) & 1][3]]}; } while (0)
            QK_LOAD(0); QK_LOAD(1); QK_LOAD(2);
            __builtin_amdgcn_sched_barrier(0);
#pragma unroll
            for (int t = 0; t < 16; ++t) {
                if (t + 3 < 16) QK_LOAD(t + 3);
                f32x4 a = bir[t & 3];
                a = __builtin_amdgcn_mfma_f32_16x16x32_bf16(k0r[t & 3], qf0, a, 0, 0, 0);
                a = __builtin_amdgcn_mfma_f32_16x16x32_bf16(k1r[t & 3], qf1, a, 0, 0, 0);
                s[t] = a;
                __builtin_amdgcn_sched_barrier(0);
            }
#undef QK_LOAD
            __builtin_amdgcn_sched_barrier(0);
            if (pu_next >= 0) attn_prefetch(F, pu_next, st);
            __builtin_amdgcn_sched_barrier(0);
            float mx = -1e30f;
#pragma unroll
            for (int t = 0; t < 16; ++t) mx = fmaxf(fmaxf(mx, fmaxf(s[t][0], s[t][1])), fmaxf(s[t][2], s[t][3]));
            mx = fmaxf(mx, __shfl_xor(mx, 16)); mx = fmaxf(mx, __shfl_xor(mx, 32));
            float lsum = 0.f;
#pragma unroll
            for (int t = 0; t < 16; ++t)
#pragma unroll
                for (int e = 0; e < 4; ++e) { const float p = __builtin_amdgcn_exp2f(s[t][e] - mx); s[t][e] = p; lsum += p; }
            lsum += __shfl_xor(lsum, 16); lsum += __shfl_xor(lsum, 32);
            f32x4 o[4];
#pragma unroll
            for (int dt = 0; dt < 4; ++dt) o[dt] = (f32x4){0.f, 0.f, 0.f, 0.f};
            s16x4 vlo[4], vhi[4];
#define PV_LOAD(i_) do { const int keyA_ = (rs + ((i_) >> 2) - base) * 64 + c0 + 4 * G + (q >> 2), keyB_ = keyA_ + 16; \
                const int aA_ = keyA_ * 128 + ((((i_) & 3) ^ ((keyA_ >> 1) & 3)) << 5) + 8 * (q & 3), aB_ = keyB_ * 128 + ((((i_) & 3) ^ ((keyB_ >> 1) & 3)) << 5) + 8 * (q & 3); \
                vlo[(i_) & 3] = __builtin_amdgcn_ds_read_tr16_b64_v4i16((LAS s16x4*)(lds + aA_)); vhi[(i_) & 3] = __builtin_amdgcn_ds_read_tr16_b64_v4i16((LAS s16x4*)(lds + aB_)); } while (0)
            PV_LOAD(0); PV_LOAD(1); PV_LOAD(2);
            __builtin_amdgcn_sched_barrier(0);
            union { bf16x8 v; unsigned u[4]; } pf;
#pragma unroll
            for (int i = 0; i < 32; ++i) { const int kk = i >> 2, dt = i & 3;
                if (i + 3 < 32) PV_LOAD(i + 3);
                if (dt == 0) { pf.u[0] = pack2(s[2 * kk][0], s[2 * kk][1]); pf.u[1] = pack2(s[2 * kk][2], s[2 * kk][3]);
                    pf.u[2] = pack2(s[2 * kk + 1][0], s[2 * kk + 1][1]); pf.u[3] = pack2(s[2 * kk + 1][2], s[2 * kk + 1][3]); }
                const bf16x8 vf = (bf16x8){vlo[i & 3][0], vlo[i & 3][1], vlo[i & 3][2], vlo[i & 3][3], vhi[i & 3][0], vhi[i & 3][1], vhi[i & 3][2], vhi[i & 3][3]};
                o[dt] = __builtin_amdgcn_mfma_f32_16x16x32_bf16(vf, pf.v, o[dt], 0, 0, 0);
                __builtin_amdgcn_sched_barrier(0);
            }
#undef PV_LOAD
            const float inv = 1.0f / lsum;
            bf16_t* yp = Y + (size_t)(b * SEQ + r * 64 + wq) * DM + h * 64 + 4 * G;
            float ssq = 0.f;
#pragma unroll
            for (int dt = 0; dt < 4; ++dt) { u32x2 w; w.x = pack2(o[dt][0] * inv, o[dt][1] * inv); w.y = pack2(o[dt][2] * inv, o[dt][3] * inv); *(u32x2*)(yp + 16 * dt) = w;
                ssq += bflo(w.x) * bflo(w.x) + bfhi(w.x) * bfhi(w.x) + bflo(w.y) * bflo(w.y) + bfhi(w.y) * bfhi(w.y); }
            ssq += __shfl_xor(ssq, 16); ssq += __shfl_xor(ssq, 32);
            if (G == 0) SQA[(size_t)(b * SEQ + r * 64 + wq) * 16 + h] = ssq;
        }
        __syncthreads();
    }
}

__device__ __forceinline__ void attn_units(const Frame& F, int first, int step, int end) {
    if (first >= end) return;
    AttnStage st; attn_prefetch(F, first, st);
    for (int pu = first; pu < end; pu += step) attn_pair_unit(F, pu, (pu + step < end) ? pu + step : -1, st);
}
__device__ __forceinline__ void p_attn_fast(const Frame& F) { attn_units(F, F.bid, F.G, NB * NH * 16); }

__device__ __forceinline__ void ssm_scan_half(const Frame& F, int g, int pm) {
    if (F.wave >= 4) return;
    const float* SS = (const float*)(F.ws + WS_SS); bf16_t* UX = (bf16_t*)(F.ws + WS_UX); const float* LAM = (const float*)(F.ws + WS_LAM);
    const int dir = F.wave & 1, b = 2 * pm + (F.wave >> 1), p = F.lane;
    const float l16r = LAM[((dir * 64 + g) * 64 + p) * 2], l16i = LAM[((dir * 64 + g) * 64 + p) * 2 + 1];
    float xr = 0.f, xi = 0.f;
    for (int c0 = 0; c0 < 128; c0 += 32) {
        float sr[32], si[32];
#pragma unroll
        for (int q = 0; q < 32; ++q) { const int c = dir ? 127 - (c0 + q) : c0 + q; const float* sp = SS + ((size_t)g * 512 + b * 128 + c) * 256 + dir * 128 + p;
            sr[q] = __hip_atomic_load(sp, __ATOMIC_RELAXED, __HIP_MEMORY_SCOPE_AGENT); si[q] = __hip_atomic_load(sp + 64, __ATOMIC_RELAXED, __HIP_MEMORY_SCOPE_AGENT); }
#pragma unroll
        for (int q = 0; q < 32; ++q) { const int c = dir ? 127 - (c0 + q) : c0 + q; bf16_t* xp = UX + ((size_t)g * 512 + b * 128 + c) * 512 + 256 + dir * 128 + p;
            xp[0] = f2bf(xr); xp[64] = f2bf(xi);
            const float nr = l16r * xr - l16i * xi + sr[q], ni = l16r * xi + l16i * xr + si[q]; xr = nr; xi = ni; }
    }
}
__device__ __forceinline__ void ssm_scan_half_lds(const Frame& F, int g, int pm) {
    if (F.wave >= 4) return;
    const LAS unsigned char* img = (const LAS unsigned char*)F.lds; bf16_t* UX = (bf16_t*)(F.ws + WS_UX); const float* LAM = (const float*)(F.ws + WS_LAM);
    const int dir = F.wave & 1, bl = F.wave >> 1, b = 2 * pm + bl, p = F.lane;
    const float l16r = LAM[((dir * 64 + g) * 64 + p) * 2], l16i = LAM[((dir * 64 + g) * 64 + p) * 2 + 1];
    float xr = 0.f, xi = 0.f;
#pragma unroll 16
    for (int q = 0; q < 128; ++q) { const int c = dir ? 127 - q : q;
        const LAS bf16_t* sp = (const LAS bf16_t*)(img + (bl * 128 + c) * EpiSLds::RS + (dir * 128 + p) * 2);
        const float sr = bf2f(sp[0]), si = bf2f(sp[64]);
        bf16_t* xp = UX + ((size_t)g * 512 + b * 128 + c) * 512 + 256 + dir * 128 + p;
        xp[0] = f2bf(xr); xp[64] = f2bf(xi);
        const float nr = l16r * xr - l16i * xi + sr, ni = l16r * xi + l16i * xr + si; xr = nr; xi = ni; }
}
__device__ __forceinline__ void touch_x_tile(const Frame& F) {
    int pm_, pn_; tile_of(unit_of(F, 0), 8, pm_, pn_);
    const float* xb = F.in[I_X] + (size_t)pm_ * 256 * DM + pn_ * 256;
    float t0_ = xb[(size_t)((F.tid) >> 3) * DM + (F.tid & 7) * 32], t1_ = xb[(size_t)((F.tid + 512) >> 3) * DM + (F.tid & 7) * 32],
          t2_ = xb[(size_t)((F.tid + 1024) >> 3) * DM + (F.tid & 7) * 32], t3_ = xb[(size_t)((F.tid + 1536) >> 3) * DM + (F.tid & 7) * 32];
    const bf16_t* wb = (const bf16_t*)(F.ws + WS_WOUTB) + pn_ * 256;
    float t4_ = *(const float*)(wb + (size_t)(F.tid >> 2) * DM + (F.tid & 3) * 64), t5_ = *(const float*)(wb + (size_t)(128 + (F.tid >> 2)) * DM + (F.tid & 3) * 64);
    asm volatile("" :: "v"(t0_), "v"(t1_), "v"(t2_), "v"(t3_), "v"(t4_), "v"(t5_));
}
__device__ __forceinline__ void p_mixer(const Frame& F) {
    for (int u = F.bid; u < 2 * NG; u += F.G) { const int g = u >> 1, pm = u & 1;
        const ARows A{(const bf16_t*)(F.ws + WS_UX) + (size_t)g * 512 * 512, 512};
        { B2Bf16 Bl; Bl.base = (const bf16_t*)(F.ws + WS_BMAT) + (size_t)g * 256 * 256; Bl.ld = 256; const EpiSLds E{(LAS unsigned char*)F.lds};
          gemm_tile2<ARows, B2Bf16, EpiSLds, false>(F.lds, A, Bl, E, pm * 256, 0, 256); }
        __syncthreads();
        ssm_scan_half_lds(F, g, pm);
        asm volatile("s_waitcnt vmcnt(0)" ::: "memory"); __syncthreads();
        { B2Bf16 Bl; Bl.base = (const bf16_t*)(F.ws + WS_KCMAT) + (size_t)g * 512 * 256; Bl.ld = 256; const EpiY E{(bf16_t*)(F.ws + WS_ZB), g};
          gemm_tile2<ARows, B2Bf16, EpiY, false>(F.lds, A, Bl, E, pm * 256, 0, 512); }
        __syncthreads();
    }
    if (F.G == 256) {
        if (F.bid < 128) {
            unsigned* ycnt = (unsigned*)(F.ws + WS_CTL + 24576);
            unsigned* tmo = (unsigned*)(F.ws + WS_CTL) + XB_TMO;
            asm volatile("s_waitcnt vmcnt(0)" ::: "memory"); __syncthreads();
            if (F.tid == 0) {
                __builtin_amdgcn_fence(__ATOMIC_RELEASE, "agent"); asm volatile("s_waitcnt vmcnt(0)" ::: "memory");
                __hip_atomic_fetch_add(ycnt, 1u, __ATOMIC_RELAXED, __HIP_MEMORY_SCOPE_AGENT);
                unsigned sp = 0;
                while (__hip_atomic_load(ycnt, __ATOMIC_RELAXED, __HIP_MEMORY_SCOPE_AGENT) < 128u) { __builtin_amdgcn_s_sleep(2);
                    if ((++sp & 255u) == 0u) { if (__hip_atomic_load(tmo, __ATOMIC_RELAXED, __HIP_MEMORY_SCOPE_AGENT)) break; if (sp > (1u << 20)) { atomicAdd(tmo, 1u); break; } } }
                __builtin_amdgcn_fence(__ATOMIC_ACQUIRE, "agent"); asm volatile("s_waitcnt vmcnt(0)" ::: "memory");
            }
            __syncthreads();
            const ARows A{(const bf16_t*)(F.ws + WS_ZB), 1024};
            const EpiGlu E{(const bf16_t*)(F.ws + WS_ZB), F.in[I_BGLU], (bf16_t*)(F.ws + WS_MIX), (float*)(F.ws + WS_SQS)};
            int pm, pn; tile_of(F.bid, 4, pm, pn);
            B2Bf16 Bl; Bl.base = (const bf16_t*)(F.ws + WS_WGLUB) + pn * 256; Bl.ld = 1024;
            gemm_tile2<ARows, B2Bf16, EpiGlu, false>(F.lds, A, Bl, E, pm * 256, pn * 256, 1024);
        }
        else { attn_units(F, F.bid - 128, 128, NB * NH * 16);
            touch_x_tile(F); }
    } else attn_units(F, F.bid, F.G, NB * NH * 16);
}


#ifndef PROBE_ABL
#define PROBE_ABL -1
#endif
#ifndef PROBE_X
#define PROBE_X 0
#endif
__device__ __forceinline__ void p_moe1_probe(const Frame& F) {
#if PROBE_ABL >= 0
    for (int r = 0;; ++r) { const int v = unit_of(F, r); if (v >= NE * 22 * 4) break; const int pm = v & 3, pn = (v >> 2) % 22, e = (v >> 2) / 22;
        const AGather A{(const bf16_t*)(F.ws + WS_H2), (const int*)(F.ws + WS_IDX), e, 0u};
        B2F32Dual Bl; Bl.g = F.in[I_WGATE] + (size_t)e * DM * DFF + pn * 128; Bl.u = F.in[I_WUP] + (size_t)e * DM * DFF + pn * 128; Bl.ld = DFF;
        const EpiMoe1 E{(bf16_t*)(F.ws + WS_HID) + (size_t)e * 1024 * DFF};
        gemm_tile2<AGather, B2F32Dual, EpiMoe1, true, PROBE_ABL>(F.lds, A, Bl, E, pm * 256, pn * 128, DM); }
#endif
}
__device__ __forceinline__ void p_ssm_naive(const Frame& F) {
    if (F.wave != 0) return;
    const bf16_t* UX = (const bf16_t*)(F.ws + WS_UX); float* ybuf = (float*)(F.ws + WS_SS); bf16_t* ZB = (bf16_t*)(F.ws + WS_ZB);
    const int lane = F.lane;
    for (int u = F.bid; u < NB * NG; u += F.G) {
        const int b = u >> 6, g = u & 63;
        for (int dir = 0; dir < 2; ++dir) {
            const int pg = dir * 64 + g;
            const float dt = expf(F.in[I_LOGDT][pg]);
            const float lr = F.in[I_ARE][pg * 64 + lane], li = F.in[I_AIM][pg * 64 + lane];
            const float mag = expf(lr * dt); const float lbr = mag * cosf(li * dt), lbi = mag * sinf(li * dt);
            const float den = lr * lr + li * li, nr = lbr - 1.0f;
            const float fr = (nr * lr + lbi * li) / den, fi = (lbi * lr - nr * li) / den;
            float bbr[16], bbi[16], cr[16], ci[16];
#pragma unroll
            for (int h = 0; h < 16; ++h) { const float br = F.in[I_BRE][(size_t)(pg * 64 + lane) * 16 + h], bi = F.in[I_BIM][(size_t)(pg * 64 + lane) * 16 + h];
                bbr[h] = fr * br - fi * bi; bbi[h] = fr * bi + fi * br;
                cr[h] = F.in[I_CRE][(size_t)(pg * 16 + h) * 64 + lane]; ci[h] = F.in[I_CIM][(size_t)(pg * 16 + h) * 64 + lane]; }
            const float dsk = F.in[I_SSMD][g * 16 + (lane & 15)];
            float xr = 0.f, xi = 0.f;
            for (int s = 0; s < SEQ; ++s) {
                const int l = dir ? (SEQ - 1 - s) : s;
                const bf16_t* up = UX + (size_t)(g * 512 + b * 128 + (l >> 4)) * 512 + (l & 15) * 16;
                const float uval = bf2f(up[lane & 15]);
                float bur = 0.f, bui = 0.f;
#pragma unroll
                for (int h = 0; h < 16; ++h) { const float uh = __shfl(uval, h); bur += bbr[h] * uh; bui += bbi[h] * uh; }
                const float nxr = lbr * xr - lbi * xi + bur, nxi = lbr * xi + lbi * xr + bui; xr = nxr; xi = nxi;
                float myy = 0.f;
#pragma unroll
                for (int h = 0; h < 16; ++h) { const float v = wave_sum(cr[h] * xr - ci[h] * xi); if (lane == h) myy = v; }
                const size_t o = (size_t)(b * SEQ + l) * 1024 + g * 16;
                if (lane < 16) {
                    if (dir == 0) ybuf[o + lane] = myy;
                    else { const float y = ybuf[o + lane] + myy + dsk * uval; ZB[o + lane] = f2bf(gelu_tanh(y)); }
                }
            }
        }
    }
}

__device__ __forceinline__ void p_attn_naive(const Frame& F) {
    const bf16_t* Q = (const bf16_t*)(F.ws + WS_Q); const bf16_t* Kb = (const bf16_t*)(F.ws + WS_K); const bf16_t* Vb = (const bf16_t*)(F.ws + WS_V);
    bf16_t* Y = (bf16_t*)(F.ws + WS_YATT); const float* rpb = F.in[I_RPB];
    for (int id = F.bid * NT + F.tid; id < TOK * NH; id += F.G * NT) {
        const int t = id >> 4, h = id & 15, b = t >> 11, l = t & 2047, r = l >> 6, w = l & 63;
        int rs = r - 4; rs = rs < 0 ? 0 : (rs > 24 ? 24 : rs);
        int cs = w - 8; cs = cs < 0 ? 0 : (cs > 48 ? 48 : cs);
        float q[64], acc[64];
        const u32x4* qp = (const u32x4*)(Q + (size_t)t * 1024 + h * 64);
#pragma unroll
        for (int i = 0; i < 8; ++i) { const u32x4 v = qp[i]; q[i * 8 + 0] = bflo(v.x); q[i * 8 + 1] = bfhi(v.x); q[i * 8 + 2] = bflo(v.y); q[i * 8 + 3] = bfhi(v.y);
            q[i * 8 + 4] = bflo(v.z); q[i * 8 + 5] = bfhi(v.z); q[i * 8 + 6] = bflo(v.w); q[i * 8 + 7] = bfhi(v.w); }
#pragma unroll
        for (int d = 0; d < 64; ++d) acc[d] = 0.f;
        float m = -1e30f, lsum = 0.f;
        for (int j = 0; j < 8; ++j) {
            const int kr = rs + j, dr = kr - r + 7;
            for (int kk = 0; kk < 16; ++kk) {
                const int wk = cs + kk, dc = wk - w + 15;
                const size_t kt = (size_t)(b * SEQ + kr * 64 + wk) * 1024 + h * 64;
                const u32x4* kp = (const u32x4*)(Kb + kt);
                float s = 0.f;
#pragma unroll
                for (int i = 0; i < 8; ++i) { const u32x4 v = kp[i];
                    s += q[i * 8 + 0] * bflo(v.x) + q[i * 8 + 1] * bfhi(v.x) + q[i * 8 + 2] * bflo(v.y) + q[i * 8 + 3] * bfhi(v.y)
                       + q[i * 8 + 4] * bflo(v.z) + q[i * 8 + 5] * bfhi(v.z) + q[i * 8 + 6] * bflo(v.w) + q[i * 8 + 7] * bfhi(v.w); }
                s += rpb[(h * 15 + dr) * 31 + dc];
                const float mn = fmaxf(m, s); const float corr = __expf(m - mn), p = __expf(s - mn);
                lsum = lsum * corr + p; m = mn;
                const u32x4* vp = (const u32x4*)(Vb + kt);
#pragma unroll
                for (int i = 0; i < 8; ++i) { const u32x4 v = vp[i];
                    acc[i * 8 + 0] = acc[i * 8 + 0] * corr + p * bflo(v.x); acc[i * 8 + 1] = acc[i * 8 + 1] * corr + p * bfhi(v.x);
                    acc[i * 8 + 2] = acc[i * 8 + 2] * corr + p * bflo(v.y); acc[i * 8 + 3] = acc[i * 8 + 3] * corr + p * bfhi(v.y);
                    acc[i * 8 + 4] = acc[i * 8 + 4] * corr + p * bflo(v.z); acc[i * 8 + 5] = acc[i * 8 + 5] * corr + p * bfhi(v.z);
                    acc[i * 8 + 6] = acc[i * 8 + 6] * corr + p * bflo(v.w); acc[i * 8 + 7] = acc[i * 8 + 7] * corr + p * bfhi(v.w); }
            }
        }
        const float inv = 1.0f / lsum;
        u32x4* yp = (u32x4*)(Y + (size_t)t * 1024 + h * 64);
#pragma unroll
        for (int i = 0; i < 8; ++i) { u32x4 o; o.x = pack2(acc[i * 8 + 0] * inv, acc[i * 8 + 1] * inv); o.y = pack2(acc[i * 8 + 2] * inv, acc[i * 8 + 3] * inv);
            o.z = pack2(acc[i * 8 + 4] * inv, acc[i * 8 + 5] * inv); o.w = pack2(acc[i * 8 + 6] * inv, acc[i * 8 + 7] * inv); yp[i] = o; }
    }
}

__device__ __forceinline__ void p_normcat(const Frame& F) {
    const bf16_t* YS = (const bf16_t*)(F.ws + WS_YSSM); const bf16_t* YA = (const bf16_t*)(F.ws + WS_YATT); bf16_t* MIX = (bf16_t*)(F.ws + WS_MIX);
    const int step = F.G * 8; int t = F.bid * 8 + F.wave;
    u32x4 nw[2][2];
    if (t < TOK) {
#pragma unroll
        for (int half = 0; half < 2; ++half)
#pragma unroll
            for (int i = 0; i < 2; ++i) nw[half][i] = *(const u32x4*)((half ? YA : YS) + (size_t)t * 1024 + i * 512 + F.lane * 8); }
    for (; t < TOK; t += step) {
        u32x4 cw[2][2];
#pragma unroll
        for (int half = 0; half < 2; ++half)
#pragma unroll
            for (int i = 0; i < 2; ++i) cw[half][i] = nw[half][i];
        if (t + step < TOK) {
#pragma unroll
            for (int half = 0; half < 2; ++half)
#pragma unroll
                for (int i = 0; i < 2; ++i) nw[half][i] = *(const u32x4*)((half ? YA : YS) + (size_t)(t + step) * 1024 + i * 512 + F.lane * 8); }
#pragma unroll
        for (int half = 0; half < 2; ++half) {
            const float* g = F.in[half ? I_GATT : I_GSSM];
            float v[16]; float ss = 0.f;
#pragma unroll
            for (int i = 0; i < 2; ++i) { const u32x4 w = cw[half][i];
                v[i * 8 + 0] = bflo(w.x); v[i * 8 + 1] = bfhi(w.x); v[i * 8 + 2] = bflo(w.y); v[i * 8 + 3] = bfhi(w.y); v[i * 8 + 4] = bflo(w.z); v[i * 8 + 5] = bfhi(w.z); v[i * 8 + 6] = bflo(w.w); v[i * 8 + 7] = bfhi(w.w); }
#pragma unroll
            for (int i = 0; i < 16; ++i) ss += v[i] * v[i];
            ss = wave_sum(ss);
            const float rstd = rsqrtf(ss * (1.0f / 1024.0f) + EPS);
#pragma unroll
            for (int i = 0; i < 2; ++i) { const int k = i * 512 + F.lane * 8; const f32x4 g0 = *(const f32x4*)(g + k), g1 = *(const f32x4*)(g + k + 4);
                u32x4 o; o.x = pack2(v[i * 8 + 0] * rstd * g0[0], v[i * 8 + 1] * rstd * g0[1]); o.y = pack2(v[i * 8 + 2] * rstd * g0[2], v[i * 8 + 3] * rstd * g0[3]);
                o.z = pack2(v[i * 8 + 4] * rstd * g1[0], v[i * 8 + 5] * rstd * g1[1]); o.w = pack2(v[i * 8 + 6] * rstd * g1[2], v[i * 8 + 7] * rstd * g1[3]);
                *(u32x4*)(MIX + (size_t)t * DM + half * 1024 + k) = o; }
        }
    }
}

template <int N> __device__ __forceinline__ void h2_step(float (&lg)[32], int lane, int m) {
    const bool hi = (lane & m) != 0;
#pragma unroll
    for (int j = 0; j < N; ++j) { float a = lg[j], b = lg[j + N]; asm volatile("" : "+v"(a), "+v"(b));
        const float keep = hi ? b : a, give = hi ? a : b; lg[j] = keep + __shfl_xor(give, m); }
}
__device__ __forceinline__ void p_h2(const Frame& F, int panel = -1, int pn = 0) {
    const bf16_t* X1 = (const bf16_t*)(F.ws + WS_X1); const float* g = F.in[I_GFFN]; const float* mod = F.modp(); const float* wr = F.in[I_WROUTER];
    bf16_t* H2 = (bf16_t*)(F.ws + WS_H2); float* AFF = (float*)(F.ws + WS_AFF);
    float* wt = (float*)F.lds;
    for (int idx = F.tid; idx < 2048 * 16; idx += NT) wt[(idx & 15) * 2052 + (idx >> 4)] = wr[idx];
    if (panel >= 0 && F.tid == 0) { unsigned* pc = (unsigned*)(F.ws + WS_CTL + 25088) + panel * 16; unsigned* tmo = (unsigned*)(F.ws + WS_CTL) + XB_TMO; unsigned sp = 0;
        while (__hip_atomic_load(pc, __ATOMIC_RELAXED, __HIP_MEMORY_SCOPE_AGENT) < 8u) { __builtin_amdgcn_s_sleep(2);
            if ((++sp & 255u) == 0u) { if (__hip_atomic_load(tmo, __ATOMIC_RELAXED, __HIP_MEMORY_SCOPE_AGENT)) break; if (sp > (1u << 20)) { atomicAdd(tmo, 1u); break; } } }
        __builtin_amdgcn_fence(__ATOMIC_ACQUIRE, "agent"); asm volatile("s_waitcnt vmcnt(0)" ::: "memory"); }
    __syncthreads();
    const int lane = F.lane;
    const int tp_first = panel >= 0 ? (panel * 256 + pn * 32) / 2 + F.wave : F.bid * 8 + F.wave, tp_step = panel >= 0 ? 8 : F.G * 8, tp_end = panel >= 0 ? (panel * 256 + pn * 32) / 2 + 16 : TOK / 2;
    for (int tp = tp_first; tp < tp_end; tp += tp_step) {
        const int t0 = 2 * tp, b = t0 >> 11, l0 = t0 & 2047; const bf16_t* xr = X1 + (size_t)t0 * DM;
        float ss0 = 0.f, ss1 = 0.f;
        u32x2 xw0[8], xw1[8];
#pragma unroll
        for (int i = 0; i < 8; ++i) { xw0[i] = *(const u32x2*)(xr + i * 256 + lane * 4); xw1[i] = *(const u32x2*)(xr + DM + i * 256 + lane * 4); }
#pragma unroll
        for (int i = 0; i < 8; ++i) { const f32x4 a0 = (f32x4){bflo(xw0[i].x), bfhi(xw0[i].x), bflo(xw0[i].y), bfhi(xw0[i].y)}, a1 = (f32x4){bflo(xw1[i].x), bfhi(xw1[i].x), bflo(xw1[i].y), bfhi(xw1[i].y)};
            ss0 += a0[0] * a0[0] + a0[1] * a0[1] + a0[2] * a0[2] + a0[3] * a0[3];
            ss1 += a1[0] * a1[0] + a1[1] * a1[1] + a1[2] * a1[2] + a1[3] * a1[3]; }
        __builtin_amdgcn_sched_barrier(0);
        ss0 = wave_sum(ss0); ss1 = wave_sum(ss1);
        const float r0 = rsqrtf(ss0 * (1.0f / DM) + EPS), r1 = rsqrtf(ss1 * (1.0f / DM) + EPS);
        float lg[32];
#pragma unroll
        for (int e = 0; e < 32; ++e) lg[e] = 0.f;
#pragma unroll
        for (int i = 0; i < 8; ++i) { const int k = i * 256 + lane * 4;
            const f32x4 gv = *(const f32x4*)(g + k), sh = *(const f32x4*)(mod + b * 12288 + 6144 + k), sc = *(const f32x4*)(mod + b * 12288 + 8192 + k);
            const f32x4 a0 = (f32x4){bflo(xw0[i].x), bfhi(xw0[i].x), bflo(xw0[i].y), bfhi(xw0[i].y)}, a1 = (f32x4){bflo(xw1[i].x), bfhi(xw1[i].x), bflo(xw1[i].y), bfhi(xw1[i].y)};
            f32x4 o0, o1;
#pragma unroll
            for (int j = 0; j < 4; ++j) { const float gs = gv[j] * (1.0f + sc[j]); o0[j] = (a0[j] * r0) * gs + sh[j]; o1[j] = (a1[j] * r1) * gs + sh[j]; }
            u32x2 w; w.x = pack2(o0[0], o0[1]); w.y = pack2(o0[2], o0[3]); *(u32x2*)(H2 + (size_t)t0 * DM + k) = w;
            w.x = pack2(o1[0], o1[1]); w.y = pack2(o1[2], o1[3]); *(u32x2*)(H2 + (size_t)(t0 + 1) * DM + k) = w;
#pragma unroll
            for (int e = 0; e < 16; ++e) { const f32x4 wv = *(const f32x4*)(wt + e * 2052 + k);
                lg[e] += o0[0] * wv[0] + o0[1] * wv[1] + o0[2] * wv[2] + o0[3] * wv[3];
                lg[16 + e] += o1[0] * wv[0] + o1[1] * wv[1] + o1[2] * wv[2] + o1[3] * wv[3];
                if ((e & 3) == 3) __builtin_amdgcn_sched_barrier(0); }
        }
h2_step<16>(lg, lane, 32); h2_step<8>(lg, lane, 16); h2_step<4>(lg, lane, 8); h2_step<2>(lg, lane, 4); h2_step<1>(lg, lane, 2);
        float z = lg[0] + __shfl_xor(lg[0], 1);
        float mx = z;
#pragma unroll
        for (int m = 2; m <= 16; m <<= 1) mx = fmaxf(mx, __shfl_xor(mx, m));
        const float ex = expf(z - mx); float den = ex;
#pragma unroll
        for (int m = 2; m <= 16; m <<= 1) den += __shfl_xor(den, m);
        if ((lane & 1) == 0) AFF[(size_t)(b * NE + ((lane >> 1) & 15)) * SEQ + l0 + (lane >> 5)] = ex / den;
    }
}

__device__ __forceinline__ int tk_block_excl_scan(int v, int tid, int lane, int wave, int* wsum, int& total) {
    int x = v;
#pragma unroll
    for (int o = 1; o < 64; o <<= 1) { const int y = __shfl_up(x, o); if (lane >= o) x += y; }
    if (lane == 63) wsum[wave] = x;
    __syncthreads();
    int off = 0, tot = 0;
#pragma unroll
    for (int w = 0; w < 8; ++w) { const int s = wsum[w]; if (w < wave) off += s; tot += s; }
    __syncthreads();
    total = tot; return off + x - v;
}
__device__ __forceinline__ void p_topk(const Frame& F) {
    int* hist = (int*)F.lds;
    int* ctl = hist + 256;
    int* wsum = hist + 272;
    const float* AFF = (const float*)(F.ws + WS_AFF); int* IDX = (int*)(F.ws + WS_IDX); float* WAFF = (float*)(F.ws + WS_WAFF); int* SLOT = (int*)(F.ws + WS_SLOT);
    const int tid = F.tid, lane = F.lane, wave = F.wave;
    for (int u = F.bid; u < NB * NE; u += F.G) {
        unsigned key[4];
        { const f32x4 v = *(const f32x4*)(AFF + (size_t)u * SEQ + 4 * tid);
#pragma unroll
          for (int s = 0; s < 4; ++s) key[s] = __float_as_uint(v[s]); }
        unsigned prefix = 0u; int remaining = CAP;
#pragma unroll
        for (int pass = 0; pass < 4; ++pass) {
            const int shift = 24 - 8 * pass;
            if (tid < 256) hist[tid] = 0;
            __syncthreads();
#pragma unroll
            for (int s = 0; s < 4; ++s) { const bool cand = (pass == 0) || ((key[s] >> (shift + 8)) == prefix); if (cand) atomicAdd(&hist[(key[s] >> shift) & 255u], 1); }
            __syncthreads();
            if (wave == 0) {
                const int h0 = hist[4 * lane], h1 = hist[4 * lane + 1], h2 = hist[4 * lane + 2], h3 = hist[4 * lane + 3];
                const int mine = h0 + h1 + h2 + h3;
                int suf = mine;
#pragma unroll
                for (int o = 1; o < 64; o <<= 1) { const int y = __shfl_down(suf, o); if (lane + o < 64) suf += y; }
                const int above = suf - mine;
                if (above < remaining && remaining <= suf) {
                    int d, ab;
                    if (above + h3 >= remaining) { d = 3; ab = above; }
                    else if (above + h3 + h2 >= remaining) { d = 2; ab = above + h3; }
                    else if (above + h3 + h2 + h1 >= remaining) { d = 1; ab = above + h3 + h2; }
                    else { d = 0; ab = above + h3 + h2 + h1; }
                    ctl[0] = 4 * lane + d; ctl[1] = remaining - ab;
                }
            }
            __syncthreads();
            prefix = (prefix << 8) | (unsigned)ctl[0]; remaining = ctl[1];
            __syncthreads();
        }
        const unsigned T = prefix; const int need = remaining;
        int neq = 0;
#pragma unroll
        for (int s = 0; s < 4; ++s) neq += (key[s] == T) ? 1 : 0;
        int toteq; int eqbase = tk_block_excl_scan(neq, tid, lane, wave, wsum, toteq);
        int nsel = 0; bool sel[4];
#pragma unroll
        for (int s = 0; s < 4; ++s) { const bool eq = (key[s] == T); sel[s] = (key[s] > T) || (eq && eqbase < need); if (eq) ++eqbase; nsel += sel[s] ? 1 : 0; }
        int totsel; int slot = tk_block_excl_scan(nsel, tid, lane, wave, wsum, totsel);
#pragma unroll
        for (int s = 0; s < 4; ++s) { const int tok = 4 * tid + s;
            if (sel[s]) { IDX[u * CAP + slot] = tok; WAFF[u * CAP + slot] = __uint_as_float(key[s]); SLOT[(size_t)u * SEQ + tok] = slot; ++slot; }
            else SLOT[(size_t)u * SEQ + tok] = -1; }
        __syncthreads();
    }
}

__device__ __forceinline__ void p_final(const Frame& F) {
    const bf16_t* X1 = (const bf16_t*)(F.ws + WS_X1); const float* mod = F.modp(); const float* g = F.in[I_GFINAL];
    const bf16_t* YE = (const bf16_t*)(F.ws + WS_YE); const int* SLOT = (const int*)(F.ws + WS_SLOT);
    for (int t = F.bid * 8 + F.wave; t < TOK; t += F.G * 8) {
        const int b = t >> 11, l = t & 2047; const bf16_t* xr = X1 + (size_t)t * DM;
        f32x4 mo[8];
#pragma unroll
        for (int i = 0; i < 8; ++i) mo[i] = (f32x4){0.f, 0.f, 0.f, 0.f};
        for (int e = 0; e < NE; ++e) {
            const int s = SLOT[(size_t)(b * NE + e) * SEQ + l];
            if (s >= 0) { const bf16_t* yr = YE + ((size_t)e * 1024 + b * 256 + s) * DM;
#pragma unroll
                for (int i = 0; i < 8; ++i) { const u32x2 w = *(const u32x2*)(yr + i * 256 + F.lane * 4); mo[i][0] += bflo(w.x); mo[i][1] += bfhi(w.x); mo[i][2] += bflo(w.y); mo[i][3] += bfhi(w.y); } }
        }
        f32x4 v[8]; float ss = 0.f;
#pragma unroll
        for (int i = 0; i < 8; ++i) { const int k = i * 256 + F.lane * 4; const u32x2 xw = *(const u32x2*)(xr + k); const f32x4 xv = (f32x4){bflo(xw.x), bfhi(xw.x), bflo(xw.y), bfhi(xw.y)}, gt = *(const f32x4*)(mod + b * 12288 + 10240 + k);
            v[i] = xv + gt * mo[i]; ss += v[i][0] * v[i][0] + v[i][1] * v[i][1] + v[i][2] * v[i][2] + v[i][3] * v[i][3]; }
        ss = wave_sum(ss);
        const float rstd = rsqrtf(ss * (1.0f / DM) + EPS);
#pragma unroll
        for (int i = 0; i < 8; ++i) { const int k = i * 256 + F.lane * 4; const f32x4 gv = *(const f32x4*)(g + k);
            *(f32x4*)(F.out + (size_t)t * DM + k) = v[i] * rstd * gv; }
    }
}

constexpr int N_PHASES = 14;
__global__ void __launch_bounds__(NT, 2) fwd(Args args) {
    extern __shared__ __attribute__((aligned(16))) unsigned char lds[];
    Frame F;
#pragma unroll
    for (int i = 0; i < 26; ++i) F.in[i] = args.in[i];
    F.out = args.out; F.ws = args.ws; F.lds = lds;
    F.tid = threadIdx.x; F.lane = F.tid & 63; F.wave = __builtin_amdgcn_readfirstlane(F.tid >> 6); F.G = gridDim.x; F.bid = blockIdx.x;
    const int lo = args.ph_lo, hi = args.ph_hi;
    XcdBarrier bar; bar.bar = (unsigned*)(F.ws + WS_CTL); bar.x = 0; bar.nloc = 0u; bar.nx = 0u;
    if (hi - lo > 1) bar = xcd_barrier_post((unsigned*)(F.ws + WS_CTL));
    bool bar_ready = false;
#define IN(k) (lo <= (k) && (k) < hi)
#define GRID_BAR() do { if (!bar_ready) { xcd_barrier_setup(bar); bar_ready = true; } xcd_barrier(bar); } while (0)
#define SEAM(k) do { if (IN(k) && IN((k) + 1)) GRID_BAR(); } while (0)
#define ADA_DONE() do { asm volatile("s_waitcnt vmcnt(0)" ::: "memory"); __syncthreads();          \
        if (F.tid == 0) { __builtin_amdgcn_fence(__ATOMIC_RELEASE, "agent"); __hip_atomic_fetch_add((unsigned*)(F.ws + WS_CTL + 24832), 1u, __ATOMIC_RELAXED, __HIP_MEMORY_SCOPE_AGENT); } } while (0)
#define ADA_WAIT() do { if (F.tid == 0) { unsigned* acnt_ = (unsigned*)(F.ws + WS_CTL + 24832); unsigned* tmo_ = (unsigned*)(F.ws + WS_CTL) + XB_TMO; unsigned sp_ = 0; \
            while (__hip_atomic_load(acnt_, __ATOMIC_RELAXED, __HIP_MEMORY_SCOPE_AGENT) < (unsigned)F.G) { __builtin_amdgcn_s_sleep(2); \
                if ((++sp_ & 255u) == 0u) { if (__hip_atomic_load(tmo_, __ATOMIC_RELAXED, __HIP_MEMORY_SCOPE_AGENT)) break; if (sp_ > (1u << 20)) { atomicAdd(tmo_, 1u); break; } } } \
            __builtin_amdgcn_fence(__ATOMIC_ACQUIRE, "agent"); asm volatile("s_waitcnt vmcnt(0)" ::: "memory"); } \
        __syncthreads(); } while (0)
    f32x4 code_touch = (f32x4){0.f, 0.f, 0.f, 0.f};
    if (IN(0)) { unsigned long long pc_; asm volatile("s_getpc_b64 %0" : "=s"(pc_));
        const char* cp_ = (const char*)(pc_ & ~0xFFFull) + (size_t)(F.bid >> 3) * 8192 + (size_t)F.tid * 16;
        asm volatile("global_load_dwordx4 %0, %1, off" : "+v"(code_touch) : "v"(cp_)); }
    if (IN(0)) { for (int rep_ = 0; rep_ <= REPS(0); ++rep_) { if (FAST_SSM && F.G == 256) {
            if (F.bid < 128) { p_ada(F, F.bid, 128, 256); ADA_DONE(); p_ssm_prep(F, F.bid >> 1, F.bid & 1, 2); }
            else { p_ada(F, 128 + F.bid, 128, 768); ADA_DONE(); p_wconv(F, F.bid - 128, 128); }
        } else { p_ada(F, F.bid, F.G, 768); p_wconv(F, F.bid, F.G); if (FAST_SSM) for (int g = F.bid; g < NG; g += F.G) p_ssm_prep(F, g, 0, 1); } __syncthreads(); } } asm volatile("s_waitcnt vmcnt(0)" :: "v"(code_touch) : "memory");
    if (IN(0) && IN(1)) { if (FAST_SSM && F.G == 256) ADA_WAIT(); else GRID_BAR(); }
    if (IN(1)) { for (int rep_ = 0; rep_ <= REPS(1); ++rep_) { p_h1(F); __syncthreads(); } } SEAM(1);
    if (IN(2)) { for (int rep_ = 0; rep_ <= REPS(2); ++rep_) { if (FAST_INPROJ) p_inproj_fast(F); else p_inproj_naive(F); __syncthreads(); } } SEAM(2);
    if (IN(3)) { for (int rep_ = 0; rep_ <= REPS(3); ++rep_) { if (FAST_SSM && FAST_ATTN) p_mixer(F); else { p_ssm_naive(F); __syncthreads(); p_attn_naive(F); } __syncthreads(); } } do { if (IN(3) && IN(6) && IN(8)) GRID_BAR(); } while (0);
    if (IN(6) && !(FAST_SSM && FAST_ATTN && FAST_GLU && F.G == 256)) { for (int rep_ = 0; rep_ <= REPS(6); ++rep_) { if (FAST_GLU) p_glu_fast(F); else p_glu_naive(F); __syncthreads(); } if (IN(8)) GRID_BAR(); }
    if (IN(8)) { for (int rep_ = 0; rep_ <= REPS(8); ++rep_) { if (FAST_OUT) p_outproj_fast(F); else p_outproj_naive(F); __syncthreads(); } }
    const bool h2_by_panel = FAST_OUT && F.G == 256 && IN(8) && IN(9) && PROBE_MASK == 0;
    if (IN(8) && IN(9) && !h2_by_panel) GRID_BAR();
    if (IN(9)) { for (int rep_ = 0; rep_ <= REPS(9); ++rep_) { if (h2_by_panel) { int pm_, pn_; tile_of(unit_of(F, 0), 8, pm_, pn_); p_h2(F, pm_, pn_); } else p_h2(F); __syncthreads(); } } SEAM(9);
    if (IN(10)) { for (int rep_ = 0; rep_ <= REPS(10); ++rep_) { p_topk(F); __syncthreads(); } }
    if (IN(10) && IN(11) && FAST_MOE1 && F.bid >= NB * NE) {
        const int v_ = unit_of(F, 0), pn_ = (v_ >> 2) % 22, e_ = (v_ >> 2) / 22; float tv_[4];
#pragma unroll
        for (int j = 0; j < 4; ++j) { const int id = F.tid * 4 + j, k = id >> 3, rem = id & 7;
            tv_[j] = (((rem >> 2) ? F.in[I_WUP] : F.in[I_WGATE]) + (size_t)e_ * DM * DFF + (size_t)k * DFF + pn_ * 128 + (rem & 3) * 32)[0]; }
        asm volatile("" :: "v"(tv_[0]), "v"(tv_[1]), "v"(tv_[2]), "v"(tv_[3])); }
    SEAM(10);
    if (IN(11)) { for (int rep_ = 0; rep_ <= REPS(11); ++rep_) { if (FAST_MOE1) p_moe1_fast(F); else p_moe1_naive(F); __syncthreads(); } } SEAM(11);
    if (IN(12)) { for (int rep_ = 0; rep_ <= REPS(12); ++rep_) { if (FAST_MOE2) p_moe2_fast(F); else p_moe2_naive(F); __syncthreads(); } }
    SEAM(12);
    if (PROBE_ABL >= 0 && IN(12)) { GRID_BAR(); p_moe1_probe(F); }
#if PROBE_X == 1
    if (IN(12)) { GRID_BAR(); p_attn_fast(F); }
#elif PROBE_X == 2
    if (IN(12)) { GRID_BAR(); for (int u = F.bid; u < 2 * NG; u += F.G) { const int g = u >> 1, pm = u & 1;
        const ARows A{(const bf16_t*)(F.ws + WS_UX) + (size_t)g * 512 * 512, 512};
        { B2Bf16 Bl; Bl.base = (const bf16_t*)(F.ws + WS_BMAT) + (size_t)g * 256 * 256; Bl.ld = 256; const EpiS E{(float*)(F.ws + WS_SS) + (size_t)g * 512 * 256};
          gemm_tile2<ARows, B2Bf16, EpiS, false>(F.lds, A, Bl, E, pm * 256, 0, 256); }
        asm volatile("s_waitcnt vmcnt(0)" ::: "memory"); __syncthreads(); ssm_scan_half(F, g, pm); asm volatile("s_waitcnt vmcnt(0)" ::: "memory"); __syncthreads();
        { B2Bf16 Bl; Bl.base = (const bf16_t*)(F.ws + WS_KCMAT) + (size_t)g * 512 * 256; Bl.ld = 256; const EpiY E{(bf16_t*)(F.ws + WS_ZB), g};
          gemm_tile2<ARows, B2Bf16, EpiY, false>(F.lds, A, Bl, E, pm * 256, 0, 512); } __syncthreads(); } }
#elif PROBE_X == 4
    if (IN(12)) { GRID_BAR(); for (int u = F.bid; u < 2 * NG; u += F.G) { const int g = u >> 1, pm = u & 1; ssm_scan_half(F, g, pm); } }
#elif PROBE_X == 3
    if (IN(12)) { GRID_BAR(); }
#endif
    if (IN(13)) { for (int rep_ = 0; rep_ <= REPS(13); ++rep_) { p_final(F); __syncthreads(); } }
#undef IN
#undef SEAM
}

extern "C" void kernel_launch(void* const* d_in, const int* in_sizes, int n_in, void* d_out, int out_size, void* d_ws, size_t ws_size, hipStream_t stream) {
    static int grid = 0;
    if (grid == 0) {
        if (n_in != 26 || out_size != TOK * DM || ws_size < WS_END) { fprintf(stderr, "kernel_launch: unexpected problem (n_in %d out %d ws %zu need %zu)\n", n_in, out_size, ws_size, (size_t)WS_END); grid = -1; return; }
        int dev = 0, cus = 0, per_cu = 0;
        if (hipGetDevice(&dev) != hipSuccess || hipDeviceGetAttribute(&cus, hipDeviceAttributeMultiprocessorCount, dev) != hipSuccess) { grid = -1; return; }
        if (hipFuncSetAttribute((const void*)fwd, hipFuncAttributeMaxDynamicSharedMemorySize, LDS_BYTES) != hipSuccess) { fprintf(stderr, "kernel_launch: hipFuncSetAttribute failed\n"); grid = -1; return; }
        if (hipOccupancyMaxActiveBlocksPerMultiprocessor(&per_cu, (const void*)fwd, NT, LDS_BYTES) != hipSuccess || per_cu < 1) { fprintf(stderr, "kernel_launch: occupancy query says %d\n", per_cu); }
        (void)hipGetLastError();
        grid = cus;
    }
    if (grid < 0) return;
    (void)hipMemsetAsync((char*)d_ws + WS_CTL, 0, CTL_BYTES + (size_t)NB * 12288 * 4, stream);
    Args a{};
    for (int i = 0; i < 26; ++i) a.in[i] = (const float*)d_in[i];
    a.out = (float*)d_out; a.ws = (unsigned char*)d_ws;
#if N_LAUNCH_MODE == 1
    a.ph_lo = 0; a.ph_hi = N_PHASES;
    hipLaunchKernelGGL(fwd, dim3(grid), dim3(NT), LDS_BYTES, stream, a);
#else
    for (int p = 0; p < N_PHASES; ++p) {
        if (p == 4 || p == 5) continue;
        a.ph_lo = p; a.ph_hi = p + 1;
        hipLaunchKernelGGL(fwd, dim3(grid), dim3(NT), LDS_BYTES, stream, a);
    }
#endif
}
```

```cpp
#include <hip/hip_runtime.h>
#include <stdint.h>
#include <stdio.h>

#ifndef N_LAUNCH_MODE
#define N_LAUNCH_MODE 1
#endif

#ifndef PROBE_MASK
#define PROBE_MASK 0
#endif
#define REPS(k) ((PROBE_MASK >> (k)) & 1)
#define FAST_INPROJ 1
#define FAST_GLU 1
#define FAST_OUT 1
#define FAST_MOE1 1
#define FAST_MOE2 1
#define FAST_SSM 1
#define FAST_ATTN 1
#define LAS __attribute__((address_space(3)))
typedef unsigned short bf16_t;
typedef float f32x4 __attribute__((ext_vector_type(4)));
typedef float f32x2 __attribute__((ext_vector_type(2)));
typedef short bf16x8 __attribute__((ext_vector_type(8)));
typedef short s16x4 __attribute__((ext_vector_type(4)));
typedef unsigned u32x2 __attribute__((ext_vector_type(2)));
typedef unsigned u32x4 __attribute__((ext_vector_type(4)));

constexpr int NT = 512;
constexpr int TOK = 8192, DM = 2048, NB = 4, SEQ = 2048;
constexpr int DSSM = 1024, DATT = 1024, NH = 16, HD = 64, DINP = 4096;
constexpr int NE = 16, CAP = 256, DFF = 2816;
constexpr int NG = 64, NP = 64, GH = 16;
constexpr float EPS = 1e-6f;

constexpr size_t al256(size_t x) { return (x + 255) & ~(size_t)255; }
constexpr size_t WS_CTL   = 0;
constexpr size_t CTL_BYTES = 32768;
constexpr size_t WS_MOD   = WS_CTL + CTL_BYTES;
constexpr size_t WS_H1    = al256(WS_MOD + (size_t)NB * 12288 * 4);
constexpr size_t WS_UX    = al256(WS_H1 + (size_t)TOK * DM * 2);
constexpr size_t WS_Q     = al256(WS_UX + (size_t)64 * 512 * 512 * 2);
constexpr size_t WS_K     = al256(WS_Q + (size_t)TOK * 1024 * 2);
constexpr size_t WS_V     = al256(WS_K + (size_t)TOK * 1024 * 2);
constexpr size_t WS_SS    = al256(WS_V + (size_t)TOK * 1024 * 2);
constexpr size_t WS_ZB    = al256(WS_SS + (size_t)64 * 512 * 256 * 4);
constexpr size_t WS_YSSM  = al256(WS_ZB + (size_t)TOK * 1024 * 2);
constexpr size_t WS_SQS   = WS_YSSM;
constexpr size_t WS_SQA   = WS_YSSM + (size_t)TOK * 4 * 4;
constexpr size_t WS_YATT  = al256(WS_YSSM + (size_t)TOK * 1024 * 2);
constexpr size_t WS_MIX   = al256(WS_YATT + (size_t)TOK * 1024 * 2);
constexpr size_t WS_X1    = al256(WS_MIX + (size_t)TOK * DM * 2);
constexpr size_t WS_H2    = al256(WS_X1 + (size_t)TOK * DM * 4);
constexpr size_t WS_AFF   = al256(WS_H2 + (size_t)TOK * DM * 2);
constexpr size_t WS_IDX   = al256(WS_AFF + (size_t)NB * NE * SEQ * 4);
constexpr size_t WS_WAFF  = al256(WS_IDX + (size_t)NB * NE * CAP * 4);
constexpr size_t WS_SLOT  = al256(WS_WAFF + (size_t)NB * NE * CAP * 4);
constexpr size_t WS_HID   = al256(WS_SLOT + (size_t)NB * NE * SEQ * 4);
constexpr size_t WS_YE    = al256(WS_HID + (size_t)NE * 1024 * DFF * 2);
constexpr size_t WS_BMAT  = al256(WS_YE + (size_t)NE * 1024 * DM * 2);
constexpr size_t WS_KCMAT = al256(WS_BMAT + (size_t)64 * 256 * 256 * 2);
constexpr size_t WS_LAM   = al256(WS_KCMAT + (size_t)64 * 512 * 256 * 2);
constexpr size_t WS_WINB  = al256(WS_LAM + (size_t)2 * 64 * 64 * 2 * 4);
constexpr size_t WS_WGLUB = al256(WS_WINB + (size_t)DM * DINP * 2);
constexpr size_t WS_WOUTB = al256(WS_WGLUB + (size_t)1024 * 1024 * 2);
constexpr size_t WS_END   = al256(WS_WOUTB + (size_t)DM * DM * 2);

constexpr int LDS_BYTES = 163840;

typedef __bf16 bf16x2_t __attribute__((ext_vector_type(2)));
__device__ __forceinline__ bf16_t f2bf(float f) { return __builtin_bit_cast(bf16_t, (__bf16)f); }
__device__ __forceinline__ float bf2f(bf16_t b) { return __uint_as_float(((unsigned)b) << 16); }
__device__ __forceinline__ float bflo(unsigned w) { return __uint_as_float(w << 16); }
__device__ __forceinline__ float bfhi(unsigned w) { return __uint_as_float(w & 0xffff0000u); }
__device__ __forceinline__ unsigned pack2(float lo, float hi) { const f32x2 f = {lo, hi}; return __builtin_bit_cast(unsigned, __builtin_convertvector(f, bf16x2_t)); }
__device__ __forceinline__ float wave_sum(float v) {
#pragma unroll
    for (int m = 32; m >= 1; m >>= 1) v += __shfl_xor(v, m);
    return v;
}
__device__ __forceinline__ float silu_f(float v) { return v / (1.0f + __expf(-v)); }
__device__ __forceinline__ float sigmoid_f(float v) { return 1.0f / (1.0f + __expf(-v)); }
__device__ __forceinline__ float gelu_tanh(float y) { const float t = 1.5957691216057308f * (y + 0.044715f * y * y * y); return y / (1.0f + __expf(-t)); }

#define XB_TMO      128
#define XB_XCNT(j)  (256  + 64 * (j))
#define XB_XSUB(j)  (1280 + 64 * (j))
#define XB_XGEN(j)  (2304 + 64 * (j))
#define XB_TOP      3328
#define XB_TOPGEN   3392
#define XCD_BAR_WORDS 3456
#define XB_SPIN_CAP (1u << 18)
__device__ __forceinline__ unsigned xb_ld(unsigned* p)              { return __hip_atomic_load(p, __ATOMIC_RELAXED, __HIP_MEMORY_SCOPE_AGENT); }
__device__ __forceinline__ unsigned xb_add(unsigned* p, unsigned v) { return __hip_atomic_fetch_add(p, v, __ATOMIC_RELAXED, __HIP_MEMORY_SCOPE_AGENT); }
__device__ __forceinline__ unsigned xb_xcc_id() { return (unsigned)__builtin_amdgcn_s_getreg((3 << 11) | 20) & 0xFu; }
#define XB_SPIN(cond, bar) do { unsigned _sp = 0; while (cond) { __builtin_amdgcn_s_sleep(1); \
    if ((++_sp & 255u) == 0u) { if (xb_ld(&(bar)[XB_TMO])) break; if (_sp > XB_SPIN_CAP) { atomicAdd(&(bar)[XB_TMO], 1u); break; } } } } while (0)
struct XcdBarrier { unsigned* bar; unsigned x; unsigned nloc, nx; };
__device__ __forceinline__ XcdBarrier xcd_barrier_post(unsigned* bar) {
    XcdBarrier b; b.bar = bar; b.x = xb_xcc_id(); b.nloc = 0u; b.nx = 0u;
    if (threadIdx.x == 0) (void)xb_add(&bar[XB_XCNT(b.x)], 1u);
    return b;
}
__device__ __forceinline__ void xcd_barrier_complete(unsigned* bar, unsigned x, unsigned& nloc, unsigned& nx) {
    const unsigned G = gridDim.x * gridDim.y * gridDim.z;
    unsigned sum, cnt, mine, sp = 0u;
    for (;;) {
        sum = 0u; cnt = 0u; mine = 0u;
#pragma unroll
        for (unsigned j = 0; j < 16; ++j) { const unsigned c = xb_ld(&bar[XB_XCNT(j)]); sum += c; cnt += (c > 0u) ? 1u : 0u; mine = (j == x) ? c : mine; }
        if (sum == G) break;
        __builtin_amdgcn_s_sleep(1);
        if ((++sp & 255u) == 0u) { if (xb_ld(&bar[XB_TMO])) break; if (sp > XB_SPIN_CAP) { atomicAdd(&bar[XB_TMO], 1u); break; } }
    }
    nloc = mine > 0u ? mine : 1u; nx = cnt > 0u ? cnt : 1u;
}
__device__ __forceinline__ void xcd_barrier_setup(XcdBarrier& b) {
    if (__builtin_amdgcn_readfirstlane(threadIdx.x >> 6) == 0) { unsigned nloc, nx; xcd_barrier_complete(b.bar, b.x, nloc, nx);
        b.nloc = (unsigned)__builtin_amdgcn_readfirstlane((int)nloc); b.nx = (unsigned)__builtin_amdgcn_readfirstlane((int)nx); }
}
__device__ __forceinline__ void xcd_barrier(XcdBarrier& b) {
    asm volatile("s_waitcnt vmcnt(0)" ::: "memory");
    __syncthreads();
    if (threadIdx.x == 0) {
        unsigned* bar = b.bar;
        __builtin_amdgcn_s_waitcnt(0);
        const unsigned nloc = b.nloc, nx = b.nx;
        const unsigned old = xb_add(&bar[XB_XSUB(b.x)], 1u);
        const unsigned gen = old / nloc;
        if (old + 1u == (gen + 1u) * nloc) {
            __builtin_amdgcn_fence(__ATOMIC_RELEASE, "agent");
            asm volatile("s_waitcnt vmcnt(0)" ::: "memory");
            const unsigned og = xb_add(&bar[XB_TOP], 1u);
            const unsigned tg = og / nx;
            if (og + 1u == (tg + 1u) * nx) xb_add(&bar[XB_TOPGEN], 1u);
            else XB_SPIN(xb_ld(&bar[XB_TOPGEN]) == tg, bar);
            __builtin_amdgcn_fence(__ATOMIC_ACQUIRE, "agent");
            xb_add(&bar[XB_XGEN(b.x)], 1u);
            asm volatile("s_waitcnt vmcnt(0)" ::: "memory");
        } else {
            XB_SPIN(xb_ld(&bar[XB_XGEN(b.x)]) == gen, bar);
            __builtin_amdgcn_fence(__ATOMIC_ACQUIRE, "agent");
            asm volatile("s_waitcnt vmcnt(0)" ::: "memory");
        }
    }
    __syncthreads();
}

struct Args { const float* in[26]; float* out; unsigned char* ws; int ph_lo, ph_hi; };
enum { I_X = 0, I_C, I_WADA, I_BADA, I_GMIX, I_WIN, I_ARE, I_AIM, I_LOGDT, I_BRE, I_BIM, I_CRE, I_CIM, I_SSMD, I_WGLU, I_BGLU, I_RPB,
       I_GSSM, I_GATT, I_WOUT, I_GFFN, I_WROUTER, I_WGATE, I_WUP, I_WDOWN, I_GFINAL };

struct ARows { const bf16_t* base; size_t ld; __device__ __forceinline__ const bf16_t* ptr(int r) const { return base + (size_t)r * ld; }
    __device__ __forceinline__ unsigned off(int r) const { return (unsigned)r * (unsigned)ld; } };
struct AGather { const bf16_t* base; const int* idx; int e; unsigned koff;
    __device__ __forceinline__ const bf16_t* ptr(int r) const { const int b = r >> 8; return base + (size_t)(b * SEQ + idx[(b * NE + e) * CAP + (r & 255)]) * DM; }
    __device__ __forceinline__ unsigned off(int r) const { const int b = r >> 8; return (unsigned)(b * SEQ + idx[(b * NE + e) * CAP + (r & 255)]) * (unsigned)DM + koff; } };
struct BF32 { const float* base; size_t ld; __device__ __forceinline__ float get(int k, int n) const { return base[(size_t)k * ld + n]; }
    __device__ __forceinline__ float get2(int, int) const { return 0.f; } };
struct BF32Dual { const float* g; const float* u; size_t ld; __device__ __forceinline__ float get(int k, int n) const { return g[(size_t)k * ld + n]; }
    __device__ __forceinline__ float get2(int k, int n) const { return u[(size_t)k * ld + n]; } };

constexpr float QSCALE = 0.125f * 1.44269504088896f;
struct EpiInProj { bf16_t* UX; bf16_t* Q; bf16_t* K; bf16_t* V;
    __device__ __forceinline__ void store(int t, int n, float v) const {
        if (n < 1024) { const int g = n >> 4, h = n & 15, b = t >> 11, l = t & 2047; UX[(size_t)(g * 512 + b * 128 + (l >> 4)) * 512 + (l & 15) * 16 + h] = f2bf(v); }
        else if (n < 2048) Q[(size_t)t * 1024 + (n - 1024)] = f2bf(v * QSCALE);
        else if (n < 3072) K[(size_t)t * 1024 + (n - 2048)] = f2bf(v);
        else V[(size_t)t * 1024 + (n - 3072)] = f2bf(v);
    }
    __device__ __forceinline__ void store2(int, int, float, float) const {}
    __device__ __forceinline__ void store4(int t, int n, f32x4 v) const {
        u32x2 w;
        if (n < 1024) { const int g = n >> 4, h = n & 15, b = t >> 11, l = t & 2047; w.x = pack2(v[0], v[1]); w.y = pack2(v[2], v[3]);
            *(u32x2*)(UX + (size_t)(g * 512 + b * 128 + (l >> 4)) * 512 + (l & 15) * 16 + h) = w; }
        else if (n < 2048) { w.x = pack2(v[0] * QSCALE, v[1] * QSCALE); w.y = pack2(v[2] * QSCALE, v[3] * QSCALE); *(u32x2*)(Q + (size_t)t * 1024 + (n - 1024)) = w; }
        else if (n < 3072) { w.x = pack2(v[0], v[1]); w.y = pack2(v[2], v[3]); *(u32x2*)(K + (size_t)t * 1024 + (n - 2048)) = w; }
        else { w.x = pack2(v[0], v[1]); w.y = pack2(v[2], v[3]); *(u32x2*)(V + (size_t)t * 1024 + (n - 3072)) = w; }
    }
    static constexpr bool ROWSTORE = true; static constexpr int TILE_COLS = 256;
    __device__ __forceinline__ bool use_rows(int n0) const { return n0 >= 1024; }
    __device__ __forceinline__ u32x2 pack4(int, int n, f32x4 v) const { const float s = (n < 2048) ? QSCALE : 1.0f; u32x2 w; w.x = pack2(v[0] * s, v[1] * s); w.y = pack2(v[2] * s, v[3] * s); return w; }
    __device__ __forceinline__ bf16_t* rowptr(int r, int n0) const { return (n0 < 2048 ? Q + (n0 - 1024) : (n0 < 3072 ? K + (n0 - 2048) : V + (n0 - 3072))) + (size_t)r * 1024; } };
struct EpiGlu { const bf16_t* Z; const float* bglu; bf16_t* Y; float* SQS;
    __device__ __forceinline__ void store(int t, int n, float v) const { const float gate = v + bglu[n]; const float z = bf2f(Z[(size_t)t * 1024 + n]); Y[(size_t)t * DM + n] = f2bf(z * sigmoid_f(gate)); }
    __device__ __forceinline__ void store2(int, int, float, float) const {}
    __device__ __forceinline__ void store4(int t, int n, f32x4 v) const {
        const f32x4 bb = *(const f32x4*)(bglu + n); const u32x2 zw = *(const u32x2*)(Z + (size_t)t * 1024 + n);
        u32x2 w; w.x = pack2(bflo(zw.x) * sigmoid_f(v[0] + bb[0]), bfhi(zw.x) * sigmoid_f(v[1] + bb[1])); w.y = pack2(bflo(zw.y) * sigmoid_f(v[2] + bb[2]), bfhi(zw.y) * sigmoid_f(v[3] + bb[3]));
        *(u32x2*)(Y + (size_t)t * DM + n) = w; }
    static constexpr bool ROWSTORE = true, ROWSQ = true; static constexpr int TILE_COLS = 256;
    __device__ __forceinline__ bool use_rows(int) const { return true; }
    __device__ __forceinline__ void rowsq(int r, int n0, float ss) const { SQS[(size_t)r * 4 + (n0 >> 8)] = ss; }
    __device__ __forceinline__ u32x2 pack4(int t, int n, f32x4 v) const { const f32x4 bb = *(const f32x4*)(bglu + n); const u32x2 zw = *(const u32x2*)(Z + (size_t)t * 1024 + n);
        u32x2 w; w.x = pack2(bflo(zw.x) * sigmoid_f(v[0] + bb[0]), bfhi(zw.x) * sigmoid_f(v[1] + bb[1])); w.y = pack2(bflo(zw.y) * sigmoid_f(v[2] + bb[2]), bfhi(zw.y) * sigmoid_f(v[3] + bb[3])); return w; }
    __device__ __forceinline__ bf16_t* rowptr(int r, int n0) const { return Y + (size_t)r * DM + n0; } };
struct EpiOut { const float* x; const float* mod; bf16_t* X1; const float* SQS; const float* SQA;
    static constexpr int MIDK = 16;
    __device__ __forceinline__ void row_factors(int row, float& mid, float& end) const {
        const f32x4* ap = (const f32x4*)(SQA + (size_t)row * 16); const f32x4 a0 = ap[0], a1 = ap[1], a2 = ap[2], a3 = ap[3], s4 = *(const f32x4*)(SQS + (size_t)row * 4);
        const float att = (((a0[0] + a0[1]) + (a0[2] + a0[3])) + ((a1[0] + a1[1]) + (a1[2] + a1[3]))) + (((a2[0] + a2[1]) + (a2[2] + a2[3])) + ((a3[0] + a3[1]) + (a3[2] + a3[3])));
        const float ssm = (s4[0] + s4[1]) + (s4[2] + s4[3]);
        const float am = att * (1.0f / 1024.0f) + EPS; end = rsqrtf(am); mid = rsqrtf(ssm * (1.0f / 1024.0f) + EPS) * sqrtf(am); }
    __device__ __forceinline__ void store(int t, int n, float v) const { const int b = t >> 11; X1[(size_t)t * DM + n] = f2bf(x[(size_t)t * DM + n] + mod[b * 12288 + 4096 + n] * v); }
    __device__ __forceinline__ void store2(int, int, float, float) const {}
    __device__ __forceinline__ u32x2 pack4(int t, int n, f32x4 v) const { const int b = t >> 11;
        const f32x4 xv = *(const f32x4*)(x + (size_t)t * DM + n), gt = *(const f32x4*)(mod + b * 12288 + 4096 + n); const f32x4 r = xv + gt * v;
        u32x2 w; w.x = pack2(r[0], r[1]); w.y = pack2(r[2], r[3]); return w; }
    __device__ __forceinline__ void store4(int t, int n, f32x4 v) const { *(u32x2*)(X1 + (size_t)t * DM + n) = pack4(t, n, v); }
    static constexpr bool ROWSTORE = true; static constexpr int TILE_COLS = 256;
    __device__ __forceinline__ bool use_rows(int) const { return true; }
    __device__ __forceinline__ bf16_t* rowptr(int r, int n0) const { return X1 + (size_t)r * DM + n0; } };
struct EpiMoe1 { bf16_t* HID;
    __device__ __forceinline__ void store(int, int, float) const {}
    __device__ __forceinline__ void store2(int r, int n, float g, float u) const { HID[(size_t)r * DFF + n] = f2bf(silu_f(g) * u); }
    __device__ __forceinline__ void store4d(int r, int n, f32x4 g, f32x4 u) const { u32x2 w; w.x = pack2(silu_f(g[0]) * u[0], silu_f(g[1]) * u[1]); w.y = pack2(silu_f(g[2]) * u[2], silu_f(g[3]) * u[3]);
        *(u32x2*)(HID + (size_t)r * DFF + n) = w; }
    static constexpr bool ROWSTORE = true; static constexpr int TILE_COLS = 128;
    __device__ __forceinline__ bool use_rows(int) const { return true; }
    __device__ __forceinline__ u32x2 pack4d(int, int, f32x4 g, f32x4 u) const { u32x2 w; w.x = pack2(silu_f(g[0]) * u[0], silu_f(g[1]) * u[1]); w.y = pack2(silu_f(g[2]) * u[2], silu_f(g[3]) * u[3]); return w; }
    __device__ __forceinline__ bf16_t* rowptr(int r, int n0) const { return HID + (size_t)r * DFF + n0; } };
struct EpiMoe2 { bf16_t* YE; const float* waff; int e;
    __device__ __forceinline__ void store(int r, int n, float v) const { const int b = r >> 8; YE[(size_t)r * DM + n] = f2bf(v * waff[(b * NE + e) * CAP + (r & 255)]); }
    __device__ __forceinline__ void store2(int, int, float, float) const {}
    __device__ __forceinline__ void store4(int r, int n, f32x4 v) const { const int b = r >> 8; const float a = waff[(b * NE + e) * CAP + (r & 255)];
        u32x2 w; w.x = pack2(v[0] * a, v[1] * a); w.y = pack2(v[2] * a, v[3] * a); *(u32x2*)(YE + (size_t)r * DM + n) = w; }
    static constexpr bool ROWSTORE = true; static constexpr int TILE_COLS = 256;
    __device__ __forceinline__ bool use_rows(int) const { return true; }
    __device__ __forceinline__ u32x2 pack4(int r, int, f32x4 v) const { const int b = r >> 8; const float a = waff[(b * NE + e) * CAP + (r & 255)]; u32x2 w; w.x = pack2(v[0] * a, v[1] * a); w.y = pack2(v[2] * a, v[3] * a); return w; }
    __device__ __forceinline__ bf16_t* rowptr(int r, int n0) const { return YE + (size_t)r * DM + n0; } };

template <class AF, class BF, class EF, bool DUAL>
__device__ __forceinline__ void gemm_naive_tile(float* lds, const AF& A, const BF& Bm, const EF& E, int m0, int n0, int K) {
    float* As = lds;
    float* Bs = lds + 16 * 132;
    float* Bs2 = Bs + 16 * 68;
    float acc[4][4], acc2[4][4];
#pragma unroll
    for (int i = 0; i < 4; ++i)
#pragma unroll
        for (int j = 0; j < 4; ++j) { acc[i][j] = 0.f; acc2[i][j] = 0.f; }
    const int tid = threadIdx.x, tm = tid >> 4, tn = tid & 15;
    const int ar = tid >> 2, ak = (tid & 3) * 4;
    const bf16_t* ap = A.ptr(m0 + ar);
    const int bk = tid >> 5, bc = (tid & 31) * 2;
    for (int k0 = 0; k0 < K; k0 += 16) {
        const u32x2 av = *(const u32x2*)(ap + k0 + ak);
        As[(ak + 0) * 132 + ar] = bflo(av.x); As[(ak + 1) * 132 + ar] = bfhi(av.x); As[(ak + 2) * 132 + ar] = bflo(av.y); As[(ak + 3) * 132 + ar] = bfhi(av.y);
        Bs[bk * 68 + bc] = Bm.get(k0 + bk, n0 + bc); Bs[bk * 68 + bc + 1] = Bm.get(k0 + bk, n0 + bc + 1);
        if (DUAL) { Bs2[bk * 68 + bc] = Bm.get2(k0 + bk, n0 + bc); Bs2[bk * 68 + bc + 1] = Bm.get2(k0 + bk, n0 + bc + 1); }
        __syncthreads();
#pragma unroll
        for (int kk = 0; kk < 16; ++kk) {
            const f32x4 a4 = *(const f32x4*)(As + kk * 132 + tm * 4);
            const f32x4 b4 = *(const f32x4*)(Bs + kk * 68 + tn * 4);
#pragma unroll
            for (int i = 0; i < 4; ++i)
#pragma unroll
                for (int j = 0; j < 4; ++j) acc[i][j] += a4[i] * b4[j];
            if (DUAL) {
                const f32x4 c4 = *(const f32x4*)(Bs2 + kk * 68 + tn * 4);
#pragma unroll
                for (int i = 0; i < 4; ++i)
#pragma unroll
                    for (int j = 0; j < 4; ++j) acc2[i][j] += a4[i] * c4[j];
            }
        }
        __syncthreads();
    }
#pragma unroll
    for (int i = 0; i < 4; ++i)
#pragma unroll
        for (int j = 0; j < 4; ++j) { if (DUAL) E.store2(m0 + tm * 4 + i, n0 + tn * 4 + j, acc[i][j], acc2[i][j]); else E.store(m0 + tm * 4 + i, n0 + tn * 4 + j, acc[i][j]); }
}

struct Frame {
    const float* in[26]; float* out; unsigned char* ws; unsigned char* lds;
    int tid, lane, wave, G, bid;
    __device__ __forceinline__ float* modp() const { return (float*)(ws + WS_MOD); }
};

__device__ __forceinline__ void p_ada(const Frame& F, int u_first, int u_step, int u_end) {
    float* sc = (float*)F.lds;
    float* red = sc + 4 * 2048;
    const float* c = F.in[I_C]; const float* w = F.in[I_WADA]; const float* bias = F.in[I_BADA];
    for (int i = F.tid; i < 4 * 2048; i += NT) sc[i] = silu_f(c[i]);
    __syncthreads();
    const int cq = F.tid & 7, kq = F.tid >> 3;
    f32x4 wv[16];
#define ADA_LOAD(u_) do { const int kh_ = (u_) & 1, n0_ = ((u_) >> 1) * 32 + cq * 4, kb_ = kh_ * 1024 + kq; \
        _Pragma("unroll") for (int q = 0; q < 16; ++q) wv[q] = __builtin_nontemporal_load((const f32x4*)(w + (size_t)(kb_ + 64 * q) * 12288 + n0_)); } while (0)
    if (u_first < u_end) ADA_LOAD(u_first);
    for (int u = u_first; u < u_end; u += u_step) {
        const int kh = u & 1, kb = kh * 1024 + kq;
        float acc[4][4];
#pragma unroll
        for (int b = 0; b < 4; ++b)
#pragma unroll
            for (int j = 0; j < 4; ++j) acc[b][j] = 0.f;
#pragma unroll
        for (int q = 0; q < 16; ++q)
#pragma unroll
            for (int b = 0; b < 4; ++b) { const float s = sc[b * 2048 + kb + 64 * q];
#pragma unroll
                for (int j = 0; j < 4; ++j) acc[b][j] += s * wv[q][j]; }
        if (u + u_step < u_end) ADA_LOAD(u + u_step);
#pragma unroll
        for (int b = 0; b < 4; ++b)
#pragma unroll
            for (int j = 0; j < 4; ++j) red[(kq * 8 + cq) * 16 + b * 4 + j] = acc[b][j];
        __syncthreads();
        if (F.tid < 128) {
            const int b = F.tid >> 5, col = F.tid & 31;
            float s = 0.f;
            for (int q = 0; q < 64; ++q) s += red[(q * 8 + (col >> 2)) * 16 + b * 4 + (col & 3)];
            const int n = (u >> 1) * 32 + col;
            atomicAdd(F.modp() + b * 12288 + n, kh == 0 ? s + bias[n] : s);
        }
        __syncthreads();
    }
#undef ADA_LOAD
}

template <bool SCALE> __device__ __forceinline__ void wconv_range(const f32x4* s, u32x4* d, int n, int start, int stride, const float* gs, const float* ga) {
    for (int i = start; i < n; i += 4 * stride) {
        f32x4 a[4], b[4];
#pragma unroll
        for (int j = 0; j < 4; ++j) { int ii = i + j * stride; ii = ii < n ? ii : n - 1; a[j] = __builtin_nontemporal_load(s + 2 * ii); b[j] = __builtin_nontemporal_load(s + 2 * ii + 1); }
#pragma unroll
        for (int j = 0; j < 4; ++j) { const int ii = i + j * stride;
            if (ii < n) { float g = 1.0f; if (SCALE) { const int k = ii >> 8; g = k < 1024 ? gs[k] : ga[k - 1024]; }
                u32x4 w; w.x = pack2(a[j][0] * g, a[j][1] * g); w.y = pack2(a[j][2] * g, a[j][3] * g); w.z = pack2(b[j][0] * g, b[j][1] * g); w.w = pack2(b[j][2] * g, b[j][3] * g); d[ii] = w; } }
    }
}
__device__ __forceinline__ void p_wconv(const Frame& F, int rank, int nblk) {
    wconv_range<false>((const f32x4*)F.in[I_WIN], (u32x4*)(F.ws + WS_WINB), DM * DINP / 8, rank * NT + F.tid, nblk * NT, nullptr, nullptr);
    wconv_range<false>((const f32x4*)F.in[I_WGLU], (u32x4*)(F.ws + WS_WGLUB), 1024 * 1024 / 8, rank * NT + F.tid, nblk * NT, nullptr, nullptr);
    wconv_range<true>((const f32x4*)F.in[I_WOUT], (u32x4*)(F.ws + WS_WOUTB), DM * DM / 8, rank * NT + F.tid, nblk * NT, F.in[I_GSSM], F.in[I_GATT]);
}
__device__ __forceinline__ void p_h1(const Frame& F) {
    const float* x = F.in[I_X]; const float* g = F.in[I_GMIX]; const float* mod = F.modp(); bf16_t* H1 = (bf16_t*)(F.ws + WS_H1);
    for (int c = F.bid * 8 + F.wave; c < TOK / 4; c += F.G * 8) {
        const int t0 = 4 * c, b = t0 >> 11;
        f32x4 xr[4][8];
#pragma unroll
        for (int i = 0; i < 8; ++i) xr[0][i] = __builtin_nontemporal_load((const f32x4*)(x + (size_t)t0 * DM + i * 256 + F.lane * 4));
        f32x4 ga[8], sb[8];
#pragma unroll
        for (int i = 0; i < 8; ++i) { const int k = i * 256 + F.lane * 4;
            const f32x4 gv = *(const f32x4*)(g + k), sc = *(const f32x4*)(mod + b * 12288 + 2048 + k); sb[i] = *(const f32x4*)(mod + b * 12288 + k);
#pragma unroll
            for (int j = 0; j < 4; ++j) ga[i][j] = gv[j] * (1.0f + sc[j]); }
#pragma unroll
        for (int r = 1; r < 4; ++r)
#pragma unroll
            for (int i = 0; i < 8; ++i) xr[r][i] = __builtin_nontemporal_load((const f32x4*)(x + (size_t)(t0 + r) * DM + i * 256 + F.lane * 4));
#pragma unroll
        for (int r = 0; r < 4; ++r) {
            float ss = 0.f;
#pragma unroll
            for (int i = 0; i < 8; ++i) ss += xr[r][i][0] * xr[r][i][0] + xr[r][i][1] * xr[r][i][1] + xr[r][i][2] * xr[r][i][2] + xr[r][i][3] * xr[r][i][3];
            ss = wave_sum(ss);
            const float rstd = rsqrtf(ss * (1.0f / DM) + EPS);
#pragma unroll
            for (int i = 0; i < 8; ++i) { const int k = i * 256 + F.lane * 4;
                float o[4];
#pragma unroll
                for (int j = 0; j < 4; ++j) o[j] = (xr[r][i][j] * rstd) * ga[i][j] + sb[i][j];
                u32x2 w; w.x = pack2(o[0], o[1]); w.y = pack2(o[2], o[3]);
                *(u32x2*)(H1 + (size_t)(t0 + r) * DM + k) = w; }
        }
    }
}

__device__ __forceinline__ void p_inproj_naive(const Frame& F) {
    const ARows A{(const bf16_t*)(F.ws + WS_H1), DM}; const BF32 Bm{F.in[I_WIN], DINP};
    const EpiInProj E{(bf16_t*)(F.ws + WS_UX), (bf16_t*)(F.ws + WS_Q), (bf16_t*)(F.ws + WS_K), (bf16_t*)(F.ws + WS_V)};
    const int nM = TOK / 128, nN = DINP / 64;
    for (int u = F.bid; u < nM * nN; u += F.G) gemm_naive_tile<ARows, BF32, EpiInProj, false>((float*)F.lds, A, Bm, E, (u / nN) * 128, (u % nN) * 64, DM);
}
__device__ __forceinline__ void p_glu_naive(const Frame& F) {
    const ARows A{(const bf16_t*)(F.ws + WS_ZB), 1024}; const BF32 Bm{F.in[I_WGLU], 1024};
    const EpiGlu E{(const bf16_t*)(F.ws + WS_ZB), F.in[I_BGLU], (bf16_t*)(F.ws + WS_MIX), (float*)(F.ws + WS_SQS)};
    const int nM = TOK / 128, nN = 1024 / 64;
    for (int u = F.bid; u < nM * nN; u += F.G) gemm_naive_tile<ARows, BF32, EpiGlu, false>((float*)F.lds, A, Bm, E, (u / nN) * 128, (u % nN) * 64, 1024);
}
__device__ __forceinline__ void p_outproj_naive(const Frame& F) {
    const ARows A{(const bf16_t*)(F.ws + WS_MIX), DM}; const BF32 Bm{F.in[I_WOUT], DM};
    const EpiOut E{F.in[I_X], F.modp(), (bf16_t*)(F.ws + WS_X1)};
    const int nM = TOK / 128, nN = DM / 64;
    for (int u = F.bid; u < nM * nN; u += F.G) gemm_naive_tile<ARows, BF32, EpiOut, false>((float*)F.lds, A, Bm, E, (u / nN) * 128, (u % nN) * 64, DM);
}
__device__ __forceinline__ void p_moe1_naive(const Frame& F) {
    const int nM = 1024 / 128, nN = DFF / 64;
    for (int u = F.bid; u < NE * nM * nN; u += F.G) {
        const int e = u / (nM * nN), r = u % (nM * nN);
        const AGather A{(const bf16_t*)(F.ws + WS_H2), (const int*)(F.ws + WS_IDX), e, 0u};
        const BF32Dual Bm{F.in[I_WGATE] + (size_t)e * DM * DFF, F.in[I_WUP] + (size_t)e * DM * DFF, DFF};
        const EpiMoe1 E{(bf16_t*)(F.ws + WS_HID) + (size_t)e * 1024 * DFF};
        gemm_naive_tile<AGather, BF32Dual, EpiMoe1, true>((float*)F.lds, A, Bm, E, (r / nN) * 128, (r % nN) * 64, DM);
    }
}
__device__ __forceinline__ void p_moe2_naive(const Frame& F) {
    const int nM = 1024 / 128, nN = DM / 64;
    for (int u = F.bid; u < NE * nM * nN; u += F.G) {
        const int e = u / (nM * nN), r = u % (nM * nN);
        const ARows A{(const bf16_t*)(F.ws + WS_HID) + (size_t)e * 1024 * DFF, DFF};
        const BF32 Bm{F.in[I_WDOWN] + (size_t)e * DFF * DM, DM};
        const EpiMoe2 E{(bf16_t*)(F.ws + WS_YE) + (size_t)e * 1024 * DM, (const float*)(F.ws + WS_WAFF), e};
        gemm_naive_tile<ARows, BF32, EpiMoe2, false>((float*)F.lds, A, Bm, E, (r / nN) * 128, (r % nN) * 64, DFF);
    }
}

__host__ __device__ __forceinline__ int lds_byte(int r, int c) { const int st = (r >> 4) * 2 + (c >> 5), rr = r & 15, cc = c & 31, ob = rr * 64 + cc * 2; return st * 1024 + (ob ^ (((ob >> 9) & 1) << 5)); }
__host__ __device__ __forceinline__ void stage_rc(int b, int& R, int& C) { const int st = b / 1024, sb = b % 1024, swz = sb ^ (((sb >> 9) & 1) << 5); R = (st >> 1) * 16 + swz / 64; C = (st & 1) * 32 + (swz % 64) / 2; }


template <class T, class = void> struct epi_rowstore { static constexpr bool value = false; };
template <class T> struct epi_rowstore<T, decltype((void)T::ROWSTORE)> { static constexpr bool value = true; };
template <class T, class = void> struct epi_rowsq { static constexpr bool value = false; };
template <class T> struct epi_rowsq<T, decltype((void)T::ROWSQ)> { static constexpr bool value = true; };
template <class T, class = void> struct epi_mid { static constexpr bool value = false; };
template <class T> struct epi_mid<T, decltype((void)T::MIDK)> { static constexpr bool value = true; };
struct EpiMoe1Part { float* part;
    __device__ __forceinline__ void store4d(int r, int n, f32x4 g, f32x4 u) const { *(f32x4*)(part + (size_t)(r & 255) * 128 + (n & 127)) = g; *(f32x4*)(part + 32768 + (size_t)(r & 255) * 128 + (n & 127)) = u; } };
struct EpiMoe1Comb { bf16_t* HID; const float* part; unsigned* flag; unsigned* tmo;
    __device__ __forceinline__ void store4d(int r, int n, f32x4 g, f32x4 u) const {
        const f32x4 pg = *(const f32x4*)(part + (size_t)(r & 255) * 128 + (n & 127)), pu = *(const f32x4*)(part + 32768 + (size_t)(r & 255) * 128 + (n & 127));
        g += pg; u += pu;
        u32x2 w; w.x = pack2(silu_f(g[0]) * u[0], silu_f(g[1]) * u[1]); w.y = pack2(silu_f(g[2]) * u[2], silu_f(g[3]) * u[3]);
        *(u32x2*)(HID + (size_t)r * DFF + n) = w; } };
template <class EF> __device__ __forceinline__ void epi_pre(const EF&) {}
__device__ __forceinline__ void epi_pre(const EpiMoe1Comb& E) {
    if (threadIdx.x == 0) { unsigned sp = 0;
        while (__hip_atomic_load(E.flag, __ATOMIC_RELAXED, __HIP_MEMORY_SCOPE_AGENT) == 0u) { __builtin_amdgcn_s_sleep(2);
            if ((++sp & 255u) == 0u) { if (__hip_atomic_load(E.tmo, __ATOMIC_RELAXED, __HIP_MEMORY_SCOPE_AGENT)) break; if (sp > (1u << 20)) { atomicAdd(E.tmo, 1u); break; } } }
        __builtin_amdgcn_fence(__ATOMIC_ACQUIRE, "agent"); asm volatile("s_waitcnt vmcnt(0)" ::: "memory"); }
    __syncthreads();
}
__device__ __forceinline__ void gload16_asm(f32x4& dst, const void* sbase, unsigned voff) { asm volatile("global_load_dwordx4 %0, %1, %2" : "=v"(dst) : "v"(voff), "s"(sbase)); }
template <int N> __device__ __forceinline__ void wait_vm1(f32x4& r) { asm volatile("s_waitcnt vmcnt(%1)" : "+v"(r) : "n"(N)); }
template <int N> __device__ __forceinline__ void wait_vm8(f32x4 (&r)[8]) { asm volatile("s_waitcnt vmcnt(%8)" : "+v"(r[0]), "+v"(r[1]), "+v"(r[2]), "+v"(r[3]), "+v"(r[4]), "+v"(r[5]), "+v"(r[6]), "+v"(r[7]) : "n"(N)); }
__device__ __forceinline__ void glds16n(const void* sbase, unsigned voff, unsigned lds_dst) {
    unsigned keep;
    asm volatile("s_mov_b32 %0, m0\n\ts_mov_b32 m0, %3\n\ts_nop 0\n\tglobal_load_lds_dwordx4 %1, %2\n\ts_mov_b32 m0, %0" : "=&s"(keep) : "v"(voff), "s"(sbase), "s"(lds_dst));
}
struct B2F32 {
    const float* base; unsigned ld; static constexpr int NL = 8;
    unsigned loff, bw0, bw1; int wid;
    __device__ __forceinline__ void init(int lane, int wid_) { wid = wid_; loff = (unsigned)lane * 16u; bw0 = (unsigned)(wid * 512 + ((8 * lane) ^ ((wid & 3) * 32))); bw1 = bw0 ^ 128u; }
    __device__ __forceinline__ void issue(int kt, int i, f32x4& r) const { gload16_asm(r, base + (size_t)(kt * 64 + wid + 8 * i) * ld, loff); }
    __device__ __forceinline__ void write1(LAS unsigned char* st, int i, const f32x4& r) const { u32x2 w; w.x = pack2(r[0], r[1]); w.y = pack2(r[2], r[3]); *(LAS u32x2*)(st + ((i & 1) ? bw1 : bw0) + i * 4096) = w; }
};
struct B2F32Dual {
    const float* g; const float* u; unsigned ld; static constexpr int NL = 8;
    unsigned loff, bw0, bw1; int wid;
    __device__ __forceinline__ void init(int lane, int wid_) { wid = wid_; loff = (unsigned)(lane >> 5) * ld * 4u + (unsigned)(lane & 31) * 16u;
        const int k = 2 * wid + (lane >> 5), slot = (k & 3) | ((k >> 1) & 4);
        bw0 = (unsigned)(k * 512 + ((8 * (lane & 31)) ^ (slot * 32))); bw1 = bw0 ^ 256u; }
    __device__ __forceinline__ void issue(int kt, int i, f32x4& r) const { gload16_asm(r, ((i >> 2) ? u : g) + (size_t)(kt * 64 + 2 * wid + 16 * (i & 3)) * ld, loff); }
    __device__ __forceinline__ void write1(LAS unsigned char* st, int i, const f32x4& r) const { u32x2 w; w.x = pack2(r[0], r[1]); w.y = pack2(r[2], r[3]); *(LAS u32x2*)(st + ((i >> 2) ? bw1 : bw0) + (i & 3) * 8192) = w; }
};
struct B2Bf16 {
    const bf16_t* base; unsigned ld; static constexpr int NL = 4;
    unsigned loff, bw0; int wid;
    __device__ __forceinline__ void init(int lane, int wid_) { wid = wid_; loff = (unsigned)(lane >> 5) * ld * 2u + (unsigned)(lane & 31) * 16u;
        const int k = 2 * wid + (lane >> 5), slot = (k & 3) | ((k >> 1) & 4); bw0 = (unsigned)(k * 512 + ((16 * (lane & 31)) ^ (slot * 32))); }
    __device__ __forceinline__ void issue(int kt, int i, f32x4& r) const { gload16_asm(r, base + (size_t)(kt * 64 + 2 * wid + 16 * i) * ld, loff); }
    __device__ __forceinline__ void write1(LAS unsigned char* st, int i, const f32x4& r) const { *(LAS f32x4*)(st + bw0 + i * 8192) = r; }
};

struct NoPf { __device__ __forceinline__ void issue(float (&)[3]) const {} __device__ __forceinline__ void retire(float (&)[3]) const {} };
struct PfLines { const void* a; const float* b0; const float* b1; bool on;
    __device__ __forceinline__ void issue(float (&v)[3]) const { if (on) { v[0] = *(const float*)a; v[1] = *b0; v[2] = *b1; } }
    __device__ __forceinline__ void retire(float (&v)[3]) const { asm volatile("" :: "v"(v[0]), "v"(v[1]), "v"(v[2])); } };
template <class AF, class BL, class EF, bool DUAL, int ABL = 0, class PF = NoPf>
__device__ __forceinline__ void gemm_tile2(unsigned char* ldsg, const AF& A, BL Bl, const EF& E, int m0, int n0, int K, const PF pf = PF()) {
    LAS unsigned char* lds = (LAS unsigned char*)ldsg;
    const unsigned lds0 = (unsigned)(uintptr_t)lds;
    const int tid = threadIdx.x, lane = tid & 63, wid = __builtin_amdgcn_readfirstlane(tid >> 6), wr = wid >> 2, wc = wid & 3, fr = lane & 15, fq = lane >> 4;
    const int nt = K / 64;
    constexpr int NL = BL::NL;
    const bf16_t* abase = A.base;
    unsigned aso[4];
#pragma unroll
    for (int p = 0; p < 4; ++p) { const int row = p * 64 + (tid >> 3), ch = (tid & 7) ^ ((row >> 1) & 7); aso[p] = (A.off(m0 + row) + (unsigned)(ch * 8)) * 2u; }
    Bl.init(lane, wid);
    const unsigned ao0 = (unsigned)((wr * 128 + fr) * 128 + (((0 + fq) ^ ((fr >> 1) & 7)) << 4));
    const unsigned ao1 = (unsigned)((wr * 128 + fr) * 128 + (((4 + fq) ^ ((fr >> 1) & 7)) << 4));
    unsigned boffn[4];
    { const int G = fq, q = fr >> 2, p = fr & 3, slot = q | ((G & 1) << 2);
#pragma unroll
      for (int ni = 0; ni < 4; ++ni) { const int colb = DUAL ? (ni >> 1) * 256 + wc * 64 + (ni & 1) * 32 : wc * 128 + ni * 32;
          boffn[ni] = (unsigned)((8 * G + q) * 512 + ((colb ^ (slot * 32)) + 8 * p)); } }
    f32x4 acc[8][4];
#pragma unroll
    for (int mi = 0; mi < 8; ++mi)
#pragma unroll
        for (int ni = 0; ni < 4; ++ni) acc[mi][ni] = (f32x4){0.f, 0.f, 0.f, 0.f};
    f32x4 breg[8];
#define G2_DMA(piece, soff, kt) if (ABL != 4 && ABL != 5) glds16n(abase, aso[piece] + (unsigned)(kt) * 128u, lds0 + (unsigned)(soff) + (unsigned)((piece) * 8192 + wid * 1024))
#define G2_RDB(dst, sbp, ni, ks) do { if (ABL == 3) { asm volatile("" : "+v"(dst)); break; } const s16x4 lo_ = __builtin_amdgcn_ds_read_tr16_b64_v4i16((LAS s16x4*)((sbp) + boffn[ni] + ((ks) * 32) * 512)); \
        const s16x4 hi_ = __builtin_amdgcn_ds_read_tr16_b64_v4i16((LAS s16x4*)((sbp) + boffn[ni] + ((ks) * 32 + 4) * 512)); \
        dst = (bf16x8){lo_[0], lo_[1], lo_[2], lo_[3], hi_[0], hi_[1], hi_[2], hi_[3]}; } while (0)
#define G2_RDA(sap, mi, ks) (ABL == 3 ? a_[9] : *(const LAS bf16x8*)((sap) + ((ks) ? ao1 : ao0) + (mi) * 2048))
#define G2_MMA(mi, afr, bfr) do { if (ABL == 1) { asm volatile("" :: "v"(afr), "v"(bfr[0]), "v"(bfr[1]), "v"(bfr[2]), "v"(bfr[3])); } else { _Pragma("unroll") for (int ni_ = 0; ni_ < 4; ++ni_) acc[mi][ni_] = __builtin_amdgcn_mfma_f32_16x16x32_bf16(bfr[ni_], afr, acc[mi][ni_], 0, 0, 0); } } while (0)
#pragma unroll
    for (int p = 0; p < 4; ++p) G2_DMA(p, 0, 0);
#pragma unroll
    for (int i = 0; i < NL; ++i) { if (ABL != 2 && ABL != 5) Bl.issue(0, i, breg[i]); }
#pragma unroll
    for (int p = 0; p < 4; ++p) G2_DMA(p, 32768, 1);
    float rf_mid0 = 1.f, rf_mid1 = 1.f, rf_end0 = 1.f, rf_end1 = 1.f;
    if constexpr (epi_mid<EF>::value) { E.row_factors(m0 + wr * 128 + fq * 16 + fr, rf_mid0, rf_end0); E.row_factors(m0 + wr * 128 + 64 + fq * 16 + fr, rf_mid1, rf_end1);
        asm volatile("" : "+v"(rf_mid0), "+v"(rf_mid1), "+v"(rf_end0), "+v"(rf_end1)); }
    wait_vm8<4>(breg);
#pragma unroll
    for (int i = 0; i < NL; ++i) Bl.write1(lds + 98304, i, breg[i]);
#pragma unroll
    for (int i = 0; i < NL; ++i) { if (ABL != 2 && ABL != 5) Bl.issue(1, i, breg[i]); }
    asm volatile("s_waitcnt lgkmcnt(0)" ::: "memory"); __builtin_amdgcn_s_barrier(); asm volatile("" ::: "memory");
    int sa_cur = 0, sa_nn = 65536;
#define G2_S0(MODE, t, mi) do { \
            if ((mi) + 2 < 8) a_[(mi) + 2] = G2_RDA(sap, (mi) + 2, 0); else a_[(mi) + 2] = G2_RDA(sap, (mi) - 6, 1); \
            if ((mi) >= 4) G2_RDB(b1[((mi) - 4) & 3], sbp, ((mi) - 4) & 3, 1); \
            if (MODE == 0 && ((mi) & 1)) G2_DMA(((mi) >> 1) & 3, sa_nn, (t) + 2);        \
            G2_MMA(mi, a_[mi], b0); \
            __builtin_amdgcn_sched_barrier(0); } while (0)
#define G2_S1(MODE, t, mi) do { \
            if ((mi) + 2 < 8) a_[(mi) + 2] = G2_RDA(sap, (mi) + 2, 1); \
            if (MODE <= 1 && (mi) < NL) { if (MODE == 0) wait_vm1<NL + 3>(breg[mi]); else wait_vm1<((NL - 1 - (mi)) > 0 ? (NL - 1 - (mi)) : 0)>(breg[mi]); \
                Bl.write1(sbn, mi, breg[mi]); if (MODE == 0 && ABL != 2 && ABL != 5) Bl.issue((t) + 2, mi, breg[mi]); } \
            G2_MMA(mi, a_[mi], b1); \
            __builtin_amdgcn_sched_barrier(0); } while (0)
#define G2_KTILE(MODE, t) do { \
        LAS unsigned char* sap = lds + sa_cur; LAS unsigned char* sbp = lds + 98304 + ((t) & 1) * 32768; LAS unsigned char* sbn = lds + 98304 + (((t) + 1) & 1) * 32768; \
        bf16x8 b0[4], b1[4], a_[10]; if (ABL == 3) { _Pragma("unroll") for (int z_ = 0; z_ < 10; ++z_) a_[z_] = (bf16x8){0,0,0,0,0,0,0,0}; _Pragma("unroll") for (int z_ = 0; z_ < 4; ++z_) { b0[z_] = a_[0]; b1[z_] = a_[0]; } } \
        G2_RDB(b0[0], sbp, 0, 0); G2_RDB(b0[1], sbp, 1, 0); G2_RDB(b0[2], sbp, 2, 0); G2_RDB(b0[3], sbp, 3, 0); \
        a_[0] = G2_RDA(sap, 0, 0); a_[1] = G2_RDA(sap, 1, 0); \
        G2_S0(MODE, t, 0); G2_S0(MODE, t, 1); G2_S0(MODE, t, 2); G2_S0(MODE, t, 3); G2_S0(MODE, t, 4); G2_S0(MODE, t, 5); G2_S0(MODE, t, 6); G2_S0(MODE, t, 7); \
        a_[0] = a_[8]; a_[1] = a_[9]; \
        G2_S1(MODE, t, 0); G2_S1(MODE, t, 1); G2_S1(MODE, t, 2); G2_S1(MODE, t, 3); G2_S1(MODE, t, 4); G2_S1(MODE, t, 5); G2_S1(MODE, t, 6); G2_S1(MODE, t, 7); \
        asm volatile("s_waitcnt lgkmcnt(0)" ::: "memory"); __builtin_amdgcn_s_barrier(); asm volatile("" ::: "memory"); \
        sa_cur = (sa_cur == 65536) ? 0 : sa_cur + 32768; sa_nn = (sa_nn == 65536) ? 0 : sa_nn + 32768; } while (0)
    int t = 0;
    if constexpr (epi_mid<EF>::value) {
        for (; t < EF::MIDK; ++t) G2_KTILE(0, t);
#pragma unroll
        for (int mi = 0; mi < 8; ++mi) { const float sc = __shfl(mi < 4 ? rf_mid0 : rf_mid1, (mi & 3) * 16 + fr);
#pragma unroll
            for (int ni = 0; ni < 4; ++ni) acc[mi][ni] *= sc; }
    }
    for (; t < nt - 2; ++t) G2_KTILE(0, t);
    G2_KTILE(1, t); ++t;
    G2_KTILE(2, t);
#undef G2_KTILE
#undef G2_S0
#undef G2_S1
#undef G2_DMA
#undef G2_RDB
#undef G2_RDA
#undef G2_MMA
    epi_pre(E);
    float pfv[3] = {0.f, 0.f, 0.f}; pf.issue(pfv);
    int fr2 = fr, fq2 = fq; asm volatile("" : "+v"(fr2), "+v"(fq2));
    if constexpr (epi_mid<EF>::value) {
#pragma unroll
        for (int mi = 0; mi < 8; ++mi) { const float sc = __shfl(mi < 4 ? rf_end0 : rf_end1, (mi & 3) * 16 + fr2);
#pragma unroll
            for (int ni = 0; ni < 4; ++ni) acc[mi][ni] *= sc; }
    }
    if constexpr (epi_rowstore<EF>::value) { if (E.use_rows(n0)) {
        constexpr int RB = EF::TILE_COLS * 2, RS = RB + 16;
#pragma unroll
        for (int mi = 0; mi < 8; ++mi) { const int rl = wr * 128 + mi * 16 + fr2, row = m0 + rl;
            if constexpr (DUAL) {
#pragma unroll
                for (int ni = 0; ni < 2; ++ni) { const int cl = wc * 32 + ni * 16 + 4 * fq2; *(LAS u32x2*)(lds + rl * RS + cl * 2) = E.pack4d(row, n0 + cl, acc[mi][ni], acc[mi][ni + 2]); }
            } else {
#pragma unroll
                for (int ni = 0; ni < 4; ++ni) { const int cl = wc * 64 + ni * 16 + 4 * fq2; *(LAS u32x2*)(lds + rl * RS + cl * 2) = E.pack4(row, n0 + cl, acc[mi][ni]); }
            } }
        asm volatile("s_waitcnt lgkmcnt(0)" ::: "memory"); __builtin_amdgcn_s_barrier(); asm volatile("" ::: "memory");
        constexpr int LPR = RB / 16, RPI = 64 / LPR;
#pragma unroll
        for (int it = 0; it < 32 / RPI; ++it) { const int rl = wid * 32 + it * RPI + lane / LPR, ch = lane % LPR;
            const u32x4 w = *(const LAS u32x4*)(lds + rl * RS + ch * 16);
            *(u32x4*)(E.rowptr(m0 + rl, n0) + ch * 8) = w;
            if constexpr (epi_rowsq<EF>::value) {
                float ss = bflo(w.x) * bflo(w.x) + bfhi(w.x) * bfhi(w.x) + bflo(w.y) * bflo(w.y) + bfhi(w.y) * bfhi(w.y) + bflo(w.z) * bflo(w.z) + bfhi(w.z) * bfhi(w.z) + bflo(w.w) * bflo(w.w) + bfhi(w.w) * bfhi(w.w);
#pragma unroll
                for (int m = 1; m < LPR; m <<= 1) ss += __shfl_xor(ss, m);
                if (ch == 0) E.rowsq(m0 + rl, n0, ss); } }
        asm volatile("s_waitcnt lgkmcnt(0)" ::: "memory"); __builtin_amdgcn_s_barrier(); asm volatile("" ::: "memory");
        pf.retire(pfv);
        return;
    } }
#pragma unroll
    for (int mi = 0; mi < 8; ++mi) {
        const int row = m0 + wr * 128 + mi * 16 + fr2;
        if constexpr (DUAL) {
#pragma unroll
            for (int ni = 0; ni < 2; ++ni) E.store4d(row, n0 + wc * 32 + ni * 16 + 4 * fq2, acc[mi][ni], acc[mi][ni + 2]);
        } else {
#pragma unroll
            for (int ni = 0; ni < 4; ++ni) E.store4(row, n0 + wc * 64 + ni * 16 + 4 * fq2, acc[mi][ni]);
        }
    }
    pf.retire(pfv);
}


namespace pg8 {
#define PG8_LAS __attribute__((address_space(3)))
typedef unsigned short bf16_t;
typedef short bf16x8 __attribute__((ext_vector_type(8)));
typedef float f32x4 __attribute__((ext_vector_type(4)));
typedef unsigned u32x4 __attribute__((ext_vector_type(4)));
constexpr int BM = 256, BK = 64, HALF = 128, HTB = HALF * BK * 2  , STAGE_BYTES = 8 * HTB, NXCD = 8, WGM = 8;

__host__ __device__ __forceinline__ int lds_byte(int r, int c) { const int st = (r >> 4) * 2 + (c >> 5), rr = r & 15, cc = c & 31, ob = rr * 64 + cc * 2; return st * 1024 + (ob ^ (((ob >> 9) & 1) << 5)); }
__host__ __device__ __forceinline__ void stage_rc(int b, int& R, int& C) { const int st = b / 1024, sb = b % 1024, swz = sb ^ (((sb >> 9) & 1) << 5); R = (st >> 1) * 16 + swz / 64; C = (st & 1) * 32 + (swz % 64) / 2; }
__host__ __device__ __forceinline__ int perm32(int rho) { const int n = rho >> 4, i = rho & 15; return 8 * (i >> 2) + 4 * n + (i & 3); }

struct Unit { int pm, pn; };
struct Gemm { const bf16_t* A; const bf16_t* Bt; int M, N, K; };

struct StaticOrder {
    int nM, nN, nwg, G, c;
    __host__ __device__ void init(int M, int N, int G_, int c_) { nM = M / BM; nN = N / BM; nwg = nM * nN; G = G_; c = c_; }
    __host__ __device__ bool next(int i, Unit& u) const {
        const long L = (long)i * G + c; if (L >= nwg) return false;
        int wgid = (int)L; { const int q = nwg / NXCD, r = nwg % NXCD, xcd = wgid % NXCD, off = wgid / NXCD; wgid = (xcd < r ? xcd * (q + 1) : r * (q + 1) + (xcd - r) * q) + off; }
        const int nig = WGM * nN, gid = wgid / nig, fm = gid * WGM, gsz = (nM - fm) < WGM ? (nM - fm) : WGM;
        u.pm = fm + ((wgid % nig) % gsz); u.pn = (wgid % nig) / gsz; return true;
    }
    __device__ __forceinline__ void a_ready(const Unit&) const {}
    __device__ __forceinline__ void done(const Unit&) const {}
};

template <class Epi, class Sched, bool STAMP = false>
__device__ __forceinline__ void gemm_phase(PG8_LAS unsigned char* lds, const Gemm g, const Sched& S, const Epi& E, unsigned long long* stamps) {
    const int tid = threadIdx.x, wid = __builtin_amdgcn_readfirstlane(tid >> 6), lane = tid & 63, wr = wid >> 2, wc = wid & 3, fr = lane & 15, fq = lane >> 4;
    const int K = g.K, nt = K / BK;
    int ts_lo = 0, ts_hi = 0, nts = 0; const unsigned long long rt_entry = STAMP ? (unsigned long long)wall_clock64() : 0ull;
#define PG8_STAMP() do { if (STAMP && wid == 0 && nts < 64) { const unsigned long long _c = (unsigned long long)clock64(); \
        ts_lo = (lane == nts) ? (int)(unsigned)_c : ts_lo; ts_hi = (lane == nts) ? (int)(unsigned)(_c >> 32) : ts_hi; ++nts; } } while (0)
    PG8_STAMP();
    unsigned voffA[2], voffB[2];
#pragma unroll
    for (int i = 0; i < 2; ++i) { int R, C; stage_rc(tid * 16 + i * 8192, R, C); const int Rb = Epi::PERM ? ((R & ~31) + perm32(R & 31)) : R;
        voffA[i] = (unsigned)(R * K + C) * 2u; voffB[i] = (unsigned)(Rb * K + C) * 2u; }
    const size_t kstep = (size_t)(BK * 2);
    const size_t hstep = (size_t)HALF * K * 2;
    const size_t tstep = 2 * hstep;
    const unsigned ldsw = (unsigned)wid * 1024u;
    const int aoff = lds_byte(wr * 64 + fr, fq * 8), boff = lds_byte(wc * 32 + fr, fq * 8);
#define PG8_SA(b, h) (((b) * 2 + (h)) * HTB)
#define PG8_SB(b, h) ((4 + (b) * 2 + (h)) * HTB)
#define PG8_STAGE(bufoff, gbase, voff) do { _Pragma("unroll") for (int _i = 0; _i < 2; ++_i) \
        __builtin_amdgcn_global_load_lds((const unsigned*)((const char*)(gbase) + (voff)[_i]), (PG8_LAS unsigned*)(lds + (bufoff) + ldsw + _i * 8192), 16, 0, 0); } while (0)
#define PG8_LDA(dst, b, h) do { _Pragma("unroll") for (int m = 0; m < 4; ++m) _Pragma("unroll") for (int k = 0; k < 2; ++k) dst[m][k] = *(const PG8_LAS bf16x8*)(lds + PG8_SA(b, h) + aoff + m * 2048 + k * 1024); } while (0)
#define PG8_LDB(dst, b, h) do { _Pragma("unroll") for (int n = 0; n < 2; ++n) _Pragma("unroll") for (int k = 0; k < 2; ++k) dst[n][k] = *(const PG8_LAS bf16x8*)(lds + PG8_SB(b, h) + boff + n * 2048 + k * 1024); } while (0)
#define PG8_MMA(ai, bj, At, Bt) do { __builtin_amdgcn_s_setprio(1); _Pragma("unroll") for (int m = 0; m < 4; ++m) _Pragma("unroll") for (int n = 0; n < 2; ++n) _Pragma("unroll") for (int k = 0; k < 2; ++k) \
        acc[ai][bj][m][n] = __builtin_amdgcn_mfma_f32_16x16x32_bf16(Bt[n][k], At[m][k], acc[ai][bj][m][n], 0, 0, 0); __builtin_amdgcn_s_setprio(0); } while (0)
#define PG8_WAIT_V(n) asm volatile("s_waitcnt vmcnt(" #n ")" ::: "memory")
#define PG8_WAIT_L(n) asm volatile("s_waitcnt lgkmcnt(" #n ")" ::: "memory")
#define PG8_BAR __builtin_amdgcn_s_barrier()
#define PG8_SCHED __builtin_amdgcn_sched_barrier(0)
    Unit cur, nxt; int ui = 0;
    if (!S.next(0, cur)) return;
    f32x4 acc[2][2][4][2];
#pragma unroll
    for (int a = 0; a < 2; ++a)
#pragma unroll
        for (int b = 0; b < 2; ++b)
#pragma unroll
            for (int m = 0; m < 4; ++m)
#pragma unroll
                for (int n = 0; n < 2; ++n) acc[a][b][m][n] = (f32x4){0.f, 0.f, 0.f, 0.f};
    bf16x8 At[4][2], B0[2][2], B1[2][2];
    const char* cA = (const char*)g.A + (size_t)cur.pm * tstep; const char* cB = (const char*)g.Bt + (size_t)cur.pn * tstep;
    S.a_ready(cur);
    PG8_STAGE(PG8_SB(0, 0), cB, voffB); PG8_STAGE(PG8_SA(0, 0), cA, voffA); PG8_STAGE(PG8_SB(0, 1), cB + hstep, voffB); PG8_STAGE(PG8_SA(0, 1), cA + hstep, voffA);
    if (wr == 1) PG8_BAR;
    PG8_WAIT_V(4); PG8_BAR;
    PG8_STAGE(PG8_SB(1, 0), cB + kstep, voffB); PG8_STAGE(PG8_SA(1, 0), cA + kstep, voffA); PG8_STAGE(PG8_SB(1, 1), cB + hstep + kstep, voffB);
    PG8_WAIT_V(6); PG8_BAR;
    PG8_STAMP();
    for (;;) {
        const bool has_next = S.next(ui + 1, nxt);
        const char* nA = has_next ? (const char*)g.A + (size_t)nxt.pm * tstep : cA; const char* nB = has_next ? (const char*)g.Bt + (size_t)nxt.pn * tstep : cB;
        for (int t = 0; t < nt; t += 2) {
            const bool last = (t == nt - 2);
            const char* a1 = cA + (size_t)(t + 1) * kstep;
            const char* a2 = last ? nA : cA + (size_t)(t + 2) * kstep; const char* b2 = last ? nB : cB + (size_t)(t + 2) * kstep;
            const char* a3 = a2 + kstep; const char* b3 = b2 + kstep;
            if (last && has_next) S.a_ready(nxt);
            PG8_LDB(B0, 0, 0); PG8_SCHED; PG8_LDA(At, 0, 0); PG8_STAGE(PG8_SA(1, 1), a1 + hstep, voffA);
            PG8_WAIT_L(8); PG8_BAR; PG8_WAIT_L(0); PG8_MMA(0, 0, At, B0); PG8_BAR; PG8_SCHED;
            PG8_LDB(B1, 0, 1); PG8_STAGE(PG8_SB(0, 0), b2, voffB);
            PG8_BAR; PG8_WAIT_L(0); PG8_MMA(0, 1, At, B1); PG8_BAR;
            PG8_LDA(At, 0, 1); PG8_STAGE(PG8_SA(0, 0), a2, voffA);
            PG8_BAR; PG8_WAIT_L(0); PG8_MMA(1, 0, At, B0); PG8_BAR; PG8_SCHED;
            PG8_STAGE(PG8_SB(0, 1), b2 + hstep, voffB);
            PG8_WAIT_V(6); PG8_BAR; PG8_MMA(1, 1, At, B1); PG8_BAR;
            PG8_LDB(B0, 1, 0); PG8_SCHED; PG8_LDA(At, 1, 0); PG8_STAGE(PG8_SA(0, 1), a2 + hstep, voffA);
            PG8_WAIT_L(8); PG8_BAR; PG8_WAIT_L(0); PG8_MMA(0, 0, At, B0); PG8_BAR; PG8_SCHED;
            PG8_LDB(B1, 1, 1); PG8_STAGE(PG8_SB(1, 0), b3, voffB);
            PG8_BAR; PG8_WAIT_L(0); PG8_MMA(0, 1, At, B1); PG8_BAR;
            PG8_LDA(At, 1, 1); PG8_STAGE(PG8_SA(1, 0), a3, voffA);
            PG8_BAR; PG8_WAIT_L(0); PG8_MMA(1, 0, At, B0); PG8_BAR; PG8_SCHED;
            PG8_STAGE(PG8_SB(1, 1), b3 + hstep, voffB);
            PG8_WAIT_V(6); PG8_BAR; PG8_MMA(1, 1, At, B1); PG8_BAR;
        }
        PG8_STAMP();
        if constexpr (!Epi::AFTER_DRAIN) { E(acc, cur, wr, wc, fr, fq); S.done(cur); }
        PG8_STAMP();
        if (!has_next) break;
#pragma unroll
        for (int a = 0; a < 2; ++a)
#pragma unroll
            for (int b = 0; b < 2; ++b)
#pragma unroll
                for (int m = 0; m < 4; ++m)
#pragma unroll
                    for (int n = 0; n < 2; ++n) acc[a][b][m][n] = (f32x4){0.f, 0.f, 0.f, 0.f};
        cur = nxt; cA = nA; cB = nB; ++ui;
    }
    PG8_WAIT_V(0);
    if (wr == 0) PG8_BAR;
    PG8_BAR;
    if constexpr (Epi::AFTER_DRAIN) { E.fused(acc, cur, wr, wc, fr, fq, lds, wid, lane); S.done(cur); }
    PG8_STAMP();
    if (STAMP && wid == 0) { stamps[lane] = lane < nts ? (((unsigned long long)(unsigned)ts_hi << 32) | (unsigned)ts_lo) : 0ull;
        if (lane == 62) stamps[62] = rt_entry; if (lane == 63) stamps[63] = (unsigned long long)wall_clock64(); }
#undef PG8_STAMP
#undef PG8_SA
#undef PG8_SB
#undef PG8_STAGE
#undef PG8_LDA
#undef PG8_LDB
#undef PG8_MMA
#undef PG8_WAIT_V
#undef PG8_WAIT_L
#undef PG8_BAR
#undef PG8_SCHED
}
}

template <class EF> struct Pg8Epi { static constexpr bool PERM = false, AFTER_DRAIN = false; EF e;
    __device__ __forceinline__ void operator()(const pg8::f32x4 (&acc)[2][2][4][2], const pg8::Unit& u, int wr, int wc, int fr, int fq) const {
        int fr2 = fr, fq2 = fq; asm volatile("" : "+v"(fr2), "+v"(fq2));
#pragma unroll
        for (int ai = 0; ai < 2; ++ai)
#pragma unroll
            for (int m = 0; m < 4; ++m) { const int row = u.pm * 256 + ai * 128 + wr * 64 + m * 16 + fr2;
#pragma unroll
                for (int bj = 0; bj < 2; ++bj)
#pragma unroll
                    for (int n = 0; n < 2; ++n) e.store4(row, u.pn * 256 + bj * 128 + wc * 32 + n * 16 + 4 * fq2, acc[ai][bj][m][n]); }
    } };
__device__ __forceinline__ int unit_of(const Frame& F, int round) { return (F.G % 8 == 0) ? round * F.G + (F.bid & 7) * (F.G >> 3) + (F.bid >> 3) : round * F.G + F.bid; }
__device__ __forceinline__ void tile_of(int v, int nN, int& pm, int& pn) { const int gid = v >> 5, loc = v & 31, gn = nN >> 2; pm = (gid / gn) * 8 + (loc & 7); pn = (gid % gn) * 4 + (loc >> 3); }

__device__ __forceinline__ void p_inproj_fast(const Frame& F) {
    const ARows A{(const bf16_t*)(F.ws + WS_H1), DM};
    const EpiInProj E{(bf16_t*)(F.ws + WS_UX), (bf16_t*)(F.ws + WS_Q), (bf16_t*)(F.ws + WS_K), (bf16_t*)(F.ws + WS_V)};
    for (int r = 0;; ++r) { const int v = unit_of(F, r); if (v >= 32 * 16) break; int pm, pn; tile_of(v, 16, pm, pn);
        B2Bf16 Bl; Bl.base = (const bf16_t*)(F.ws + WS_WINB) + pn * 256; Bl.ld = DINP;
        gemm_tile2<ARows, B2Bf16, EpiInProj, false>(F.lds, A, Bl, E, pm * 256, pn * 256, DM); }
}
__device__ __forceinline__ void p_glu_fast(const Frame& F) {
    const ARows A{(const bf16_t*)(F.ws + WS_ZB), 1024};
    const EpiGlu E{(const bf16_t*)(F.ws + WS_ZB), F.in[I_BGLU], (bf16_t*)(F.ws + WS_MIX), (float*)(F.ws + WS_SQS)};
    for (int r = 0;; ++r) { const int v = unit_of(F, r); if (v >= 32 * 4) break; int pm, pn; tile_of(v, 4, pm, pn);
        B2Bf16 Bl; Bl.base = (const bf16_t*)(F.ws + WS_WGLUB) + pn * 256; Bl.ld = 1024;
        gemm_tile2<ARows, B2Bf16, EpiGlu, false>(F.lds, A, Bl, E, pm * 256, pn * 256, 1024); }
}
__device__ __forceinline__ void p_outproj_fast(const Frame& F) {
    const ARows A{(const bf16_t*)(F.ws + WS_MIX), DM};
    const EpiOut E{F.in[I_X], F.modp(), (bf16_t*)(F.ws + WS_X1), (const float*)(F.ws + WS_SQS), (const float*)(F.ws + WS_SQA)};
    for (int r = 0;; ++r) { const int v = unit_of(F, r); if (v >= 32 * 8) break; int pm, pn; tile_of(v, 8, pm, pn);
        B2Bf16 Bl; Bl.base = (const bf16_t*)(F.ws + WS_WOUTB) + pn * 256; Bl.ld = DM;
        gemm_tile2<ARows, B2Bf16, EpiOut, false>(F.lds, A, Bl, E, pm * 256, pn * 256, DM);
        if (F.G == 256) {
            asm volatile("s_waitcnt vmcnt(0)" ::: "memory"); __syncthreads();
            if (F.tid == 0) { __builtin_amdgcn_fence(__ATOMIC_RELEASE, "agent"); __hip_atomic_fetch_add((unsigned*)(F.ws + WS_CTL + 25088) + pm * 16, 1u, __ATOMIC_RELAXED, __HIP_MEMORY_SCOPE_AGENT); } } }
}
__device__ __forceinline__ void p_moe1_fast(const Frame& F) {
    constexpr int NU = NE * 22 * 4;
    const bool split_tail = (F.G == 256);
    for (int r = 0;; ++r) {
        int v = unit_of(F, r); bool helper = false;
        if (split_tail && r == 5) { helper = (F.bid & 7) >= 4; if (helper) v -= 4 * 32; }
        if (v >= NU) break;
        const int pm = v & 3, pn = (v >> 2) % 22, e = (v >> 2) / 22;
        B2F32Dual Bl; Bl.g = F.in[I_WGATE] + (size_t)e * DM * DFF + pn * 128; Bl.u = F.in[I_WUP] + (size_t)e * DM * DFF + pn * 128; Bl.ld = DFF;
        PfLines pf; pf.on = false; pf.a = nullptr; pf.b0 = nullptr; pf.b1 = nullptr;
        if (split_tail && r < 5) {
            int vn = unit_of(F, r + 1); unsigned kst = 0u; if (r + 1 == 5 && (F.bid & 7) >= 4) { vn -= 4 * 32; kst = 1024u; }
            const int pmn = vn & 3, pnn = (vn >> 2) % 22, en = (vn >> 2) / 22;
            const AGather An{(const bf16_t*)(F.ws + WS_H2), (const int*)(F.ws + WS_IDX), en, kst};
            pf.a = An.base + An.off(pmn * 256 + (F.tid >> 1)) + (F.tid & 1) * 64;
            const int id0 = 2 * F.tid, k0 = id0 >> 3, rem0 = id0 & 7;
            const float* bb = ((rem0 >> 2) ? F.in[I_WUP] : F.in[I_WGATE]) + (size_t)en * DM * DFF + (size_t)(kst + k0) * DFF + pnn * 128 + (rem0 & 3) * 32;
            pf.b0 = bb; pf.b1 = bb + 32; pf.on = true; }
        if (split_tail && r == 5) {
            const int pair = v - 5 * 256;
            float* part = (float*)(F.ws + WS_SS) + (size_t)pair * 65536;
            unsigned* flag = (unsigned*)(F.ws + WS_CTL + 16384) + pair * 16; unsigned* tmo = (unsigned*)(F.ws + WS_CTL) + XB_TMO;
            if (helper) {
                const AGather A{(const bf16_t*)(F.ws + WS_H2), (const int*)(F.ws + WS_IDX), e, 1024u};
                Bl.g += (size_t)1024 * DFF; Bl.u += (size_t)1024 * DFF;
                const EpiMoe1Part E{part};
                gemm_tile2<AGather, B2F32Dual, EpiMoe1Part, true>(F.lds, A, Bl, E, pm * 256, pn * 128, 1024);
                asm volatile("s_waitcnt vmcnt(0)" ::: "memory"); __syncthreads();
                if (F.tid == 0) { __builtin_amdgcn_fence(__ATOMIC_RELEASE, "agent"); asm volatile("s_waitcnt vmcnt(0)" ::: "memory"); __hip_atomic_store(flag, 1u, __ATOMIC_RELAXED, __HIP_MEMORY_SCOPE_AGENT); }
                { const int v2 = unit_of(F, 0), pn2 = (v2 >> 2) & 7, e2 = v2 >> 5; float tv_[4];
#pragma unroll
                  for (int j = 0; j < 4; ++j) { const int id = F.tid * 4 + j; tv_[j] = (F.in[I_WDOWN] + (size_t)e2 * DFF * DM + (size_t)(id >> 3) * DM + pn2 * 256 + (id & 7) * 32)[0]; }
                  asm volatile("" :: "v"(tv_[0]), "v"(tv_[1]), "v"(tv_[2]), "v"(tv_[3])); }
            } else {
                const AGather A{(const bf16_t*)(F.ws + WS_H2), (const int*)(F.ws + WS_IDX), e, 0u};
                const EpiMoe1Comb E{(bf16_t*)(F.ws + WS_HID) + (size_t)e * 1024 * DFF, part, flag, tmo};
                gemm_tile2<AGather, B2F32Dual, EpiMoe1Comb, true>(F.lds, A, Bl, E, pm * 256, pn * 128, 1024);
            }
            break;
        }
        const AGather A{(const bf16_t*)(F.ws + WS_H2), (const int*)(F.ws + WS_IDX), e, 0u};
        const EpiMoe1 E{(bf16_t*)(F.ws + WS_HID) + (size_t)e * 1024 * DFF};
        gemm_tile2<AGather, B2F32Dual, EpiMoe1, true, 0, PfLines>(F.lds, A, Bl, E, pm * 256, pn * 128, DM, pf); }
}
__device__ __forceinline__ void p_moe2_fast(const Frame& F) {
    for (int r = 0;; ++r) { const int v = unit_of(F, r); if (v >= NE * 8 * 4) break; const int pm = v & 3, pn = (v >> 2) & 7, e = v >> 5;
        const ARows A{(const bf16_t*)(F.ws + WS_HID) + (size_t)e * 1024 * DFF, DFF};
        B2F32 Bl; Bl.base = F.in[I_WDOWN] + (size_t)e * DFF * DM + pn * 256; Bl.ld = DM;
        const EpiMoe2 E{(bf16_t*)(F.ws + WS_YE) + (size_t)e * 1024 * DM, (const float*)(F.ws + WS_WAFF), e};
        PfLines pf; pf.on = false; pf.a = nullptr; pf.b0 = nullptr; pf.b1 = nullptr;
        { const int vn = unit_of(F, r + 1);
          if (vn < NE * 8 * 4) { const int pmn = vn & 3, pnn = (vn >> 2) & 7, en = vn >> 5;
            pf.a = (const bf16_t*)(F.ws + WS_HID) + (size_t)en * 1024 * DFF + (size_t)(pmn * 256 + (F.tid >> 1)) * DFF + (F.tid & 1) * 64;
            const int id0 = 2 * F.tid;
            const float* bb = F.in[I_WDOWN] + (size_t)en * DFF * DM + (size_t)(id0 >> 3) * DM + pnn * 256 + (id0 & 7) * 32;
            pf.b0 = bb; pf.b1 = bb + 32; pf.on = true; } }
        gemm_tile2<ARows, B2F32, EpiMoe2, false, 0, PfLines>(F.lds, A, Bl, E, pm * 256, pn * 256, DFF, pf); }
}


__device__ __forceinline__ void p_ssm_prep(const Frame& F, int g, int part, int nparts) {
    float* lam = (float*)F.lds;
    float* bb = lam + 4352;
    float* cc = bb + 4096;
    float* Tt = cc + 4160;
    const int tid = F.tid;
    if (tid < 128) {
        const int dir = tid >> 6, p = tid & 63, pg = dir * 64 + g;
        const double dt = exp((double)F.in[I_LOGDT][pg]);
        const double lr = (double)F.in[I_ARE][pg * 64 + p], li = (double)F.in[I_AIM][pg * 64 + p];
        const double mg = exp(lr * dt), lbr = mg * cos(li * dt), lbi = mg * sin(li * dt);
        double pr = 1.0, pi = 0.0;
        for (int m = 0; m <= 16; ++m) { lam[((dir * 64 + p) * 17 + m) * 2 + 0] = (float)pr; lam[((dir * 64 + p) * 17 + m) * 2 + 1] = (float)pi;
            if (m == 16 && part == 0) { float* LAM = (float*)(F.ws + WS_LAM); LAM[((dir * 64 + g) * 64 + p) * 2 + 0] = (float)pr; LAM[((dir * 64 + g) * 64 + p) * 2 + 1] = (float)pi; }
            const double nr_ = pr * lbr - pi * lbi, ni_ = pr * lbi + pi * lbr; pr = nr_; pi = ni_; }
        const double den = lr * lr + li * li, nr = lbr - 1.0;
        const double fr = (nr * lr + lbi * li) / den, fi = (lbi * lr - nr * li) / den;
        const f32x4* bre = (const f32x4*)(F.in[I_BRE] + (size_t)(pg * 64 + p) * 16); const f32x4* bim = (const f32x4*)(F.in[I_BIM] + (size_t)(pg * 64 + p) * 16);
#pragma unroll
        for (int q = 0; q < 4; ++q) { const f32x4 br4 = bre[q], bi4 = bim[q];
#pragma unroll
            for (int j = 0; j < 4; ++j) { const double br = br4[j], bi = bi4[j]; const int h = q * 4 + j;
                bb[((dir * 64 + p) * 16 + h) * 2 + 0] = (float)(fr * br - fi * bi); bb[((dir * 64 + p) * 16 + h) * 2 + 1] = (float)(fr * bi + fi * br); } }
    }
    for (int i = tid; i < 2048; i += NT) { const int dir = i >> 10, h = (i >> 6) & 15, p = i & 63;
        cc[((dir * 16 + h) * 65 + p) * 2 + 0] = F.in[I_CRE][(size_t)((dir * 64 + g) * 16 + h) * 64 + p]; cc[((dir * 16 + h) * 65 + p) * 2 + 1] = F.in[I_CIM][(size_t)((dir * 64 + g) * 16 + h) * 64 + p]; }
    __syncthreads();
    {
        const int slot = tid >> 4, hp = tid & 15;
        const int dir = slot < 16 ? 1 : 0, m = slot < 16 ? 15 - slot : slot - 16;
        float s[16];
#pragma unroll
        for (int h = 0; h < 16; ++h) s[h] = 0.f;
        for (int p = 0; p < 64; ++p) { const f32x2 c = *(const f32x2*)(cc + ((dir * 16 + hp) * 65 + p) * 2), l = *(const f32x2*)(lam + ((dir * 64 + p) * 17 + m) * 2);
            const float mr = c[0] * l[0] - c[1] * l[1], mi = c[0] * l[1] + c[1] * l[0];
            const f32x4* bp = (const f32x4*)(bb + (dir * 64 + p) * 32);
#pragma unroll
            for (int q = 0; q < 8; ++q) { const f32x4 bv = bp[q]; s[2 * q] += mr * bv[0] - mi * bv[1]; s[2 * q + 1] += mr * bv[2] - mi * bv[3]; } }
        float* red0 = Tt + 31 * 264;
        if (slot == 15) {
#pragma unroll
            for (int h = 0; h < 16; ++h) red0[h * 16 + hp] = s[h]; }
        __syncthreads();
        if (slot != 15) { const int ti = slot < 15 ? slot : slot - 1;
            if (slot == 16) {
#pragma unroll
                for (int h = 0; h < 16; ++h) s[h] += red0[h * 16 + hp] + ((h == hp) ? F.in[I_SSMD][g * 16 + hp] : 0.f); }
#pragma unroll
            for (int h = 0; h < 16; ++h) Tt[ti * 264 + h * 16 + hp] = s[h]; }
    }
    __syncthreads();
    bf16_t* BM = (bf16_t*)(F.ws + WS_BMAT) + (size_t)g * 256 * 256;
    for (int i = part * NT + tid; i < 256 * 32; i += nparts * NT) { const int k = i >> 5, nc = i & 31, j = k >> 4, h = k & 15, dir = nc >> 4, ri = (nc >> 3) & 1, p0 = (nc & 7) * 8, m = dir ? j : 15 - j; float v[8];
#pragma unroll
        for (int q = 0; q < 8; ++q) { const f32x2 l = *(const f32x2*)(lam + ((dir * 64 + p0 + q) * 17 + m) * 2), bv = *(const f32x2*)(bb + ((dir * 64 + p0 + q) * 16 + h) * 2);
            v[q] = ri ? (l[0] * bv[1] + l[1] * bv[0]) : (l[0] * bv[0] - l[1] * bv[1]); }
        u32x4 w; w.x = pack2(v[0], v[1]); w.y = pack2(v[2], v[3]); w.z = pack2(v[4], v[5]); w.w = pack2(v[6], v[7]);
        *(u32x4*)(BM + (size_t)k * 256 + nc * 8) = w; }
    bf16_t* KC = (bf16_t*)(F.ws + WS_KCMAT) + (size_t)g * 512 * 256;
    for (int i = part * NT + tid; i < 512 * 32; i += nparts * NT) { const int k = i >> 5, nc = i & 31, ii = nc >> 1, hp0 = (nc & 1) * 8; float v[8];
        if (k < 256) { const int j = k >> 4, h = k & 15; const f32x4* tp = (const f32x4*)(Tt + (ii - j + 15) * 264 + h * 16 + hp0); const f32x4 t0 = tp[0], t1 = tp[1];
            v[0] = t0[0]; v[1] = t0[1]; v[2] = t0[2]; v[3] = t0[3]; v[4] = t1[0]; v[5] = t1[1]; v[6] = t1[2]; v[7] = t1[3]; }
        else { const int kk = k - 256, dir = kk >> 7, ri = (kk >> 6) & 1, p = kk & 63, m = dir ? 16 - ii : ii + 1; const f32x2 l = *(const f32x2*)(lam + ((dir * 64 + p) * 17 + m) * 2);
#pragma unroll
            for (int q = 0; q < 8; ++q) { const f32x2 c = *(const f32x2*)(cc + ((dir * 16 + hp0 + q) * 65 + p) * 2); v[q] = ri ? -(c[0] * l[1] + c[1] * l[0]) : (c[0] * l[0] - c[1] * l[1]); } }
        u32x4 w; w.x = pack2(v[0], v[1]); w.y = pack2(v[2], v[3]); w.z = pack2(v[4], v[5]); w.w = pack2(v[6], v[7]);
        *(u32x4*)(KC + (size_t)k * 256 + nc * 8) = w; }
    __syncthreads();
}
struct EpiS { float* SS;
    __device__ __forceinline__ void store4(int r, int n, f32x4 v) const { *(f32x4*)(SS + (size_t)r * 256 + n) = v; } };
struct EpiSLds { LAS unsigned char* img;
    static constexpr int RS = 528;
    __device__ __forceinline__ void store4(int r, int n, f32x4 v) const { u32x2 w; w.x = pack2(v[0], v[1]); w.y = pack2(v[2], v[3]); *(LAS u32x2*)(img + (r & 255) * RS + n * 2) = w; } };
struct EpiY { bf16_t* ZB; int g;
    __device__ __forceinline__ void store4(int r, int n, f32x4 v) const { const int b = r >> 7, c = r & 127, i = n >> 4, hp = n & 15; const size_t t = (size_t)b * SEQ + c * 16 + i;
        u32x2 w; w.x = pack2(gelu_tanh(v[0]), gelu_tanh(v[1])); w.y = pack2(gelu_tanh(v[2]), gelu_tanh(v[3])); *(u32x2*)(ZB + t * 1024 + g * 16 + hp) = w; } };
__device__ __forceinline__ void p_ssm_sgemm(const Frame& F) {
    for (int r = 0;; ++r) { const int v = unit_of(F, r); if (v >= 128) break; const int g = v >> 1, pm = v & 1;
        const ARows A{(const bf16_t*)(F.ws + WS_UX) + (size_t)g * 512 * 512, 512};
        B2Bf16 Bl; Bl.base = (const bf16_t*)(F.ws + WS_BMAT) + (size_t)g * 256 * 256; Bl.ld = 256;
        const EpiS E{(float*)(F.ws + WS_SS) + (size_t)g * 512 * 256};
        gemm_tile2<ARows, B2Bf16, EpiS, false>(F.lds, A, Bl, E, pm * 256, 0, 256); }
}
__device__ __forceinline__ void p_ssm_ygemm(const Frame& F) {
    for (int r = 0;; ++r) { const int v = unit_of(F, r); if (v >= 128) break; const int g = v >> 1, pm = v & 1;
        const ARows A{(const bf16_t*)(F.ws + WS_UX) + (size_t)g * 512 * 512, 512};
        B2Bf16 Bl; Bl.base = (const bf16_t*)(F.ws + WS_KCMAT) + (size_t)g * 512 * 256; Bl.ld = 256;
        const EpiY E{(bf16_t*)(F.ws + WS_ZB), g};
        gemm_tile2<ARows, B2Bf16, EpiY, false>(F.lds, A, Bl, E, pm * 256, 0, 512); }
}
__device__ __forceinline__ void p_ssm_scan(const Frame& F) {
    const float* SS = (const float*)(F.ws + WS_SS); bf16_t* UX = (bf16_t*)(F.ws + WS_UX); const float* LAM = (const float*)(F.ws + WS_LAM);
    for (int w = F.bid + F.G * F.wave; w < NG * NB * 2; w += F.G * 8) {
        const int dir = w & 1, b = (w >> 1) & 3, g = w >> 3, p = F.lane;
        const float l16r = LAM[((dir * 64 + g) * 64 + p) * 2], l16i = LAM[((dir * 64 + g) * 64 + p) * 2 + 1];
        float xr = 0.f, xi = 0.f;
        for (int c0 = 0; c0 < 128; c0 += 8) {
            float sr[8], si[8];
#pragma unroll
            for (int q = 0; q < 8; ++q) { const int c = dir ? 127 - (c0 + q) : c0 + q; const float* sp = SS + ((size_t)g * 512 + b * 128 + c) * 256 + dir * 128 + p; sr[q] = sp[0]; si[q] = sp[64]; }
#pragma unroll
            for (int q = 0; q < 8; ++q) { const int c = dir ? 127 - (c0 + q) : c0 + q; bf16_t* xp = UX + ((size_t)g * 512 + b * 128 + c) * 512 + 256 + dir * 128 + p;
                xp[0] = f2bf(xr); xp[64] = f2bf(xi);
                const float nr = l16r * xr - l16i * xi + sr[q], ni = l16r * xi + l16i * xr + si[q]; xr = nr; xi = ni; }
        }
    }
}


struct AttnStage { u32x4 vv[9], kv[9]; bf16x8 q0, q1; float rpv; };
__device__ __forceinline__ void attn_prefetch(const Frame& F, int pu, AttnStage& st) {
    const bf16_t* Kb = (const bf16_t*)(F.ws + WS_K); const bf16_t* Vb = (const bf16_t*)(F.ws + WS_V);
    const int b = pu >> 8, h = (pu >> 4) & 15, i2 = pu & 15, r0 = 2 * i2;
    int rs0 = r0 - 4; rs0 = rs0 < 0 ? 0 : (rs0 > 24 ? 24 : rs0);
    const int base = rs0 < 23 ? rs0 : 23;
#pragma unroll
    for (int i = 0; i < 9; ++i) { const int c = F.tid + i * NT, key = c >> 3, chunk = c & 7; const size_t go = (size_t)(b * SEQ + base * 64 + key) * 1024 + h * 64 + chunk * 8;
        st.vv[i] = *(const u32x4*)(Vb + go); st.kv[i] = *(const u32x4*)(Kb + go); }
    { const int r = r0 + (F.wave >> 2), wq = 16 * (F.wave & 3) + (F.lane & 15);
      const bf16_t* qp = (const bf16_t*)(F.ws + WS_Q) + (size_t)(b * SEQ + r * 64 + wq) * 1024 + h * 64 + 8 * (F.lane >> 4);
      st.q0 = *(const bf16x8*)qp; st.q1 = *(const bf16x8*)(qp + 32); }
    st.rpv = (F.tid < 465) ? F.in[I_RPB][h * 465 + F.tid] : 0.f;
}
__device__ __forceinline__ void attn_pair_unit(const Frame& F, int pu, int pu_next, AttnStage& st) {
    LAS unsigned char* lds = (LAS unsigned char*)F.lds;
    LAS float* rp = (LAS float*)(lds + 147456);
    const bf16_t* Q = (const bf16_t*)(F.ws + WS_Q); const bf16_t* Kb = (const bf16_t*)(F.ws + WS_K); const bf16_t* Vb = (const bf16_t*)(F.ws + WS_V);
    bf16_t* Y = (bf16_t*)(F.ws + WS_MIX) + 1024; float* SQA = (float*)(F.ws + WS_SQA); const float* rpb = F.in[I_RPB];
    const int lane = F.lane, wave = F.wave, q = lane & 15, G = lane >> 4;
    {
        const int b = pu >> 8, h = (pu >> 4) & 15, i2 = pu & 15, r0 = 2 * i2;
        int rs0 = r0 - 4; rs0 = rs0 < 0 ? 0 : (rs0 > 24 ? 24 : rs0);
        const int base = rs0 < 23 ? rs0 : 23;
        {
#pragma unroll
          for (int i = 0; i < 9; ++i) { const int c = F.tid + i * NT, key = c >> 3, chunk = c & 7;
              *(LAS u32x4*)(lds + key * 128 + (((((chunk >> 1) ^ ((key >> 1) & 3)) << 1) | (chunk & 1)) << 4)) = st.vv[i];
              *(LAS u32x4*)(lds + 73728 + key * 128 + ((chunk ^ ((key >> 1) & 7)) << 4)) = st.kv[i]; } }
        if (F.tid < 465) rp[(F.tid / 31) * 32 + (F.tid % 31)] = st.rpv * 1.44269504088896f; else if (F.tid >= 480 && F.tid < 495) rp[(F.tid - 480) * 32 + 31] = -1e30f;
        const bf16x8 qf0 = st.q0, qf1 = st.q1;
        __syncthreads();
        {
            const int r = r0 + (wave >> 2), qb = wave & 3;
            int rs = r - 4; rs = rs < 0 ? 0 : (rs > 24 ? 24 : rs);
            const int c0 = (qb == 0) ? 0 : (qb == 1) ? 8 : (qb == 2) ? 24 : 32;
            const int wq = 16 * qb + q;
            int cs = wq - 8; cs = cs < 0 ? 0 : (cs > 48 ? 48 : cs);
            const LAS float* rpl = rp + (rs - r + 7) * 32;
            int bo[2][4];
#pragma unroll
            for (int hf = 0; hf < 2; ++hf)
#pragma unroll
                for (int e = 0; e < 4; ++e) { const int wk = c0 + 16 * hf + 4 * G + e; const bool valid = (wk >= cs) && (wk < cs + 16); bo[hf][e] = valid ? wk - wq + 15 : 31; }
            f32x4 s[16];
            bf16x8 k0r[4], k1r[4]; f32x4 bir[4];
#define QK_LOAD(t_) do { const int kk_ = (rs + ((t_) >> 1) - base) * 64 + c0 + 16 * ((t_) & 1) + q;         \
                k0r[(t_) & 3] = *(const LAS bf16x8*)(lds + 73728 + kk_ * 128 + ((G ^ ((kk_ >> 1) & 7)) << 4)); k1r[(t_) & 3] = *(const LAS bf16x8*)(lds + 73728 + kk_ * 128 + (((4 + G) ^ ((kk_ >> 1) & 7)) << 4)); \
                bir[(t_) & 3] = (f32x4){rpl[((t_) >> 1) * 32 + bo[(t_) & 1][0]], rpl[((t_) >> 1) * 32 + bo[(t_) & 1][1]], rpl[((t_) >> 1) * 32 + bo[(t_) & 1][2]], rpl[((t_) >> 1) * 32 + bo[(t_) & 1][3]]}; } while (0)
            QK_LOAD(0); QK_LOAD(1); QK_LOAD(2);
            __builtin_amdgcn_sched_barrier(0);
#pragma unroll
            for (int t = 0; t < 16; ++t) {
                if (t + 3 < 16) QK_LOAD(t + 3);
                f32x4 a = bir[t & 3];
                a = __builtin_amdgcn_mfma_f32_16x16x32_bf16(k0r[t & 3], qf0, a, 0, 0, 0);
                a = __builtin_amdgcn_mfma_f32_16x16x32_bf16(k1r[t & 3], qf1, a, 0, 0, 0);
                s[t] = a;
                __builtin_amdgcn_sched_barrier(0);
            }
#undef QK_LOAD
            __builtin_amdgcn_sched_barrier(0);
            if (pu_next >= 0) attn_prefetch(F, pu_next, st);
            __builtin_amdgcn_sched_barrier(0);
            float mx = -1e30f;
#pragma unroll
            for (int t = 0; t < 16; ++t) mx = fmaxf(fmaxf(mx, fmaxf(s[t][0], s[t][1])), fmaxf(s[t][2], s[t][3]));
            mx = fmaxf(mx, __shfl_xor(mx, 16)); mx = fmaxf(mx, __shfl_xor(mx, 32));
            float lsum = 0.f;
#pragma unroll
            for (int t = 0; t < 16; ++t)
#pragma unroll
                for (int e = 0; e < 4; ++e) { const float p = __builtin_amdgcn_exp2f(s[t][e] - mx); s[t][e] = p; lsum += p; }
            lsum += __shfl_xor(lsum, 16); lsum += __shfl_xor(lsum, 32);
            f32x4 o[4];
#pragma unroll
            for (int dt = 0; dt < 4; ++dt) o[dt] = (f32x4){0.f, 0.f, 0.f, 0.f};
            s16x4 vlo[4], vhi[4];
#define PV_LOAD(i_) do { const int keyA_ = (rs + ((i_) >> 2) - base) * 64 + c0 + 4 * G + (q >> 2), keyB_ = keyA_ + 16; \
                const int aA_ = keyA_ * 128 + ((((i_) & 3) ^ ((keyA_ >> 1) & 3)) << 5) + 8 * (q & 3), aB_ = keyB_ * 128 + ((((i_) & 3) ^ ((keyB_ >> 1) & 3)) << 5) + 8 * (q & 3); \
                vlo[(i_) & 3] = __builtin_amdgcn_ds_read_tr16_b64_v4i16((LAS s16x4*)(lds + aA_)); vhi[(i_) & 3] = __builtin_amdgcn_ds_read_tr16_b64_v4i16((LAS s16x4*)(lds + aB_)); } while (0)
            PV_LOAD(0); PV_LOAD(1); PV_LOAD(2);
            __builtin_amdgcn_sched_barrier(0);
            union { bf16x8 v; unsigned u[4]; } pf;
#pragma unroll
            for (int i = 0; i < 32; ++i) { const int kk = i >> 2, dt = i & 3;
                if (i + 3 < 32) PV_LOAD(i + 3);
                if (dt == 0) { pf.u[0] = pack2(s[2 * kk][0], s[2 * kk][1]); pf.u[1] = pack2(s[2 * kk][2], s[2 * kk][3]);
                    pf.u[2] = pack2(s[2 * kk + 1][0], s[2 * kk + 1][1]); pf.u[3] = pack2(s[2 * kk + 1][2], s[2 * kk + 1][3]); }
                const bf16x8 vf = (bf16x8){vlo[i & 3][0], vlo[i & 3][1], vlo[i & 3][2], vlo[i & 3][3], vhi[i & 3][0], vhi[i & 3][1], vhi[i & 3][2], vhi[i & 3][3]};
                o[dt] = __builtin_amdgcn_mfma_f32_16x16x32_bf16(vf, pf.v, o[dt], 0, 0, 0);
                __builtin_amdgcn_sched_barrier(0);
            }
#undef PV_LOAD
            const float inv = 1.0f / lsum;
            bf16_t* yp = Y + (size_t)(b * SEQ + r * 64 + wq) * DM + h * 64 + 4 * G;
            float ssq = 0.f;
#pragma unroll
            for (int dt = 0; dt < 4; ++dt) { u32x2 w; w.x = pack2(o[dt][0] * inv, o[dt][1] * inv); w.y = pack2(o[dt][2] * inv, o[dt][3] * inv); *(u32x2*)(yp + 16 * dt) = w;
                ssq += bflo(w.x) * bflo(w.x) + bfhi(w.x) * bfhi(w.x) + bflo(w.y) * bflo(w.y) + bfhi(w.y) * bfhi(w.y); }
            ssq += __shfl_xor(ssq, 16); ssq += __shfl_xor(ssq, 32);
            if (G == 0) SQA[(size_t)(b * SEQ + r * 64 + wq) * 16 + h] = ssq;
        }
        __syncthreads();
    }
}

__device__ __forceinline__ void attn_units(const Frame& F, int first, int step, int end) {
    if (first >= end) return;
    AttnStage st; attn_prefetch(F, first, st);
    for (int pu = first; pu < end; pu += step) attn_pair_unit(F, pu, (pu + step < end) ? pu + step : -1, st);
}
__device__ __forceinline__ void p_attn_fast(const Frame& F) { attn_units(F, F.bid, F.G, NB * NH * 16); }

__device__ __forceinline__ void ssm_scan_half(const Frame& F, int g, int pm) {
    if (F.wave >= 4) return;
    const float* SS = (const float*)(F.ws + WS_SS); bf16_t* UX = (bf16_t*)(F.ws + WS_UX); const float* LAM = (const float*)(F.ws + WS_LAM);
    const int dir = F.wave & 1, b = 2 * pm + (F.wave >> 1), p = F.lane;
    const float l16r = LAM[((dir * 64 + g) * 64 + p) * 2], l16i = LAM[((dir * 64 + g) * 64 + p) * 2 + 1];
    float xr = 0.f, xi = 0.f;
    for (int c0 = 0; c0 < 128; c0 += 32) {
        float sr[32], si[32];
#pragma unroll
        for (int q = 0; q < 32; ++q) { const int c = dir ? 127 - (c0 + q) : c0 + q; const float* sp = SS + ((size_t)g * 512 + b * 128 + c) * 256 + dir * 128 + p;
            sr[q] = __hip_atomic_load(sp, __ATOMIC_RELAXED, __HIP_MEMORY_SCOPE_AGENT); si[q] = __hip_atomic_load(sp + 64, __ATOMIC_RELAXED, __HIP_MEMORY_SCOPE_AGENT); }
#pragma unroll
        for (int q = 0; q < 32; ++q) { const int c = dir ? 127 - (c0 + q) : c0 + q; bf16_t* xp = UX + ((size_t)g * 512 + b * 128 + c) * 512 + 256 + dir * 128 + p;
            xp[0] = f2bf(xr); xp[64] = f2bf(xi);
            const float nr = l16r * xr - l16i * xi + sr[q], ni = l16r * xi + l16i * xr + si[q]; xr = nr; xi = ni; }
    }
}
__device__ __forceinline__ void ssm_scan_half_lds(const Frame& F, int g, int pm) {
    if (F.wave >= 4) return;
    const LAS unsigned char* img = (const LAS unsigned char*)F.lds; bf16_t* UX = (bf16_t*)(F.ws + WS_UX); const float* LAM = (const float*)(F.ws + WS_LAM);
    const int dir = F.wave & 1, bl = F.wave >> 1, b = 2 * pm + bl, p = F.lane;
    const float l16r = LAM[((dir * 64 + g) * 64 + p) * 2], l16i = LAM[((dir * 64 + g) * 64 + p) * 2 + 1];
    float xr = 0.f, xi = 0.f;
#pragma unroll 16
    for (int q = 0; q < 128; ++q) { const int c = dir ? 127 - q : q;
        const LAS bf16_t* sp = (const LAS bf16_t*)(img + (bl * 128 + c) * EpiSLds::RS + (dir * 128 + p) * 2);
        const float sr = bf2f(sp[0]), si = bf2f(sp[64]);
        bf16_t* xp = UX + ((size_t)g * 512 + b * 128 + c) * 512 + 256 + dir * 128 + p;
        xp[0] = f2bf(xr); xp[64] = f2bf(xi);
        const float nr = l16r * xr - l16i * xi + sr, ni = l16r * xi + l16i * xr + si; xr = nr; xi = ni; }
}
__device__ __forceinline__ void touch_x_tile(const Frame& F) {
    int pm_, pn_; tile_of(unit_of(F, 0), 8, pm_, pn_);
    const float* xb = F.in[I_X] + (size_t)pm_ * 256 * DM + pn_ * 256;
    float t0_ = xb[(size_t)((F.tid) >> 3) * DM + (F.tid & 7) * 32], t1_ = xb[(size_t)((F.tid + 512) >> 3) * DM + (F.tid & 7) * 32],
          t2_ = xb[(size_t)((F.tid + 1024) >> 3) * DM + (F.tid & 7) * 32], t3_ = xb[(size_t)((F.tid + 1536) >> 3) * DM + (F.tid & 7) * 32];
    const bf16_t* wb = (const bf16_t*)(F.ws + WS_WOUTB) + pn_ * 256;
    float t4_ = *(const float*)(wb + (size_t)(F.tid >> 2) * DM + (F.tid & 3) * 64), t5_ = *(const float*)(wb + (size_t)(128 + (F.tid >> 2)) * DM + (F.tid & 3) * 64);
    asm volatile("" :: "v"(t0_), "v"(t1_), "v"(t2_), "v"(t3_), "v"(t4_), "v"(t5_));
}
__device__ __forceinline__ void p_mixer(const Frame& F) {
    for (int u = F.bid; u < 2 * NG; u += F.G) { const int g = u >> 1, pm = u & 1;
        const ARows A{(const bf16_t*)(F.ws + WS_UX) + (size_t)g * 512 * 512, 512};
        { B2Bf16 Bl; Bl.base = (const bf16_t*)(F.ws + WS_BMAT) + (size_t)g * 256 * 256; Bl.ld = 256; const EpiSLds E{(LAS unsigned char*)F.lds};
          gemm_tile2<ARows, B2Bf16, EpiSLds, false>(F.lds, A, Bl, E, pm * 256, 0, 256); }
        __syncthreads();
        ssm_scan_half_lds(F, g, pm);
        asm volatile("s_waitcnt vmcnt(0)" ::: "memory"); __syncthreads();
        { B2Bf16 Bl; Bl.base = (const bf16_t*)(F.ws + WS_KCMAT) + (size_t)g * 512 * 256; Bl.ld = 256; const EpiY E{(bf16_t*)(F.ws + WS_ZB), g};
          gemm_tile2<ARows, B2Bf16, EpiY, false>(F.lds, A, Bl, E, pm * 256, 0, 512); }
        __syncthreads();
    }
    if (F.G == 256) {
        if (F.bid < 128) {
            unsigned* ycnt = (unsigned*)(F.ws + WS_CTL + 24576);
            unsigned* tmo = (unsigned*)(F.ws + WS_CTL) + XB_TMO;
            asm volatile("s_waitcnt vmcnt(0)" ::: "memory"); __syncthreads();
            if (F.tid == 0) {
                __builtin_amdgcn_fence(__ATOMIC_RELEASE, "agent"); asm volatile("s_waitcnt vmcnt(0)" ::: "memory");
                __hip_atomic_fetch_add(ycnt, 1u, __ATOMIC_RELAXED, __HIP_MEMORY_SCOPE_AGENT);
                unsigned sp = 0;
                while (__hip_atomic_load(ycnt, __ATOMIC_RELAXED, __HIP_MEMORY_SCOPE_AGENT) < 128u) { __builtin_amdgcn_s_sleep(2);
                    if ((++sp & 255u) == 0u) { if (__hip_atomic_load(tmo, __ATOMIC_RELAXED, __HIP_MEMORY_SCOPE_AGENT)) break; if (sp > (1u << 20)) { atomicAdd(tmo, 1u); break; } } }
                __builtin_amdgcn_fence(__ATOMIC_ACQUIRE, "agent"); asm volatile("s_waitcnt vmcnt(0)" ::: "memory");
            }
            __syncthreads();
            const ARows A{(const bf16_t*)(F.ws + WS_ZB), 1024};
            const EpiGlu E{(const bf16_t*)(F.ws + WS_ZB), F.in[I_BGLU], (bf16_t*)(F.ws + WS_MIX), (float*)(F.ws + WS_SQS)};
            int pm, pn; tile_of(F.bid, 4, pm, pn);
            B2Bf16 Bl; Bl.base = (const bf16_t*)(F.ws + WS_WGLUB) + pn * 256; Bl.ld = 1024;
            gemm_tile2<ARows, B2Bf16, EpiGlu, false>(F.lds, A, Bl, E, pm * 256, pn * 256, 1024);
        }
        else { attn_units(F, F.bid - 128, 128, NB * NH * 16);
            touch_x_tile(F); }
    } else attn_units(F, F.bid, F.G, NB * NH * 16);
}


#ifndef PROBE_ABL
#define PROBE_ABL -1
#endif
#ifndef PROBE_X
#define PROBE_X 0
#endif
__device__ __forceinline__ void p_moe1_probe(const Frame& F) {
#if PROBE_ABL >= 0
    for (int r = 0;; ++r) { const int v = unit_of(F, r); if (v >= NE * 22 * 4) break; const int pm = v & 3, pn = (v >> 2) % 22, e = (v >> 2) / 22;
        const AGather A{(const bf16_t*)(F.ws + WS_H2), (const int*)(F.ws + WS_IDX), e, 0u};
        B2F32Dual Bl; Bl.g = F.in[I_WGATE] + (size_t)e * DM * DFF + pn * 128; Bl.u = F.in[I_WUP] + (size_t)e * DM * DFF + pn * 128; Bl.ld = DFF;
        const EpiMoe1 E{(bf16_t*)(F.ws + WS_HID) + (size_t)e * 1024 * DFF};
        gemm_tile2<AGather, B2F32Dual, EpiMoe1, true, PROBE_ABL>(F.lds, A, Bl, E, pm * 256, pn * 128, DM); }
#endif
}
__device__ __forceinline__ void p_ssm_naive(const Frame& F) {
    if (F.wave != 0) return;
    const bf16_t* UX = (const bf16_t*)(F.ws + WS_UX); float* ybuf = (float*)(F.ws + WS_SS); bf16_t* ZB = (bf16_t*)(F.ws + WS_ZB);
    const int lane = F.lane;
    for (int u = F.bid; u < NB * NG; u += F.G) {
        const int b = u >> 6, g = u & 63;
        for (int dir = 0; dir < 2; ++dir) {
            const int pg = dir * 64 + g;
            const float dt = expf(F.in[I_LOGDT][pg]);
            const float lr = F.in[I_ARE][pg * 64 + lane], li = F.in[I_AIM][pg * 64 + lane];
            const float mag = expf(lr * dt); const float lbr = mag * cosf(li * dt), lbi = mag * sinf(li * dt);
            const float den = lr * lr + li * li, nr = lbr - 1.0f;
            const float fr = (nr * lr + lbi * li) / den, fi = (lbi * lr - nr * li) / den;
            float bbr[16], bbi[16], cr[16], ci[16];
#pragma unroll
            for (int h = 0; h < 16; ++h) { const float br = F.in[I_BRE][(size_t)(pg * 64 + lane) * 16 + h], bi = F.in[I_BIM][(size_t)(pg * 64 + lane) * 16 + h];
                bbr[h] = fr * br - fi * bi; bbi[h] = fr * bi + fi * br;
                cr[h] = F.in[I_CRE][(size_t)(pg * 16 + h) * 64 + lane]; ci[h] = F.in[I_CIM][(size_t)(pg * 16 + h) * 64 + lane]; }
            const float dsk = F.in[I_SSMD][g * 16 + (lane & 15)];
            float xr = 0.f, xi = 0.f;
            for (int s = 0; s < SEQ; ++s) {
                const int l = dir ? (SEQ - 1 - s) : s;
                const bf16_t* up = UX + (size_t)(g * 512 + b * 128 + (l >> 4)) * 512 + (l & 15) * 16;
                const float uval = bf2f(up[lane & 15]);
                float bur = 0.f, bui = 0.f;
#pragma unroll
                for (int h = 0; h < 16; ++h) { const float uh = __shfl(uval, h); bur += bbr[h] * uh; bui += bbi[h] * uh; }
                const float nxr = lbr * xr - lbi * xi + bur, nxi = lbr * xi + lbi * xr + bui; xr = nxr; xi = nxi;
                float myy = 0.f;
#pragma unroll
                for (int h = 0; h < 16; ++h) { const float v = wave_sum(cr[h] * xr - ci[h] * xi); if (lane == h) myy = v; }
                const size_t o = (size_t)(b * SEQ + l) * 1024 + g * 16;
                if (lane < 16) {
                    if (dir == 0) ybuf[o + lane] = myy;
                    else { const float y = ybuf[o + lane] + myy + dsk * uval; ZB[o + lane] = f2bf(gelu_tanh(y)); }
                }
            }
        }
    }
}

__device__ __forceinline__ void p_attn_naive(const Frame& F) {
    const bf16_t* Q = (const bf16_t*)(F.ws + WS_Q); const bf16_t* Kb = (const bf16_t*)(F.ws + WS_K); const bf16_t* Vb = (const bf16_t*)(F.ws + WS_V);
    bf16_t* Y = (bf16_t*)(F.ws + WS_YATT); const float* rpb = F.in[I_RPB];
    for (int id = F.bid * NT + F.tid; id < TOK * NH; id += F.G * NT) {
        const int t = id >> 4, h = id & 15, b = t >> 11, l = t & 2047, r = l >> 6, w = l & 63;
        int rs = r - 4; rs = rs < 0 ? 0 : (rs > 24 ? 24 : rs);
        int cs = w - 8; cs = cs < 0 ? 0 : (cs > 48 ? 48 : cs);
        float q[64], acc[64];
        const u32x4* qp = (const u32x4*)(Q + (size_t)t * 1024 + h * 64);
#pragma unroll
        for (int i = 0; i < 8; ++i) { const u32x4 v = qp[i]; q[i * 8 + 0] = bflo(v.x); q[i * 8 + 1] = bfhi(v.x); q[i * 8 + 2] = bflo(v.y); q[i * 8 + 3] = bfhi(v.y);
            q[i * 8 + 4] = bflo(v.z); q[i * 8 + 5] = bfhi(v.z); q[i * 8 + 6] = bflo(v.w); q[i * 8 + 7] = bfhi(v.w); }
#pragma unroll
        for (int d = 0; d < 64; ++d) acc[d] = 0.f;
        float m = -1e30f, lsum = 0.f;
        for (int j = 0; j < 8; ++j) {
            const int kr = rs + j, dr = kr - r + 7;
            for (int kk = 0; kk < 16; ++kk) {
                const int wk = cs + kk, dc = wk - w + 15;
                const size_t kt = (size_t)(b * SEQ + kr * 64 + wk) * 1024 + h * 64;
                const u32x4* kp = (const u32x4*)(Kb + kt);
                float s = 0.f;
#pragma unroll
                for (int i = 0; i < 8; ++i) { const u32x4 v = kp[i];
                    s += q[i * 8 + 0] * bflo(v.x) + q[i * 8 + 1] * bfhi(v.x) + q[i * 8 + 2] * bflo(v.y) + q[i * 8 + 3] * bfhi(v.y)
                       + q[i * 8 + 4] * bflo(v.z) + q[i * 8 + 5] * bfhi(v.z) + q[i * 8 + 6] * bflo(v.w) + q[i * 8 + 7] * bfhi(v.w); }
                s += rpb[(h * 15 + dr) * 31 + dc];
                const float mn = fmaxf(m, s); const float corr = __expf(m - mn), p = __expf(s - mn);
                lsum = lsum * corr + p; m = mn;
                const u32x4* vp = (const u32x4*)(Vb + kt);
#pragma unroll
                for (int i = 0; i < 8; ++i) { const u32x4 v = vp[i];
                    acc[i * 8 + 0] = acc[i * 8 + 0] * corr + p * bflo(v.x); acc[i * 8 + 1] = acc[i * 8 + 1] * corr + p * bfhi(v.x);
                    acc[i * 8 + 2] = acc[i * 8 + 2] * corr + p * bflo(v.y); acc[i * 8 + 3] = acc[i * 8 + 3] * corr + p * bfhi(v.y);
                    acc[i * 8 + 4] = acc[i * 8 + 4] * corr + p * bflo(v.z); acc[i * 8 + 5] = acc[i * 8 + 5] * corr + p * bfhi(v.z);
                    acc[i * 8 + 6] = acc[i * 8 + 6] * corr + p * bflo(v.w); acc[i * 8 + 7] = acc[i * 8 + 7] * corr + p * bfhi(v.w); }
            }
        }
        const float inv = 1.0f / lsum;
        u32x4* yp = (u32x4*)(Y + (size_t)t * 1024 + h * 64);
#pragma unroll
        for (int i = 0; i < 8; ++i) { u32x4 o; o.x = pack2(acc[i * 8 + 0] * inv, acc[i * 8 + 1] * inv); o.y = pack2(acc[i * 8 + 2] * inv, acc[i * 8 + 3] * inv);
            o.z = pack2(acc[i * 8 + 4] * inv, acc[i * 8 + 5] * inv); o.w = pack2(acc[i * 8 + 6] * inv, acc[i * 8 + 7] * inv); yp[i] = o; }
    }
}

__device__ __forceinline__ void p_normcat(const Frame& F) {
    const bf16_t* YS = (const bf16_t*)(F.ws + WS_YSSM); const bf16_t* YA = (const bf16_t*)(F.ws + WS_YATT); bf16_t* MIX = (bf16_t*)(F.ws + WS_MIX);
    const int step = F.G * 8; int t = F.bid * 8 + F.wave;
    u32x4 nw[2][2];
    if (t < TOK) {
#pragma unroll
        for (int half = 0; half < 2; ++half)
#pragma unroll
            for (int i = 0; i < 2; ++i) nw[half][i] = *(const u32x4*)((half ? YA : YS) + (size_t)t * 1024 + i * 512 + F.lane * 8); }
    for (; t < TOK; t += step) {
        u32x4 cw[2][2];
#pragma unroll
        for (int half = 0; half < 2; ++half)
#pragma unroll
            for (int i = 0; i < 2; ++i) cw[half][i] = nw[half][i];
        if (t + step < TOK) {
#pragma unroll
            for (int half = 0; half < 2; ++half)
#pragma unroll
                for (int i = 0; i < 2; ++i) nw[half][i] = *(const u32x4*)((half ? YA : YS) + (size_t)(t + step) * 1024 + i * 512 + F.lane * 8); }
#pragma unroll
        for (int half = 0; half < 2; ++half) {
            const float* g = F.in[half ? I_GATT : I_GSSM];
            float v[16]; float ss = 0.f;
#pragma unroll
            for (int i = 0; i < 2; ++i) { const u32x4 w = cw[half][i];
                v[i * 8 + 0] = bflo(w.x); v[i * 8 + 1] = bfhi(w.x); v[i * 8 + 2] = bflo(w.y); v[i * 8 + 3] = bfhi(w.y); v[i * 8 + 4] = bflo(w.z); v[i * 8 + 5] = bfhi(w.z); v[i * 8 + 6] = bflo(w.w); v[i * 8 + 7] = bfhi(w.w); }
#pragma unroll
            for (int i = 0; i < 16; ++i) ss += v[i] * v[i];
            ss = wave_sum(ss);
            const float rstd = rsqrtf(ss * (1.0f / 1024.0f) + EPS);
#pragma unroll
            for (int i = 0; i < 2; ++i) { const int k = i * 512 + F.lane * 8; const f32x4 g0 = *(const f32x4*)(g + k), g1 = *(const f32x4*)(g + k + 4);
                u32x4 o; o.x = pack2(v[i * 8 + 0] * rstd * g0[0], v[i * 8 + 1] * rstd * g0[1]); o.y = pack2(v[i * 8 + 2] * rstd * g0[2], v[i * 8 + 3] * rstd * g0[3]);
                o.z = pack2(v[i * 8 + 4] * rstd * g1[0], v[i * 8 + 5] * rstd * g1[1]); o.w = pack2(v[i * 8 + 6] * rstd * g1[2], v[i * 8 + 7] * rstd * g1[3]);
                *(u32x4*)(MIX + (size_t)t * DM + half * 1024 + k) = o; }
        }
    }
}

template <int N> __device__ __forceinline__ void h2_step(float (&lg)[32], int lane, int m) {
    const bool hi = (lane & m) != 0;
#pragma unroll
    for (int j = 0; j < N; ++j) { float a = lg[j], b = lg[j + N]; asm volatile("" : "+v"(a), "+v"(b));
        const float keep = hi ? b : a, give = hi ? a : b; lg[j] = keep + __shfl_xor(give, m); }
}
__device__ __forceinline__ void p_h2(const Frame& F, int panel = -1, int pn = 0) {
    const bf16_t* X1 = (const bf16_t*)(F.ws + WS_X1); const float* g = F.in[I_GFFN]; const float* mod = F.modp(); const float* wr = F.in[I_WROUTER];
    bf16_t* H2 = (bf16_t*)(F.ws + WS_H2); float* AFF = (float*)(F.ws + WS_AFF);
    float* wt = (float*)F.lds;
    for (int idx = F.tid; idx < 2048 * 16; idx += NT) wt[(idx & 15) * 2052 + (idx >> 4)] = wr[idx];
    if (panel >= 0 && F.tid == 0) { unsigned* pc = (unsigned*)(F.ws + WS_CTL + 25088) + panel * 16; unsigned* tmo = (unsigned*)(F.ws + WS_CTL) + XB_TMO; unsigned sp = 0;
        while (__hip_atomic_load(pc, __ATOMIC_RELAXED, __HIP_MEMORY_SCOPE_AGENT) < 8u) { __builtin_amdgcn_s_sleep(2);
            if ((++sp & 255u) == 0u) { if (__hip_atomic_load(tmo, __ATOMIC_RELAXED, __HIP_MEMORY_SCOPE_AGENT)) break; if (sp > (1u << 20)) { atomicAdd(tmo, 1u); break; } } }
        __builtin_amdgcn_fence(__ATOMIC_ACQUIRE, "agent"); asm volatile("s_waitcnt vmcnt(0)" ::: "memory"); }
    __syncthreads();
    const int lane = F.lane;
    const int tp_first = panel >= 0 ? (panel * 256 + pn * 32) / 2 + F.wave : F.bid * 8 + F.wave, tp_step = panel >= 0 ? 8 : F.G * 8, tp_end = panel >= 0 ? (panel * 256 + pn * 32) / 2 + 16 : TOK / 2;
    for (int tp = tp_first; tp < tp_end; tp += tp_step) {
        const int t0 = 2 * tp, b = t0 >> 11, l0 = t0 & 2047; const bf16_t* xr = X1 + (size_t)t0 * DM;
        float ss0 = 0.f, ss1 = 0.f;
        u32x2 xw0[8], xw1[8];
#pragma unroll
        for (int i = 0; i < 8; ++i) { xw0[i] = *(const u32x2*)(xr + i * 256 + lane * 4); xw1[i] = *(const u32x2*)(xr + DM + i * 256 + lane * 4); }
#pragma unroll
        for (int i = 0; i < 8; ++i) { const f32x4 a0 = (f32x4){bflo(xw0[i].x), bfhi(xw0[i].x), bflo(xw0[i].y), bfhi(xw0[i].y)}, a1 = (f32x4){bflo(xw1[i].x), bfhi(xw1[i].x), bflo(xw1[i].y), bfhi(xw1[i].y)};
            ss0 += a0[0] * a0[0] + a0[1] * a0[1] + a0[2] * a0[2] + a0[3] * a0[3];
            ss1 += a1[0] * a1[0] + a1[1] * a1[1] + a1[2] * a1[2] + a1[3] * a1[3]; }
        __builtin_amdgcn_sched_barrier(0);
        ss0 = wave_sum(ss0); ss1 = wave_sum(ss1);
        const float r0 = rsqrtf(ss0 * (1.0f / DM) + EPS), r1 = rsqrtf(ss1 * (1.0f / DM) + EPS);
        float lg[32];
#pragma unroll
        for (int e = 0; e < 32; ++e) lg[e] = 0.f;
#pragma unroll
        for (int i = 0; i < 8; ++i) { const int k = i * 256 + lane * 4;
            const f32x4 gv = *(const f32x4*)(g + k), sh = *(const f32x4*)(mod + b * 12288 + 6144 + k), sc = *(const f32x4*)(mod + b * 12288 + 8192 + k);
            const f32x4 a0 = (f32x4){bflo(xw0[i].x), bfhi(xw0[i].x), bflo(xw0[i].y), bfhi(xw0[i].y)}, a1 = (f32x4){bflo(xw1[i].x), bfhi(xw1[i].x), bflo(xw1[i].y), bfhi(xw1[i].y)};
            f32x4 o0, o1;
#pragma unroll
            for (int j = 0; j < 4; ++j) { const float gs = gv[j] * (1.0f + sc[j]); o0[j] = (a0[j] * r0) * gs + sh[j]; o1[j] = (a1[j] * r1) * gs + sh[j]; }
            u32x2 w; w.x = pack2(o0[0], o0[1]); w.y = pack2(o0[2], o0[3]); *(u32x2*)(H2 + (size_t)t0 * DM + k) = w;
            w.x = pack2(o1[0], o1[1]); w.y = pack2(o1[2], o1[3]); *(u32x2*)(H2 + (size_t)(t0 + 1) * DM + k) = w;
#pragma unroll
            for (int e = 0; e < 16; ++e) { const f32x4 wv = *(const f32x4*)(wt + e * 2052 + k);
                lg[e] += o0[0] * wv[0] + o0[1] * wv[1] + o0[2] * wv[2] + o0[3] * wv[3];
                lg[16 + e] += o1[0] * wv[0] + o1[1] * wv[1] + o1[2] * wv[2] + o1[3] * wv[3];
                if ((e & 3) == 3) __builtin_amdgcn_sched_barrier(0); }
        }
h2_step<16>(lg, lane, 32); h2_step<8>(lg, lane, 16); h2_step<4>(lg, lane, 8); h2_step<2>(lg, lane, 4); h2_step<1>(lg, lane, 2);
        float z = lg[0] + __shfl_xor(lg[0], 1);
        float mx = z;
#pragma unroll
        for (int m = 2; m <= 16; m <<= 1) mx = fmaxf(mx, __shfl_xor(mx, m));
        const float ex = expf(z - mx); float den = ex;
#pragma unroll
        for (int m = 2; m <= 16; m <<= 1) den += __shfl_xor(den, m);
        if ((lane & 1) == 0) AFF[(size_t)(b * NE + ((lane >> 1) & 15)) * SEQ + l0 + (lane >> 5)] = ex / den;
    }
}

__device__ __forceinline__ int tk_block_excl_scan(int v, int tid, int lane, int wave, int* wsum, int& total) {
    int x = v;
#pragma unroll
    for (int o = 1; o < 64; o <<= 1) { const int y = __shfl_up(x, o); if (lane >= o) x += y; }
    if (lane == 63) wsum[wave] = x;
    __syncthreads();
    int off = 0, tot = 0;
#pragma unroll
    for (int w = 0; w < 8; ++w) { const int s = wsum[w]; if (w < wave) off += s; tot += s; }
    __syncthreads();
    total = tot; return off + x - v;
}
__device__ __forceinline__ void p_topk(const Frame& F) {
    int* hist = (int*)F.lds;
    int* ctl = hist + 256;
    int* wsum = hist + 272;
    const float* AFF = (const float*)(F.ws + WS_AFF); int* IDX = (int*)(F.ws + WS_IDX); float* WAFF = (float*)(F.ws + WS_WAFF); int* SLOT = (int*)(F.ws + WS_SLOT);
    const int tid = F.tid, lane = F.lane, wave = F.wave;
    for (int u = F.bid; u < NB * NE; u += F.G) {
        unsigned key[4];
        { const f32x4 v = *(const f32x4*)(AFF + (size_t)u * SEQ + 4 * tid);
#pragma unroll
          for (int s = 0; s < 4; ++s) key[s] = __float_as_uint(v[s]); }
        unsigned prefix = 0u; int remaining = CAP;
#pragma unroll
        for (int pass = 0; pass < 4; ++pass) {
            const int shift = 24 - 8 * pass;
            if (tid < 256) hist[tid] = 0;
            __syncthreads();
#pragma unroll
            for (int s = 0; s < 4; ++s) { const bool cand = (pass == 0) || ((key[s] >> (shift + 8)) == prefix); if (cand) atomicAdd(&hist[(key[s] >> shift) & 255u], 1); }
            __syncthreads();
            if (wave == 0) {
                const int h0 = hist[4 * lane], h1 = hist[4 * lane + 1], h2 = hist[4 * lane + 2], h3 = hist[4 * lane + 3];
                const int mine = h0 + h1 + h2 + h3;
                int suf = mine;
#pragma unroll
                for (int o = 1; o < 64; o <<= 1) { const int y = __shfl_down(suf, o); if (lane + o < 64) suf += y; }
                const int above = suf - mine;
                if (above < remaining && remaining <= suf) {
                    int d, ab;
                    if (above + h3 >= remaining) { d = 3; ab = above; }
                    else if (above + h3 + h2 >= remaining) { d = 2; ab = above + h3; }
                    else if (above + h3 + h2 + h1 >= remaining) { d = 1; ab = above + h3 + h2; }
                    else { d = 0; ab = above + h3 + h2 + h1; }
                    ctl[0] = 4 * lane + d; ctl[1] = remaining - ab;
                }
            }
            __syncthreads();
            prefix = (prefix << 8) | (unsigned)ctl[0]; remaining = ctl[1];
            __syncthreads();
        }
        const unsigned T = prefix; const int need = remaining;
        int neq = 0;
#pragma unroll
        for (int s = 0; s < 4; ++s) neq += (key[s] == T) ? 1 : 0;
        int toteq; int eqbase = tk_block_excl_scan(neq, tid, lane, wave, wsum, toteq);
        int nsel = 0; bool sel[4];
#pragma unroll
        for (int s = 0; s < 4; ++s) { const bool eq = (key[s] == T); sel[s] = (key[s] > T) || (eq && eqbase < need); if (eq) ++eqbase; nsel += sel[s] ? 1 : 0; }
        int totsel; int slot = tk_block_excl_scan(nsel, tid, lane, wave, wsum, totsel);
#pragma unroll
        for (int s = 0; s < 4; ++s) { const int tok = 4 * tid + s;
            if (sel[s]) { IDX[u * CAP + slot] = tok; WAFF[u * CAP + slot] = __uint_as_float(key[s]); SLOT[(size_t)u * SEQ + tok] = slot; ++slot; }
            else SLOT[(size_t)u * SEQ + tok] = -1; }
        __syncthreads();
    }
}

__device__ __forceinline__ void p_final(const Frame& F) {
    const bf16_t* X1 = (const bf16_t*)(F.ws + WS_X1); const float* mod = F.modp(); const float* g = F.in[I_GFINAL];
    const bf16_t* YE = (const bf16_t*)(F.ws + WS_YE); const int* SLOT = (const int*)(F.ws + WS_SLOT);
    for (int t = F.bid * 8 + F.wave; t < TOK; t += F.G * 8) {
        const int b = t >> 11, l = t & 2047; const bf16_t* xr = X1 + (size_t)t * DM;
        f32x4 mo[8];
#pragma unroll
        for (int i = 0; i < 8; ++i) mo[i] = (f32x4){0.f, 0.f, 0.f, 0.f};
        for (int e = 0; e < NE; ++e) {
            const int s = SLOT[(size_t)(b * NE + e) * SEQ + l];
            if (s >= 0) { const bf16_t* yr = YE + ((size_t)e * 1024 + b * 256 + s) * DM;
#pragma unroll
                for (int i = 0; i < 8; ++i) { const u32x2 w = *(const u32x2*)(yr + i * 256 + F.lane * 4); mo[i][0] += bflo(w.x); mo[i][1] += bfhi(w.x); mo[i][2] += bflo(w.y); mo[i][3] += bfhi(w.y); } }
        }
        f32x4 v[8]; float ss = 0.f;
#pragma unroll
        for (int i = 0; i < 8; ++i) { const int k = i * 256 + F.lane * 4; const u32x2 xw = *(const u32x2*)(xr + k); const f32x4 xv = (f32x4){bflo(xw.x), bfhi(xw.x), bflo(xw.y), bfhi(xw.y)}, gt = *(const f32x4*)(mod + b * 12288 + 10240 + k);
            v[i] = xv + gt * mo[i]; ss += v[i][0] * v[i][0] + v[i][1] * v[i][1] + v[i][2] * v[i][2] + v[i][3] * v[i][3]; }
        ss = wave_sum(ss);
        const float rstd = rsqrtf(ss * (1.0f / DM) + EPS);
#pragma unroll
        for (int i = 0; i < 8; ++i) { const int k = i * 256 + F.lane * 4; const f32x4 gv = *(const f32x4*)(g + k);
            *(f32x4*)(F.out + (size_t)t * DM + k) = v[i] * rstd * gv; }
    }
}

constexpr int N_PHASES = 14;
__global__ void __launch_bounds__(NT, 2) fwd(Args args) {
    extern __shared__ __attribute__((aligned(16))) unsigned char lds[];
    Frame F;
#pragma unroll
    for (int i = 0; i < 26; ++i) F.in[i] = args.in[i];
    F.out = args.out; F.ws = args.ws; F.lds = lds;
    F.tid = threadIdx.x; F.lane = F.tid & 63; F.wave = __builtin_amdgcn_readfirstlane(F.tid >> 6); F.G = gridDim.x; F.bid = blockIdx.x;
    const int lo = args.ph_lo, hi = args.ph_hi;
    XcdBarrier bar; bar.bar = (unsigned*)(F.ws + WS_CTL); bar.x = 0; bar.nloc = 0u; bar.nx = 0u;
    if (hi - lo > 1) bar = xcd_barrier_post((unsigned*)(F.ws + WS_CTL));
    bool bar_ready = false;
#define IN(k) (lo <= (k) && (k) < hi)
#define GRID_BAR() do { if (!bar_ready) { xcd_barrier_setup(bar); bar_ready = true; } xcd_barrier(bar); } while (0)
#define SEAM(k) do { if (IN(k) && IN((k) + 1)) GRID_BAR(); } while (0)
#define ADA_DONE() do { asm volatile("s_waitcnt vmcnt(0)" ::: "memory"); __syncthreads();          \
        if (F.tid == 0) { __builtin_amdgcn_fence(__ATOMIC_RELEASE, "agent"); __hip_atomic_fetch_add((unsigned*)(F.ws + WS_CTL + 24832), 1u, __ATOMIC_RELAXED, __HIP_MEMORY_SCOPE_AGENT); } } while (0)
#define ADA_WAIT() do { if (F.tid == 0) { unsigned* acnt_ = (unsigned*)(F.ws + WS_CTL + 24832); unsigned* tmo_ = (unsigned*)(F.ws + WS_CTL) + XB_TMO; unsigned sp_ = 0; \
            while (__hip_atomic_load(acnt_, __ATOMIC_RELAXED, __HIP_MEMORY_SCOPE_AGENT) < (unsigned)F.G) { __builtin_amdgcn_s_sleep(2); \
                if ((++sp_ & 255u) == 0u) { if (__hip_atomic_load(tmo_, __ATOMIC_RELAXED, __HIP_MEMORY_SCOPE_AGENT)) break; if (sp_ > (1u << 20)) { atomicAdd(tmo_, 1u); break; } } } \
            __builtin_amdgcn_fence(__ATOMIC_ACQUIRE, "agent"); asm volatile("s_waitcnt vmcnt(0)" ::: "memory"); } \
        __syncthreads(); } while (0)
    f32x4 code_touch = (f32x4){0.f, 0.f, 0.f, 0.f};
    if (IN(0)) { unsigned long long pc_; asm volatile("s_getpc_b64 %0" : "=s"(pc_));
        const char* cp_ = (const char*)(pc_ & ~0xFFFull) + (size_t)(F.bid >> 3) * 8192 + (size_t)F.tid * 16;
        asm volatile("global_load_dwordx4 %0, %1, off" : "+v"(code_touch) : "v"(cp_)); }
    if (IN(0)) { for (int rep_ = 0; rep_ <= REPS(0); ++rep_) { if (FAST_SSM && F.G == 256) {
            if (F.bid < 128) { p_ada(F, F.bid, 128, 256); ADA_DONE(); p_ssm_prep(F, F.bid >> 1, F.bid & 1, 2); }
            else { p_ada(F, 128 + F.bid, 128, 768); ADA_DONE(); p_wconv(F, F.bid - 128, 128); }
        } else { p_ada(F, F.bid, F.G, 768); p_wconv(F, F.bid, F.G); if (FAST_SSM) for (int g = F.bid; g < NG; g += F.G) p_ssm_prep(F, g, 0, 1); } __syncthreads(); } } asm volatile("s_waitcnt vmcnt(0)" :: "v"(code_touch) : "memory");
    if (IN(0) && IN(1)) { if (FAST_SSM && F.G == 256) ADA_WAIT(); else GRID_BAR(); }
    if (IN(1)) { for (int rep_ = 0; rep_ <= REPS(1); ++rep_) { p_h1(F); __syncthreads(); } } SEAM(1);
    if (IN(2)) { for (int rep_ = 0; rep_ <= REPS(2); ++rep_) { if (FAST_INPROJ) p_inproj_fast(F); else p_inproj_naive(F); __syncthreads(); } } SEAM(2);
    if (IN(3)) { for (int rep_ = 0; rep_ <= REPS(3); ++rep_) { if (FAST_SSM && FAST_ATTN) p_mixer(F); else { p_ssm_naive(F); __syncthreads(); p_attn_naive(F); } __syncthreads(); } } do { if (IN(3) && IN(6) && IN(8)) GRID_BAR(); } while (0);
    if (IN(6) && !(FAST_SSM && FAST_ATTN && FAST_GLU && F.G == 256)) { for (int rep_ = 0; rep_ <= REPS(6); ++rep_) { if (FAST_GLU) p_glu_fast(F); else p_glu_naive(F); __syncthreads(); } if (IN(8)) GRID_BAR(); }
    if (IN(8)) { for (int rep_ = 0; rep_ <= REPS(8); ++rep_) { if (FAST_OUT) p_outproj_fast(F); else p_outproj_naive(F); __syncthreads(); } }
    const bool h2_by_panel = FAST_OUT && F.G == 256 && IN(8) && IN(9) && PROBE_MASK == 0;
    if (IN(8) && IN(9) && !h2_by_panel) GRID_BAR();
    if (IN(9)) { for (int rep_ = 0; rep_ <= REPS(9); ++rep_) { if (h2_by_panel) { int pm_, pn_; tile_of(unit_of(F, 0), 8, pm_, pn_); p_h2(F, pm_, pn_); } else p_h2(F); __syncthreads(); } } SEAM(9);
    if (IN(10)) { for (int rep_ = 0; rep_ <= REPS(10); ++rep_) { p_topk(F); __syncthreads(); } }
    if (IN(10) && IN(11) && FAST_MOE1 && F.bid >= NB * NE) {
        const int v_ = unit_of(F, 0), pn_ = (v_ >> 2) % 22, e_ = (v_ >> 2) / 22; float tv_[4];
#pragma unroll
        for (int j = 0; j < 4; ++j) { const int id = F.tid * 4 + j, k = id >> 3, rem = id & 7;
            tv_[j] = (((rem >> 2) ? F.in[I_WUP] : F.in[I_WGATE]) + (size_t)e_ * DM * DFF + (size_t)k * DFF + pn_ * 128 + (rem & 3) * 32)[0]; }
        asm volatile("" :: "v"(tv_[0]), "v"(tv_[1]), "v"(tv_[2]), "v"(tv_[3])); }
    SEAM(10);
    if (IN(11)) { for (int rep_ = 0; rep_ <= REPS(11); ++rep_) { if (FAST_MOE1) p_moe1_fast(F); else p_moe1_naive(F); __syncthreads(); } } SEAM(11);
    if (IN(12)) { for (int rep_ = 0; rep_ <= REPS(12); ++rep_) { if (FAST_MOE2) p_moe2_fast(F); else p_moe2_naive(F); __syncthreads(); } }
    SEAM(12);
    if (PROBE_ABL >= 0 && IN(12)) { GRID_BAR(); p_moe1_probe(F); }
#if PROBE_X == 1
    if (IN(12)) { GRID_BAR(); p_attn_fast(F); }
#elif PROBE_X == 2
    if (IN(12)) { GRID_BAR(); for (int u = F.bid; u < 2 * NG; u += F.G) { const int g = u >> 1, pm = u & 1;
        const ARows A{(const bf16_t*)(F.ws + WS_UX) + (size_t)g * 512 * 512, 512};
        { B2Bf16 Bl; Bl.base = (const bf16_t*)(F.ws + WS_BMAT) + (size_t)g * 256 * 256; Bl.ld = 256; const EpiS E{(float*)(F.ws + WS_SS) + (size_t)g * 512 * 256};
          gemm_tile2<ARows, B2Bf16, EpiS, false>(F.lds, A, Bl, E, pm * 256, 0, 256); }
        asm volatile("s_waitcnt vmcnt(0)" ::: "memory"); __syncthreads(); ssm_scan_half(F, g, pm); asm volatile("s_waitcnt vmcnt(0)" ::: "memory"); __syncthreads();
        { B2Bf16 Bl; Bl.base = (const bf16_t*)(F.ws + WS_KCMAT) + (size_t)g * 512 * 256; Bl.ld = 256; const EpiY E{(bf16_t*)(F.ws + WS_ZB), g};
          gemm_tile2<ARows, B2Bf16, EpiY, false>(F.lds, A, Bl, E, pm * 256, 0, 512); } __syncthreads(); } }
#elif PROBE_X == 4
    if (IN(12)) { GRID_BAR(); for (int u = F.bid; u < 2 * NG; u += F.G) { const int g = u >> 1, pm = u & 1; ssm_scan_half(F, g, pm); } }
#elif PROBE_X == 3
    if (IN(12)) { GRID_BAR(); }
#endif
    if (IN(13)) { for (int rep_ = 0; rep_ <= REPS(13); ++rep_) { p_final(F); __syncthreads(); } }
#undef IN
#undef SEAM
}

extern "C" void kernel_launch(void* const* d_in, const int* in_sizes, int n_in, void* d_out, int out_size, void* d_ws, size_t ws_size, hipStream_t stream) {
    static int grid = 0;
    if (grid == 0) {
        if (n_in != 26 || out_size != TOK * DM || ws_size < WS_END) { fprintf(stderr, "kernel_launch: unexpected problem (n_in %d out %d ws %zu need %zu)\n", n_in, out_size, ws_size, (size_t)WS_END); grid = -1; return; }
        int dev = 0, cus = 0, per_cu = 0;
        if (hipGetDevice(&dev) != hipSuccess || hipDeviceGetAttribute(&cus, hipDeviceAttributeMultiprocessorCount, dev) != hipSuccess) { grid = -1; return; }
        if (hipFuncSetAttribute((const void*)fwd, hipFuncAttributeMaxDynamicSharedMemorySize, LDS_BYTES) != hipSuccess) { fprintf(stderr, "kernel_launch: hipFuncSetAttribute failed\n"); grid = -1; return; }
        if (hipOccupancyMaxActiveBlocksPerMultiprocessor(&per_cu, (const void*)fwd, NT, LDS_BYTES) != hipSuccess || per_cu < 1) { fprintf(stderr, "kernel_launch: occupancy query says %d\n", per_cu); }
        (void)hipGetLastError();
        grid = cus;
    }
    if (grid < 0) return;
    (void)hipMemsetAsync((char*)d_ws + WS_CTL, 0, CTL_BYTES + (size_t)NB * 12288 * 4, stream);
    Args a{};
    for (int i = 0; i < 26; ++i) a.in[i] = (const float*)d_in[i];
    a.out = (float*)d_out; a.ws = (unsigned char*)d_ws;
#if N_LAUNCH_MODE == 1
    a.ph_lo = 0; a.ph_hi = N_PHASES;
    hipLaunchKernelGGL(fwd, dim3(grid), dim3(NT), LDS_BYTES, stream, a);
#else
    for (int p = 0; p < N_PHASES; ++p) {
        if (p == 4 || p == 5) continue;
        a.ph_lo = p; a.ph_hi = p + 1;
        hipLaunchKernelGGL(fwd, dim3(grid), dim3(NT), LDS_BYTES, stream, a);
    }
#endif
}
```

```cpp
#include <hip/hip_runtime.h>
#include <stdint.h>
#include <stdio.h>

#ifndef N_LAUNCH_MODE
#define N_LAUNCH_MODE 1
#endif

#ifndef PROBE_MASK
#define PROBE_MASK 0
#endif
#define REPS(k) ((PROBE_MASK >> (k)) & 1)
#define FAST_INPROJ 1
#define FAST_GLU 1
#define FAST_OUT 1
#define FAST_MOE1 1
#define FAST_MOE2 1
#define FAST_SSM 1
#define FAST_ATTN 1
#define LAS __attribute__((address_space(3)))
typedef unsigned short bf16_t;
typedef float f32x4 __attribute__((ext_vector_type(4)));
typedef float f32x2 __attribute__((ext_vector_type(2)));
typedef short bf16x8 __attribute__((ext_vector_type(8)));
typedef short s16x4 __attribute__((ext_vector_type(4)));
typedef unsigned u32x2 __attribute__((ext_vector_type(2)));
typedef unsigned u32x4 __attribute__((ext_vector_type(4)));

constexpr int NT = 512;
constexpr int TOK = 8192, DM = 2048, NB = 4, SEQ = 2048;
constexpr int DSSM = 1024, DATT = 1024, NH = 16, HD = 64, DINP = 4096;
constexpr int NE = 16, CAP = 256, DFF = 2816;
constexpr int NG = 64, NP = 64, GH = 16;
constexpr float EPS = 1e-6f;

constexpr size_t al256(size_t x) { return (x + 255) & ~(size_t)255; }
constexpr size_t WS_CTL   = 0;
constexpr size_t CTL_BYTES = 32768;
constexpr size_t WS_MOD   = WS_CTL + CTL_BYTES;
constexpr size_t WS_H1    = al256(WS_MOD + (size_t)NB * 12288 * 4);
constexpr size_t WS_UX    = al256(WS_H1 + (size_t)TOK * DM * 2);
constexpr size_t WS_Q     = al256(WS_UX + (size_t)64 * 512 * 512 * 2);
constexpr size_t WS_K     = al256(WS_Q + (size_t)TOK * 1024 * 2);
constexpr size_t WS_V     = al256(WS_K + (size_t)TOK * 1024 * 2);
constexpr size_t WS_SS    = al256(WS_V + (size_t)TOK * 1024 * 2);
constexpr size_t WS_ZB    = al256(WS_SS + (size_t)64 * 512 * 256 * 4);
constexpr size_t WS_YSSM  = al256(WS_ZB + (size_t)TOK * 1024 * 2);
constexpr size_t WS_SQS   = WS_YSSM;
constexpr size_t WS_SQA   = WS_YSSM + (size_t)TOK * 4 * 4;
constexpr size_t WS_YATT  = al256(WS_YSSM + (size_t)TOK * 1024 * 2);
constexpr size_t WS_MIX   = al256(WS_YATT + (size_t)TOK * 1024 * 2);
constexpr size_t WS_X1    = al256(WS_MIX + (size_t)TOK * DM * 2);
constexpr size_t WS_H2    = al256(WS_X1 + (size_t)TOK * DM * 4);
constexpr size_t WS_AFF   = al256(WS_H2 + (size_t)TOK * DM * 2);
constexpr size_t WS_IDX   = al256(WS_AFF + (size_t)NB * NE * SEQ * 4);
constexpr size_t WS_WAFF  = al256(WS_IDX + (size_t)NB * NE * CAP * 4);
constexpr size_t WS_SLOT  = al256(WS_WAFF + (size_t)NB * NE * CAP * 4);
constexpr size_t WS_HID   = al256(WS_SLOT + (size_t)NB * NE * SEQ * 4);
constexpr size_t WS_YE    = al256(WS_HID + (size_t)NE * 1024 * DFF * 2);
constexpr size_t WS_BMAT  = al256(WS_YE + (size_t)NE * 1024 * DM * 2);
constexpr size_t WS_KCMAT = al256(WS_BMAT + (size_t)64 * 256 * 256 * 2);
constexpr size_t WS_LAM   = al256(WS_KCMAT + (size_t)64 * 512 * 256 * 2);
constexpr size_t WS_WINB  = al256(WS_LAM + (size_t)2 * 64 * 64 * 2 * 4);
constexpr size_t WS_WGLUB = al256(WS_WINB + (size_t)DM * DINP * 2);
constexpr size_t WS_WOUTB = al256(WS_WGLUB + (size_t)1024 * 1024 * 2);
constexpr size_t WS_END   = al256(WS_WOUTB + (size_t)DM * DM * 2);

constexpr int LDS_BYTES = 163840;

typedef __bf16 bf16x2_t __attribute__((ext_vector_type(2)));
__device__ __forceinline__ bf16_t f2bf(float f) { return __builtin_bit_cast(bf16_t, (__bf16)f); }
__device__ __forceinline__ float bf2f(bf16_t b) { return __uint_as_float(((unsigned)b) << 16); }
__device__ __forceinline__ float bflo(unsigned w) { return __uint_as_float(w << 16); }
__device__ __forceinline__ float bfhi(unsigned w) { return __uint_as_float(w & 0xffff0000u); }
__device__ __forceinline__ unsigned pack2(float lo, float hi) { const f32x2 f = {lo, hi}; return __builtin_bit_cast(unsigned, __builtin_convertvector(f, bf16x2_t)); }
__device__ __forceinline__ float wave_sum(float v) {
#pragma unroll
    for (int m = 32; m >= 1; m >>= 1) v += __shfl_xor(v, m);
    return v;
}
__device__ __forceinline__ float silu_f(float v) { return v * __builtin_amdgcn_rcpf(1.0f + __expf(-v)); }
__device__ __forceinline__ float sigmoid_f(float v) { return __builtin_amdgcn_rcpf(1.0f + __expf(-v)); }
__device__ __forceinline__ float gelu_tanh(float y) { const float t = y + 0.044715f * y * y * y; return y * __builtin_amdgcn_rcpf(1.0f + __builtin_amdgcn_exp2f(-2.3022082232f * t)); }
__device__ __forceinline__ f32x2 exp2_2(f32x2 v) { return (f32x2){__builtin_amdgcn_exp2f(v[0]), __builtin_amdgcn_exp2f(v[1])}; }
__device__ __forceinline__ f32x2 rcp_2(f32x2 v) { return (f32x2){__builtin_amdgcn_rcpf(v[0]), __builtin_amdgcn_rcpf(v[1])}; }
__device__ __forceinline__ f32x2 sigmoid_2(f32x2 v) { return rcp_2(exp2_2(v * (f32x2){-1.44269504f, -1.44269504f}) + (f32x2){1.0f, 1.0f}); }
__device__ __forceinline__ f32x2 silu_mul_2(f32x2 g, f32x2 u) { return g * sigmoid_2(g) * u; }
__device__ __forceinline__ f32x2 gelu_tanh_2(f32x2 y) { const f32x2 t = y + (f32x2){0.044715f, 0.044715f} * y * y * y; return y * rcp_2(exp2_2(t * (f32x2){-2.3022082232f, -2.3022082232f}) + (f32x2){1.0f, 1.0f}); }
__device__ __forceinline__ u32x2 silu_pack4(f32x4 g, f32x4 u) { const f32x2 a = silu_mul_2((f32x2){g[0], g[1]}, (f32x2){u[0], u[1]}), b = silu_mul_2((f32x2){g[2], g[3]}, (f32x2){u[2], u[3]}); u32x2 w; w.x = pack2(a[0], a[1]); w.y = pack2(b[0], b[1]); return w; }
__device__ __forceinline__ u32x2 glu_pack4(u32x2 zw, f32x4 v, f32x4 bb) { const f32x2 a = (f32x2){bflo(zw.x), bfhi(zw.x)} * sigmoid_2((f32x2){v[0] + bb[0], v[1] + bb[1]}), b = (f32x2){bflo(zw.y), bfhi(zw.y)} * sigmoid_2((f32x2){v[2] + bb[2], v[3] + bb[3]}); u32x2 w; w.x = pack2(a[0], a[1]); w.y = pack2(b[0], b[1]); return w; }

#define XB_TMO      128
#define XB_XCNT(j)  (256  + 64 * (j))
#define XB_XSUB(j)  (1280 + 64 * (j))
#define XB_XGEN(j)  (2304 + 64 * (j))
#define XB_TOP      3328
#define XB_TOPGEN   3392
#define XCD_BAR_WORDS 3456
#define XB_SPIN_CAP (1u << 18)
__device__ __forceinline__ unsigned xb_ld(unsigned* p)              { return __hip_atomic_load(p, __ATOMIC_RELAXED, __HIP_MEMORY_SCOPE_AGENT); }
__device__ __forceinline__ unsigned xb_add(unsigned* p, unsigned v) { return __hip_atomic_fetch_add(p, v, __ATOMIC_RELAXED, __HIP_MEMORY_SCOPE_AGENT); }
__device__ __forceinline__ unsigned xb_xcc_id() { return (unsigned)__builtin_amdgcn_s_getreg((3 << 11) | 20) & 0xFu; }
#define XB_SPIN(cond, bar) do { unsigned _sp = 0; while (cond) { __builtin_amdgcn_s_sleep(1); \
    if ((++_sp & 255u) == 0u) { if (xb_ld(&(bar)[XB_TMO])) break; if (_sp > XB_SPIN_CAP) { atomicAdd(&(bar)[XB_TMO], 1u); break; } } } } while (0)
struct XcdBarrier { unsigned* bar; unsigned x; unsigned nloc, nx; };
__device__ __forceinline__ XcdBarrier xcd_barrier_post(unsigned* bar) {
    XcdBarrier b; b.bar = bar; b.x = xb_xcc_id(); b.nloc = 0u; b.nx = 0u;
    if (threadIdx.x == 0) (void)xb_add(&bar[XB_XCNT(b.x)], 1u);
    return b;
}
__device__ __forceinline__ void xcd_barrier_complete(unsigned* bar, unsigned x, unsigned& nloc, unsigned& nx) {
    const unsigned G = gridDim.x * gridDim.y * gridDim.z;
    unsigned sum, cnt, mine, sp = 0u;
    for (;;) {
        sum = 0u; cnt = 0u; mine = 0u;
#pragma unroll
        for (unsigned j = 0; j < 16; ++j) { const unsigned c = xb_ld(&bar[XB_XCNT(j)]); sum += c; cnt += (c > 0u) ? 1u : 0u; mine = (j == x) ? c : mine; }
        if (sum == G) break;
        __builtin_amdgcn_s_sleep(1);
        if ((++sp & 255u) == 0u) { if (xb_ld(&bar[XB_TMO])) break; if (sp > XB_SPIN_CAP) { atomicAdd(&bar[XB_TMO], 1u); break; } }
    }
    nloc = mine > 0u ? mine : 1u; nx = cnt > 0u ? cnt : 1u;
}
__device__ __forceinline__ void xcd_barrier_setup(XcdBarrier& b) {
    if (__builtin_amdgcn_readfirstlane(threadIdx.x >> 6) == 0) { unsigned nloc, nx; xcd_barrier_complete(b.bar, b.x, nloc, nx);
        b.nloc = (unsigned)__builtin_amdgcn_readfirstlane((int)nloc); b.nx = (unsigned)__builtin_amdgcn_readfirstlane((int)nx); }
}
__device__ __forceinline__ void xcd_barrier(XcdBarrier& b) {
    asm volatile("s_waitcnt vmcnt(0)" ::: "memory");
    __syncthreads();
    if (threadIdx.x == 0) {
        unsigned* bar = b.bar;
        __builtin_amdgcn_s_waitcnt(0);
        const unsigned nloc = b.nloc, nx = b.nx;
        const unsigned old = xb_add(&bar[XB_XSUB(b.x)], 1u);
        const unsigned gen = old / nloc;
        if (old + 1u == (gen + 1u) * nloc) {
            __builtin_amdgcn_fence(__ATOMIC_RELEASE, "agent");
            asm volatile("s_waitcnt vmcnt(0)" ::: "memory");
            const unsigned og = xb_add(&bar[XB_TOP], 1u);
            const unsigned tg = og / nx;
            if (og + 1u == (tg + 1u) * nx) xb_add(&bar[XB_TOPGEN], 1u);
            else XB_SPIN(xb_ld(&bar[XB_TOPGEN]) == tg, bar);
            __builtin_amdgcn_fence(__ATOMIC_ACQUIRE, "agent");
            xb_add(&bar[XB_XGEN(b.x)], 1u);
            asm volatile("s_waitcnt vmcnt(0)" ::: "memory");
        } else {
            XB_SPIN(xb_ld(&bar[XB_XGEN(b.x)]) == gen, bar);
            __builtin_amdgcn_fence(__ATOMIC_ACQUIRE, "agent");
            asm volatile("s_waitcnt vmcnt(0)" ::: "memory");
        }
    }
    __syncthreads();
}

struct Args { const float* in[26]; float* out; unsigned char* ws; int ph_lo, ph_hi; };
enum { I_X = 0, I_C, I_WADA, I_BADA, I_GMIX, I_WIN, I_ARE, I_AIM, I_LOGDT, I_BRE, I_BIM, I_CRE, I_CIM, I_SSMD, I_WGLU, I_BGLU, I_RPB,
       I_GSSM, I_GATT, I_WOUT, I_GFFN, I_WROUTER, I_WGATE, I_WUP, I_WDOWN, I_GFINAL };

__device__ __forceinline__ void st8_wt(void* p, u32x2 w) { asm volatile("global_store_dwordx2 %0, %1, off sc1\n\ts_nop 1" :: "v"(p), "v"(w) : "memory"); }
struct ARows { const bf16_t* base; size_t ld; __device__ __forceinline__ const bf16_t* ptr(int r) const { return base + (size_t)r * ld; }
    __device__ __forceinline__ unsigned off(int r) const { return (unsigned)r * (unsigned)ld; } };
struct AGather { const bf16_t* base; const int* idx; int e; unsigned koff;
    __device__ __forceinline__ const bf16_t* ptr(int r) const { const int b = r >> 8; return base + (size_t)(b * SEQ + idx[(b * NE + e) * CAP + (r & 255)]) * DM; }
    __device__ __forceinline__ unsigned off(int r) const { const int b = r >> 8; return (unsigned)(b * SEQ + idx[(b * NE + e) * CAP + (r & 255)]) * (unsigned)DM + koff; } };
struct BF32 { const float* base; size_t ld; __device__ __forceinline__ float get(int k, int n) const { return base[(size_t)k * ld + n]; }
    __device__ __forceinline__ float get2(int, int) const { return 0.f; } };
struct BF32Dual { const float* g; const float* u; size_t ld; __device__ __forceinline__ float get(int k, int n) const { return g[(size_t)k * ld + n]; }
    __device__ __forceinline__ float get2(int k, int n) const { return u[(size_t)k * ld + n]; } };

constexpr float QSCALE = 0.125f * 1.44269504088896f;
struct EpiInProj { bf16_t* UX; bf16_t* Q; bf16_t* K; bf16_t* V;
    __device__ __forceinline__ void store(int t, int n, float v) const {
        if (n < 1024) { const int g = n >> 4, h = n & 15, b = t >> 11, l = t & 2047; UX[(size_t)(g * 512 + b * 128 + (l >> 4)) * 512 + (l & 15) * 16 + h] = f2bf(v); }
        else if (n < 2048) Q[(size_t)t * 1024 + (n - 1024)] = f2bf(v * QSCALE);
        else if (n < 3072) K[(size_t)t * 1024 + (n - 2048)] = f2bf(v);
        else V[(size_t)t * 1024 + (n - 3072)] = f2bf(v);
    }
    __device__ __forceinline__ void store2(int, int, float, float) const {}
    __device__ __forceinline__ void store4(int t, int n, f32x4 v) const {
        u32x2 w;
        if (n < 1024) { const int g = n >> 4, h = n & 15, b = t >> 11, l = t & 2047; w.x = pack2(v[0], v[1]); w.y = pack2(v[2], v[3]);
            *(u32x2*)(UX + (size_t)(g * 512 + b * 128 + (l >> 4)) * 512 + (l & 15) * 16 + h) = w; }
        else if (n < 2048) { w.x = pack2(v[0] * QSCALE, v[1] * QSCALE); w.y = pack2(v[2] * QSCALE, v[3] * QSCALE); *(u32x2*)(Q + (size_t)t * 1024 + (n - 1024)) = w; }
        else if (n < 3072) { w.x = pack2(v[0], v[1]); w.y = pack2(v[2], v[3]); *(u32x2*)(K + (size_t)t * 1024 + (n - 2048)) = w; }
        else { w.x = pack2(v[0], v[1]); w.y = pack2(v[2], v[3]); *(u32x2*)(V + (size_t)t * 1024 + (n - 3072)) = w; }
    }
    static constexpr bool ROWSTORE = true; static constexpr int TILE_COLS = 256;
    __device__ __forceinline__ bool use_rows(int n0) const { return n0 >= 1024; }
    __device__ __forceinline__ u32x2 pack4(int, int n, f32x4 v) const { const float s = (n < 2048) ? QSCALE : 1.0f; u32x2 w; w.x = pack2(v[0] * s, v[1] * s); w.y = pack2(v[2] * s, v[3] * s); return w; }
    __device__ __forceinline__ bf16_t* rowptr(int r, int n0) const { return (n0 < 2048 ? Q + (n0 - 1024) : (n0 < 3072 ? K + (n0 - 2048) : V + (n0 - 3072))) + (size_t)r * 1024; } };
struct EpiGlu { const bf16_t* Z; const float* bglu; bf16_t* Y; float* SQS;
    __device__ __forceinline__ void store(int t, int n, float v) const { const float gate = v + bglu[n]; const float z = bf2f(Z[(size_t)t * 1024 + n]); Y[(size_t)t * DM + n] = f2bf(z * sigmoid_f(gate)); }
    __device__ __forceinline__ void store2(int, int, float, float) const {}
    __device__ __forceinline__ void store4(int t, int n, f32x4 v) const {
        const f32x4 bb = *(const f32x4*)(bglu + n); const u32x2 zw = *(const u32x2*)(Z + (size_t)t * 1024 + n);
        u32x2 w = glu_pack4(zw, v, bb);
        *(u32x2*)(Y + (size_t)t * DM + n) = w; }
    static constexpr bool ROWSTORE = true, ROWSQ = true; static constexpr int TILE_COLS = 256;
    __device__ __forceinline__ bool use_rows(int) const { return true; }
    __device__ __forceinline__ void rowsq(int r, int n0, float ss) const { SQS[(size_t)r * 4 + (n0 >> 8)] = ss; }
    typedef f32x4 Col; typedef u32x2 Pre; static constexpr int PRE_MI = 8;
    __device__ __forceinline__ Col colpre(int n) const { return *(const f32x4*)(bglu + n); }
    __device__ __forceinline__ Pre pre(int t, int n) const { return *(const u32x2*)(Z + (size_t)t * 1024 + n); }
    __device__ __forceinline__ u32x2 pack4p(const Pre& zw, const Col& bb, f32x4 v) const {
        u32x2 w = glu_pack4(zw, v, bb); return w; }
    __device__ __forceinline__ u32x2 pack4(int t, int n, f32x4 v) const { const f32x4 bb = *(const f32x4*)(bglu + n); const u32x2 zw = *(const u32x2*)(Z + (size_t)t * 1024 + n);
        u32x2 w = glu_pack4(zw, v, bb); return w; }
    __device__ __forceinline__ bf16_t* rowptr(int r, int n0) const { return Y + (size_t)r * DM + n0; } };
struct EpiOut { const float* x; const float* mod; bf16_t* X1; const float* SQS; const float* SQA;
    static constexpr int MIDK = 16;
    __device__ __forceinline__ void row_factors(int row, float& mid, float& end) const {
        const f32x4* ap = (const f32x4*)(SQA + (size_t)row * 16); const f32x4 a0 = ap[0], a1 = ap[1], a2 = ap[2], a3 = ap[3], s4 = *(const f32x4*)(SQS + (size_t)row * 4);
        const float att = (((a0[0] + a0[1]) + (a0[2] + a0[3])) + ((a1[0] + a1[1]) + (a1[2] + a1[3]))) + (((a2[0] + a2[1]) + (a2[2] + a2[3])) + ((a3[0] + a3[1]) + (a3[2] + a3[3])));
        const float ssm = (s4[0] + s4[1]) + (s4[2] + s4[3]);
        const float am = att * (1.0f / 1024.0f) + EPS; end = rsqrtf(am); mid = rsqrtf(ssm * (1.0f / 1024.0f) + EPS) * sqrtf(am); }
    __device__ __forceinline__ void store(int t, int n, float v) const { const int b = t >> 11; X1[(size_t)t * DM + n] = f2bf(x[(size_t)t * DM + n] + mod[b * 12288 + 4096 + n] * v); }
    __device__ __forceinline__ void store2(int, int, float, float) const {}
    __device__ __forceinline__ u32x2 pack4(int t, int n, f32x4 v) const { const int b = t >> 11;
        const f32x4 xv = *(const f32x4*)(x + (size_t)t * DM + n), gt = *(const f32x4*)(mod + b * 12288 + 4096 + n); const f32x4 r = xv + gt * v;
        u32x2 w; w.x = pack2(r[0], r[1]); w.y = pack2(r[2], r[3]); return w; }
    __device__ __forceinline__ void store4(int t, int n, f32x4 v) const { *(u32x2*)(X1 + (size_t)t * DM + n) = pack4(t, n, v); }
    typedef f32x4 Col; typedef f32x4 Pre; static constexpr int PRE_MI = 4;
    int bsel;
    __device__ __forceinline__ Col colpre(int n) const { return *(const f32x4*)(mod + bsel * 12288 + 4096 + n); }
    __device__ __forceinline__ Pre pre(int t, int n) const { return __builtin_nontemporal_load((const f32x4*)(x + (size_t)t * DM + n)); }
    __device__ __forceinline__ u32x2 pack4p(const Pre& xv, const Col& gt, f32x4 v) const { const f32x4 r = xv + gt * v; u32x2 w; w.x = pack2(r[0], r[1]); w.y = pack2(r[2], r[3]); return w; }
    static constexpr bool ROWSTORE = true; static constexpr int TILE_COLS = 256;
    __device__ __forceinline__ bool use_rows(int) const { return true; }
    __device__ __forceinline__ bf16_t* rowptr(int r, int n0) const { return X1 + (size_t)r * DM + n0; } };
struct EpiMoe1 { bf16_t* HID;
    __device__ __forceinline__ void store(int, int, float) const {}
    __device__ __forceinline__ void store2(int r, int n, float g, float u) const { HID[(size_t)r * DFF + n] = f2bf(silu_f(g) * u); }
    __device__ __forceinline__ void store4d(int r, int n, f32x4 g, f32x4 u) const { u32x2 w = silu_pack4(g, u);
        *(u32x2*)(HID + (size_t)r * DFF + n) = w; }
    static constexpr bool ROWSTORE = true; static constexpr int TILE_COLS = 128;
    __device__ __forceinline__ bool use_rows(int) const { return true; }
    __device__ __forceinline__ u32x2 pack4d(int, int, f32x4 g, f32x4 u) const { u32x2 w = silu_pack4(g, u); return w; }
    __device__ __forceinline__ bf16_t* rowptr(int r, int n0) const { return HID + (size_t)r * DFF + n0; } };
struct EpiMoe2 { bf16_t* YE; const float* waff; int e;
    __device__ __forceinline__ void store(int r, int n, float v) const { const int b = r >> 8; YE[(size_t)r * DM + n] = f2bf(v * waff[(b * NE + e) * CAP + (r & 255)]); }
    __device__ __forceinline__ void store2(int, int, float, float) const {}
    __device__ __forceinline__ void store4(int r, int n, f32x4 v) const { const int b = r >> 8; const float a = waff[(b * NE + e) * CAP + (r & 255)];
        u32x2 w; w.x = pack2(v[0] * a, v[1] * a); w.y = pack2(v[2] * a, v[3] * a); *(u32x2*)(YE + (size_t)r * DM + n) = w; }
    static constexpr bool ROWSTORE = true; static constexpr int TILE_COLS = 256;
    __device__ __forceinline__ bool use_rows(int) const { return true; }
    __device__ __forceinline__ u32x2 pack4(int r, int, f32x4 v) const { const int b = r >> 8; const float a = waff[(b * NE + e) * CAP + (r & 255)]; u32x2 w; w.x = pack2(v[0] * a, v[1] * a); w.y = pack2(v[2] * a, v[3] * a); return w; }
    typedef int Col; typedef float Pre; static constexpr int PRE_MI = 8;
    __device__ __forceinline__ Col colpre(int) const { return 0; }
    __device__ __forceinline__ Pre pre(int r, int) const { const int b = r >> 8; return waff[(b * NE + e) * CAP + (r & 255)]; }
    __device__ __forceinline__ u32x2 pack4p(const Pre& a, const Col&, f32x4 v) const { u32x2 w; w.x = pack2(v[0] * a, v[1] * a); w.y = pack2(v[2] * a, v[3] * a); return w; }
    __device__ __forceinline__ bf16_t* rowptr(int r, int n0) const { return YE + (size_t)r * DM + n0; } };

template <class AF, class BF, class EF, bool DUAL>
__device__ __forceinline__ void gemm_naive_tile(float* lds, const AF& A, const BF& Bm, const EF& E, int m0, int n0, int K) {
    float* As = lds;
    float* Bs = lds + 16 * 132;
    float* Bs2 = Bs + 16 * 68;
    float acc[4][4], acc2[4][4];
#pragma unroll
    for (int i = 0; i < 4; ++i)
#pragma unroll
        for (int j = 0; j < 4; ++j) { acc[i][j] = 0.f; acc2[i][j] = 0.f; }
    const int tid = threadIdx.x, tm = tid >> 4, tn = tid & 15;
    const int ar = tid >> 2, ak = (tid & 3) * 4;
    const bf16_t* ap = A.ptr(m0 + ar);
    const int bk = tid >> 5, bc = (tid & 31) * 2;
    for (int k0 = 0; k0 < K; k0 += 16) {
        const u32x2 av = *(const u32x2*)(ap + k0 + ak);
        As[(ak + 0) * 132 + ar] = bflo(av.x); As[(ak + 1) * 132 + ar] = bfhi(av.x); As[(ak + 2) * 132 + ar] = bflo(av.y); As[(ak + 3) * 132 + ar] = bfhi(av.y);
        Bs[bk * 68 + bc] = Bm.get(k0 + bk, n0 + bc); Bs[bk * 68 + bc + 1] = Bm.get(k0 + bk, n0 + bc + 1);
        if (DUAL) { Bs2[bk * 68 + bc] = Bm.get2(k0 + bk, n0 + bc); Bs2[bk * 68 + bc + 1] = Bm.get2(k0 + bk, n0 + bc + 1); }
        __syncthreads();
#pragma unroll
        for (int kk = 0; kk < 16; ++kk) {
            const f32x4 a4 = *(const f32x4*)(As + kk * 132 + tm * 4);
            const f32x4 b4 = *(const f32x4*)(Bs + kk * 68 + tn * 4);
#pragma unroll
            for (int i = 0; i < 4; ++i)
#pragma unroll
                for (int j = 0; j < 4; ++j) acc[i][j] += a4[i] * b4[j];
            if (DUAL) {
                const f32x4 c4 = *(const f32x4*)(Bs2 + kk * 68 + tn * 4);
#pragma unroll
                for (int i = 0; i < 4; ++i)
#pragma unroll
                    for (int j = 0; j < 4; ++j) acc2[i][j] += a4[i] * c4[j];
            }
        }
        __syncthreads();
    }
#pragma unroll
    for (int i = 0; i < 4; ++i)
#pragma unroll
        for (int j = 0; j < 4; ++j) { if (DUAL) E.store2(m0 + tm * 4 + i, n0 + tn * 4 + j, acc[i][j], acc2[i][j]); else E.store(m0 + tm * 4 + i, n0 + tn * 4 + j, acc[i][j]); }
}

struct Frame {
    const float* in[26]; float* out; unsigned char* ws; unsigned char* lds;
    int tid, lane, wave, G, bid;
    __device__ __forceinline__ float* modp() const { return (float*)(ws + WS_MOD); }
};

__device__ __forceinline__ void p_ada(const Frame& F, int u_first, int u_step, int u_end) {
    float* sc = (float*)F.lds;
    float* red = sc + 4 * 2048;
    const float* c = F.in[I_C]; const float* w = F.in[I_WADA]; const float* bias = F.in[I_BADA];
    for (int i = F.tid; i < 4 * 2048; i += NT) sc[i] = silu_f(c[i]);
    __syncthreads();
    const int cq = F.tid & 7, kq = F.tid >> 3;
    f32x4 wv[16];
#define ADA_LOAD(u_) do { const int kh_ = (u_) & 1, n0_ = ((u_) >> 1) * 32 + cq * 4, kb_ = kh_ * 1024 + kq; \
        _Pragma("unroll") for (int q = 0; q < 16; ++q) wv[q] = __builtin_nontemporal_load((const f32x4*)(w + (size_t)(kb_ + 64 * q) * 12288 + n0_)); } while (0)
    if (u_first < u_end) ADA_LOAD(u_first);
    for (int u = u_first; u < u_end; u += u_step) {
        const int kh = u & 1, kb = kh * 1024 + kq;
        float acc[4][4];
#pragma unroll
        for (int b = 0; b < 4; ++b)
#pragma unroll
            for (int j = 0; j < 4; ++j) acc[b][j] = 0.f;
#pragma unroll
        for (int q = 0; q < 16; ++q)
#pragma unroll
            for (int b = 0; b < 4; ++b) { const float s = sc[b * 2048 + kb + 64 * q];
#pragma unroll
                for (int j = 0; j < 4; ++j) acc[b][j] += s * wv[q][j]; }
        if (u + u_step < u_end) ADA_LOAD(u + u_step);
#pragma unroll
        for (int b = 0; b < 4; ++b)
#pragma unroll
            for (int j = 0; j < 4; ++j) red[(kq * 8 + cq) * 16 + b * 4 + j] = acc[b][j];
        __syncthreads();
        if (F.tid < 128) {
            const int b = F.tid >> 5, col = F.tid & 31;
            float s = 0.f;
            for (int q = 0; q < 64; ++q) s += red[(q * 8 + (col >> 2)) * 16 + b * 4 + (col & 3)];
            const int n = (u >> 1) * 32 + col;
            atomicAdd(F.modp() + b * 12288 + n, kh == 0 ? s + bias[n] : s);
        }
        __syncthreads();
    }
#undef ADA_LOAD
}

template <bool SCALE> __device__ __forceinline__ void wconv_load(const f32x4* s, int n, int i, int stride, const float* gs, const float* ga, f32x4 (&a)[4], f32x4 (&b)[4], float (&gq)[4]) {
#pragma unroll
    for (int j = 0; j < 4; ++j) { int ii = i + j * stride; ii = ii < n ? ii : n - 1; a[j] = __builtin_nontemporal_load(s + 2 * ii); b[j] = __builtin_nontemporal_load(s + 2 * ii + 1);
        gq[j] = 1.0f; if (SCALE) { const int k = ii >> 8; gq[j] = k < 1024 ? gs[k] : ga[k - 1024]; } }
}
__device__ __forceinline__ void wconv_store(u32x4* d, int n, int i, int stride, const f32x4 (&a)[4], const f32x4 (&b)[4], const float (&gq)[4]) {
#pragma unroll
    for (int j = 0; j < 4; ++j) { const int ii = i + j * stride;
        if (ii < n) { const float g = gq[j];
            u32x4 w; w.x = pack2(a[j][0] * g, a[j][1] * g); w.y = pack2(a[j][2] * g, a[j][3] * g); w.z = pack2(b[j][0] * g, b[j][1] * g); w.w = pack2(b[j][2] * g, b[j][3] * g); d[ii] = w; } }
}
template <bool SCALE> __device__ __forceinline__ void wconv_range(const f32x4* s, u32x4* d, int n, int start, int stride, const float* gs, const float* ga) {
    f32x4 a0[4], b0[4], a1[4], b1[4]; float g0[4], g1[4];
    int i = start;
    if (i < n) wconv_load<SCALE>(s, n, i, stride, gs, ga, a0, b0, g0);
    for (; i < n; i += 8 * stride) {
        if (i + 4 * stride < n) wconv_load<SCALE>(s, n, i + 4 * stride, stride, gs, ga, a1, b1, g1);
        wconv_store(d, n, i, stride, a0, b0, g0);
        if (i + 8 * stride < n) wconv_load<SCALE>(s, n, i + 8 * stride, stride, gs, ga, a0, b0, g0);
        if (i + 4 * stride < n) wconv_store(d, n, i + 4 * stride, stride, a1, b1, g1);
    }
}
__device__ __forceinline__ void p_wconv(const Frame& F, int rank, int nblk) {
    wconv_range<false>((const f32x4*)F.in[I_WIN], (u32x4*)(F.ws + WS_WINB), DM * DINP / 8, rank * NT + F.tid, nblk * NT, nullptr, nullptr);
    wconv_range<false>((const f32x4*)F.in[I_WGLU], (u32x4*)(F.ws + WS_WGLUB), 1024 * 1024 / 8, rank * NT + F.tid, nblk * NT, nullptr, nullptr);
    wconv_range<true>((const f32x4*)F.in[I_WOUT], (u32x4*)(F.ws + WS_WOUTB), DM * DM / 8, rank * NT + F.tid, nblk * NT, F.in[I_GSSM], F.in[I_GATT]);
}
__device__ __forceinline__ void p_h1(const Frame& F) {
    const float* x = F.in[I_X]; const float* g = F.in[I_GMIX]; const float* mod = F.modp(); bf16_t* H1 = (bf16_t*)(F.ws + WS_H1);
    for (int c = F.bid * 8 + F.wave; c < TOK / 4; c += F.G * 8) {
        const int t0 = 4 * c, b = t0 >> 11;
        f32x4 xr[4][8];
#pragma unroll
        for (int i = 0; i < 8; ++i) xr[0][i] = __builtin_nontemporal_load((const f32x4*)(x + (size_t)t0 * DM + i * 256 + F.lane * 4));
        f32x4 ga[8], sb[8];
#pragma unroll
        for (int i = 0; i < 8; ++i) { const int k = i * 256 + F.lane * 4;
            const f32x4 gv = *(const f32x4*)(g + k), sc = *(const f32x4*)(mod + b * 12288 + 2048 + k); sb[i] = *(const f32x4*)(mod + b * 12288 + k);
#pragma unroll
            for (int j = 0; j < 4; ++j) ga[i][j] = gv[j] * (1.0f + sc[j]); }
#pragma unroll
        for (int r = 1; r < 4; ++r)
#pragma unroll
            for (int i = 0; i < 8; ++i) xr[r][i] = __builtin_nontemporal_load((const f32x4*)(x + (size_t)(t0 + r) * DM + i * 256 + F.lane * 4));
#pragma unroll
        for (int r = 0; r < 4; ++r) {
            float ss = 0.f;
#pragma unroll
            for (int i = 0; i < 8; ++i) ss += xr[r][i][0] * xr[r][i][0] + xr[r][i][1] * xr[r][i][1] + xr[r][i][2] * xr[r][i][2] + xr[r][i][3] * xr[r][i][3];
            ss = wave_sum(ss);
            const float rstd = rsqrtf(ss * (1.0f / DM) + EPS);
#pragma unroll
            for (int i = 0; i < 8; ++i) { const int k = i * 256 + F.lane * 4;
                float o[4];
#pragma unroll
                for (int j = 0; j < 4; ++j) o[j] = (xr[r][i][j] * rstd) * ga[i][j] + sb[i][j];
                u32x2 w; w.x = pack2(o[0], o[1]); w.y = pack2(o[2], o[3]);
                *(u32x2*)(H1 + (size_t)(t0 + r) * DM + k) = w; }
        }
    }
}

__device__ __forceinline__ void p_inproj_naive(const Frame& F) {
    const ARows A{(const bf16_t*)(F.ws + WS_H1), DM}; const BF32 Bm{F.in[I_WIN], DINP};
    const EpiInProj E{(bf16_t*)(F.ws + WS_UX), (bf16_t*)(F.ws + WS_Q), (bf16_t*)(F.ws + WS_K), (bf16_t*)(F.ws + WS_V)};
    const int nM = TOK / 128, nN = DINP / 64;
    for (int u = F.bid; u < nM * nN; u += F.G) gemm_naive_tile<ARows, BF32, EpiInProj, false>((float*)F.lds, A, Bm, E, (u / nN) * 128, (u % nN) * 64, DM);
}
__device__ __forceinline__ void p_glu_naive(const Frame& F) {
    const ARows A{(const bf16_t*)(F.ws + WS_ZB), 1024}; const BF32 Bm{F.in[I_WGLU], 1024};
    const EpiGlu E{(const bf16_t*)(F.ws + WS_ZB), F.in[I_BGLU], (bf16_t*)(F.ws + WS_MIX), (float*)(F.ws + WS_SQS)};
    const int nM = TOK / 128, nN = 1024 / 64;
    for (int u = F.bid; u < nM * nN; u += F.G) gemm_naive_tile<ARows, BF32, EpiGlu, false>((float*)F.lds, A, Bm, E, (u / nN) * 128, (u % nN) * 64, 1024);
}
__device__ __forceinline__ void p_outproj_naive(const Frame& F) {
    const ARows A{(const bf16_t*)(F.ws + WS_MIX), DM}; const BF32 Bm{F.in[I_WOUT], DM};
    const EpiOut E{F.in[I_X], F.modp(), (bf16_t*)(F.ws + WS_X1)};
    const int nM = TOK / 128, nN = DM / 64;
    for (int u = F.bid; u < nM * nN; u += F.G) gemm_naive_tile<ARows, BF32, EpiOut, false>((float*)F.lds, A, Bm, E, (u / nN) * 128, (u % nN) * 64, DM);
}
__device__ __forceinline__ void p_moe1_naive(const Frame& F) {
    const int nM = 1024 / 128, nN = DFF / 64;
    for (int u = F.bid; u < NE * nM * nN; u += F.G) {
        const int e = u / (nM * nN), r = u % (nM * nN);
        const AGather A{(const bf16_t*)(F.ws + WS_H2), (const int*)(F.ws + WS_IDX), e, 0u};
        const BF32Dual Bm{F.in[I_WGATE] + (size_t)e * DM * DFF, F.in[I_WUP] + (size_t)e * DM * DFF, DFF};
        const EpiMoe1 E{(bf16_t*)(F.ws + WS_HID) + (size_t)e * 1024 * DFF};
        gemm_naive_tile<AGather, BF32Dual, EpiMoe1, true>((float*)F.lds, A, Bm, E, (r / nN) * 128, (r % nN) * 64, DM);
    }
}
__device__ __forceinline__ void p_moe2_naive(const Frame& F) {
    const int nM = 1024 / 128, nN = DM / 64;
    for (int u = F.bid; u < NE * nM * nN; u += F.G) {
        const int e = u / (nM * nN), r = u % (nM * nN);
        const ARows A{(const bf16_t*)(F.ws + WS_HID) + (size_t)e * 1024 * DFF, DFF};
        const BF32 Bm{F.in[I_WDOWN] + (size_t)e * DFF * DM, DM};
        const EpiMoe2 E{(bf16_t*)(F.ws + WS_YE) + (size_t)e * 1024 * DM, (const float*)(F.ws + WS_WAFF), e};
        gemm_naive_tile<ARows, BF32, EpiMoe2, false>((float*)F.lds, A, Bm, E, (r / nN) * 128, (r % nN) * 64, DFF);
    }
}

__host__ __device__ __forceinline__ int lds_byte(int r, int c) { const int st = (r >> 4) * 2 + (c >> 5), rr = r & 15, cc = c & 31, ob = rr * 64 + cc * 2; return st * 1024 + (ob ^ (((ob >> 9) & 1) << 5)); }
__host__ __device__ __forceinline__ void stage_rc(int b, int& R, int& C) { const int st = b / 1024, sb = b % 1024, swz = sb ^ (((sb >> 9) & 1) << 5); R = (st >> 1) * 16 + swz / 64; C = (st & 1) * 32 + (swz % 64) / 2; }


template <class T, class = void> struct epi_rowstore { static constexpr bool value = false; };
template <class T> struct epi_rowstore<T, decltype((void)T::ROWSTORE)> { static constexpr bool value = true; };
template <class T, class = void> struct epi_rowsq { static constexpr bool value = false; };
template <class T> struct epi_rowsq<T, decltype((void)T::ROWSQ)> { static constexpr bool value = true; };
template <class T, class = void> struct epi_prel { static constexpr bool value = false; };
template <class T> struct epi_prel<T, decltype((void)T::PRE_MI)> { static constexpr bool value = true; };
template <class T, class = void> struct epi_mid { static constexpr bool value = false; };
template <class T> struct epi_mid<T, decltype((void)T::MIDK)> { static constexpr bool value = true; };
struct EpiMoe1Part { float* part;
    __device__ __forceinline__ void store4d(int r, int n, f32x4 g, f32x4 u) const {
        bf16_t* pg = (bf16_t*)part + (size_t)(r & 255) * 128 + (n & 127); bf16_t* pu = pg + 32768;
        u32x2 wg, wu; wg.x = pack2(g[0], g[1]); wg.y = pack2(g[2], g[3]); wu.x = pack2(u[0], u[1]); wu.y = pack2(u[2], u[3]);
        asm volatile("global_store_dwordx2 %0, %1, off sc1\n\ts_nop 1" :: "v"(pg), "v"(wg) : "memory");
        asm volatile("global_store_dwordx2 %0, %1, off sc1\n\ts_nop 1" :: "v"(pu), "v"(wu) : "memory"); } };
struct EpiMoe1Comb { bf16_t* HID; const float* part; unsigned* flag; unsigned* tmo;
    __device__ __forceinline__ void store4d(int r, int n, f32x4 g, f32x4 u) const {
        const PreD p = pred(r, n); store4dp(p, r, n, g, u); }
    struct PreD { u32x2 pg, pu; }; static constexpr int PRED_MI = 4;
    __device__ __forceinline__ PreD pred(int r, int n) const { PreD p; const bf16_t* a_ = (const bf16_t*)part + (size_t)(r & 255) * 128 + (n & 127); p.pg = *(const u32x2*)a_; p.pu = *(const u32x2*)(a_ + 32768); return p; }
    __device__ __forceinline__ void store4dp(const PreD& p, int r, int n, f32x4 g, f32x4 u) const {
        g += (f32x4){bflo(p.pg.x), bfhi(p.pg.x), bflo(p.pg.y), bfhi(p.pg.y)}; u += (f32x4){bflo(p.pu.x), bfhi(p.pu.x), bflo(p.pu.y), bfhi(p.pu.y)};
        u32x2 w = silu_pack4(g, u);
        *(u32x2*)(HID + (size_t)r * DFF + n) = w; } };
template <class T, class = void> struct epi_pred { static constexpr bool value = false; };
template <class T> struct epi_pred<T, decltype((void)T::PRED_MI)> { static constexpr bool value = true; };
template <class EF> __device__ __forceinline__ void epi_pre(const EF&) {}
__device__ __forceinline__ void epi_pre(const EpiMoe1Comb& E) {
    if (threadIdx.x == 0) { unsigned sp = 0;
        while (__hip_atomic_load(E.flag, __ATOMIC_RELAXED, __HIP_MEMORY_SCOPE_AGENT) == 0u) { __builtin_amdgcn_s_sleep(2);
            if ((++sp & 255u) == 0u) { if (__hip_atomic_load(E.tmo, __ATOMIC_RELAXED, __HIP_MEMORY_SCOPE_AGENT)) break; if (sp > (1u << 20)) { atomicAdd(E.tmo, 1u); break; } } }
        __builtin_amdgcn_fence(__ATOMIC_ACQUIRE, "agent"); asm volatile("s_waitcnt vmcnt(0)" ::: "memory"); }
    __syncthreads();
}
__device__ __forceinline__ void gload16_asm(f32x4& dst, const void* sbase, unsigned voff) { asm volatile("global_load_dwordx4 %0, %1, %2" : "=v"(dst) : "v"(voff), "s"(sbase)); }
template <int N> __device__ __forceinline__ void wait_vm1(f32x4& r) { asm volatile("s_waitcnt vmcnt(%1)" : "+v"(r) : "n"(N)); }
template <int N> __device__ __forceinline__ void wait_vm8(f32x4 (&r)[8]) { asm volatile("s_waitcnt vmcnt(%8)" : "+v"(r[0]), "+v"(r[1]), "+v"(r[2]), "+v"(r[3]), "+v"(r[4]), "+v"(r[5]), "+v"(r[6]), "+v"(r[7]) : "n"(N)); }
__device__ __forceinline__ void glds16n(const void* sbase, unsigned voff, unsigned lds_dst) {
    unsigned keep;
    asm volatile("s_mov_b32 %0, m0\n\ts_mov_b32 m0, %3\n\ts_nop 0\n\tglobal_load_lds_dwordx4 %1, %2\n\ts_mov_b32 m0, %0" : "=&s"(keep) : "v"(voff), "s"(sbase), "s"(lds_dst));
}
struct B2F32 {
    const float* base; unsigned ld; static constexpr int NL = 8;
    unsigned loff, bw0, bw1; int wid;
    __device__ __forceinline__ void init(int lane, int wid_) { wid = wid_; loff = (unsigned)lane * 16u; bw0 = (unsigned)(wid * 512 + ((8 * lane) ^ ((wid & 3) * 32))); bw1 = bw0 ^ 128u; }
    __device__ __forceinline__ void issue(int kt, int i, f32x4& r) const { gload16_asm(r, base + (size_t)(kt * 64 + wid + 8 * i) * ld, loff); }
    __device__ __forceinline__ void write1(LAS unsigned char* st, int i, const f32x4& r) const { u32x2 w; w.x = pack2(r[0], r[1]); w.y = pack2(r[2], r[3]); *(LAS u32x2*)(st + ((i & 1) ? bw1 : bw0) + i * 4096) = w; }
};
struct B2F32Dual {
    const float* g; const float* u; unsigned ld; static constexpr int NL = 8;
    unsigned loff, bw0, bw1; int wid;
    __device__ __forceinline__ void init(int lane, int wid_) { wid = wid_; loff = (unsigned)(lane >> 5) * ld * 4u + (unsigned)(lane & 31) * 16u;
        const int k = 2 * wid + (lane >> 5), slot = (k & 3) | ((k >> 1) & 4);
        bw0 = (unsigned)(k * 512 + ((8 * (lane & 31)) ^ (slot * 32))); bw1 = bw0 ^ 256u; }
    __device__ __forceinline__ void issue(int kt, int i, f32x4& r) const { gload16_asm(r, ((i >> 2) ? u : g) + (size_t)(kt * 64 + 2 * wid + 16 * (i & 3)) * ld, loff); }
    __device__ __forceinline__ void write1(LAS unsigned char* st, int i, const f32x4& r) const { u32x2 w; w.x = pack2(r[0], r[1]); w.y = pack2(r[2], r[3]); *(LAS u32x2*)(st + ((i >> 2) ? bw1 : bw0) + (i & 3) * 8192) = w; }
};
struct B2Bf16 {
    const bf16_t* base; unsigned ld; static constexpr int NL = 4;
    unsigned loff, bw0; int wid;
    __device__ __forceinline__ void init(int lane, int wid_) { wid = wid_; loff = (unsigned)(lane >> 5) * ld * 2u + (unsigned)(lane & 31) * 16u;
        const int k = 2 * wid + (lane >> 5), slot = (k & 3) | ((k >> 1) & 4); bw0 = (unsigned)(k * 512 + ((16 * (lane & 31)) ^ (slot * 32))); }
    __device__ __forceinline__ void issue(int kt, int i, f32x4& r) const { gload16_asm(r, base + (size_t)(kt * 64 + 2 * wid + 16 * i) * ld, loff); }
    __device__ __forceinline__ void write1(LAS unsigned char* st, int i, const f32x4& r) const { *(LAS f32x4*)(st + bw0 + i * 8192) = r; }
};

struct NoPf { __device__ __forceinline__ void issue(float (&)[3]) const {} __device__ __forceinline__ void retire(float (&)[3]) const {} };
struct AsoPre { unsigned v[4]; bool on; };
struct PfLines { const void* a; const float* b0; const float* b1; bool on;
    __device__ __forceinline__ void issue(float (&v)[3]) const { if (on) { v[0] = *(const float*)a; v[1] = *b0; v[2] = *b1; } }
    __device__ __forceinline__ void retire(float (&v)[3]) const { asm volatile("" :: "v"(v[0]), "v"(v[1]), "v"(v[2])); } };
template <class AF, class BL, class EF, bool DUAL, int ABL = 0, class PF = NoPf>
__device__ __forceinline__ void gemm_tile2(unsigned char* ldsg, const AF& A, BL Bl, const EF& E, int m0, int n0, int K, const PF pf = PF(), const AsoPre apre = AsoPre{{0u, 0u, 0u, 0u}, false}) {
    LAS unsigned char* lds = (LAS unsigned char*)ldsg;
    const unsigned lds0 = (unsigned)(uintptr_t)lds;
    const int tid = threadIdx.x, lane = tid & 63, wid = __builtin_amdgcn_readfirstlane(tid >> 6), wr = wid >> 2, wc = wid & 3, fr = lane & 15, fq = lane >> 4;
    const int nt = K / 64;
    constexpr int NL = BL::NL;
    const bf16_t* abase = A.base;
    unsigned aso[4];
#pragma unroll
    for (int p = 0; p < 4; ++p) { const int row = p * 64 + (tid >> 3), ch = (tid & 7) ^ ((row >> 1) & 7); aso[p] = apre.on ? apre.v[p] : (A.off(m0 + row) + (unsigned)(ch * 8)) * 2u; }
    Bl.init(lane, wid);
    const unsigned ao0 = (unsigned)((wr * 128 + fr) * 128 + (((0 + fq) ^ ((fr >> 1) & 7)) << 4));
    const unsigned ao1 = (unsigned)((wr * 128 + fr) * 128 + (((4 + fq) ^ ((fr >> 1) & 7)) << 4));
    unsigned boffn[4];
    { const int G = fq, q = fr >> 2, p = fr & 3, slot = q | ((G & 1) << 2);
#pragma unroll
      for (int ni = 0; ni < 4; ++ni) { const int colb = DUAL ? (ni >> 1) * 256 + wc * 64 + (ni & 1) * 32 : wc * 128 + ni * 32;
          boffn[ni] = (unsigned)((8 * G + q) * 512 + ((colb ^ (slot * 32)) + 8 * p)); } }
    f32x4 acc[8][4];
#pragma unroll
    for (int mi = 0; mi < 8; ++mi)
#pragma unroll
        for (int ni = 0; ni < 4; ++ni) acc[mi][ni] = (f32x4){0.f, 0.f, 0.f, 0.f};
    f32x4 breg[8];
#define G2_DMA(piece, soff, kt) if (ABL != 4 && ABL != 5) glds16n(abase, aso[piece] + (unsigned)(kt) * 128u, lds0 + (unsigned)(soff) + (unsigned)((piece) * 8192 + wid * 1024))
#define G2_RDB(dst, sbp, ni, ks) do { if (ABL == 3) { asm volatile("" : "+v"(dst)); break; } const s16x4 lo_ = __builtin_amdgcn_ds_read_tr16_b64_v4i16((LAS s16x4*)((sbp) + boffn[ni] + ((ks) * 32) * 512)); \
        const s16x4 hi_ = __builtin_amdgcn_ds_read_tr16_b64_v4i16((LAS s16x4*)((sbp) + boffn[ni] + ((ks) * 32 + 4) * 512)); \
        dst = (bf16x8){lo_[0], lo_[1], lo_[2], lo_[3], hi_[0], hi_[1], hi_[2], hi_[3]}; } while (0)
#define G2_RDA(sap, mi, ks) (ABL == 3 ? a_[9] : *(const LAS bf16x8*)((sap) + ((ks) ? ao1 : ao0) + (mi) * 2048))
#define G2_MMA(mi, afr, bfr) do { if (ABL == 1) { asm volatile("" :: "v"(afr), "v"(bfr[0]), "v"(bfr[1]), "v"(bfr[2]), "v"(bfr[3])); } else { _Pragma("unroll") for (int ni_ = 0; ni_ < 4; ++ni_) acc[mi][ni_] = __builtin_amdgcn_mfma_f32_16x16x32_bf16(bfr[ni_], afr, acc[mi][ni_], 0, 0, 0); } } while (0)
#pragma unroll
    for (int p = 0; p < 4; ++p) G2_DMA(p, 0, 0);
#pragma unroll
    for (int i = 0; i < NL; ++i) { if (ABL != 2 && ABL != 5) Bl.issue(0, i, breg[i]); }
#pragma unroll
    for (int p = 0; p < 4; ++p) G2_DMA(p, 32768, 1);
    float rf_mid0 = 1.f, rf_mid1 = 1.f, rf_end0 = 1.f, rf_end1 = 1.f;
    if constexpr (epi_mid<EF>::value) { E.row_factors(m0 + wr * 128 + fq * 16 + fr, rf_mid0, rf_end0); E.row_factors(m0 + wr * 128 + 64 + fq * 16 + fr, rf_mid1, rf_end1);
        asm volatile("" : "+v"(rf_mid0), "+v"(rf_mid1), "+v"(rf_end0), "+v"(rf_end1)); }
    wait_vm8<4>(breg);
#pragma unroll
    for (int i = 0; i < NL; ++i) Bl.write1(lds + 98304, i, breg[i]);
#pragma unroll
    for (int i = 0; i < NL; ++i) { if (ABL != 2 && ABL != 5) Bl.issue(1, i, breg[i]); }
    asm volatile("s_waitcnt lgkmcnt(0)" ::: "memory"); __builtin_amdgcn_s_barrier(); asm volatile("" ::: "memory");
    int sa_cur = 0, sa_nn = 65536;
#define G2_S0(MODE, t, mi) do { \
            if ((mi) + 2 < 8) a_[(mi) + 2] = G2_RDA(sap, (mi) + 2, 0); else a_[(mi) + 2] = G2_RDA(sap, (mi) - 6, 1); \
            if ((mi) >= 4) G2_RDB(b1[((mi) - 4) & 3], sbp, ((mi) - 4) & 3, 1); \
            if (MODE == 0 && (mi) < 4) G2_DMA((mi) & 3, sa_nn, (t) + 2); \
            G2_MMA(mi, a_[mi], b0); \
            __builtin_amdgcn_sched_barrier(0); } while (0)
#define G2_S1(MODE, t, mi) do { \
            if ((mi) + 2 < 8) a_[(mi) + 2] = G2_RDA(sap, (mi) + 2, 1); \
            if (MODE <= 1 && (mi) < NL) { if (MODE == 0) wait_vm1<NL + 3>(breg[mi]); else wait_vm1<((NL - 1 - (mi)) > 0 ? (NL - 1 - (mi)) : 0)>(breg[mi]); \
                Bl.write1(sbn, mi, breg[mi]); if (MODE == 0 && ABL != 2 && ABL != 5) Bl.issue((t) + 2, mi, breg[mi]); } \
            G2_MMA(mi, a_[mi], b1); \
            __builtin_amdgcn_sched_barrier(0); } while (0)
#define G2_KTILE(MODE, t) do { \
        LAS unsigned char* sap = lds + sa_cur; LAS unsigned char* sbp = lds + 98304 + ((t) & 1) * 32768; LAS unsigned char* sbn = lds + 98304 + (((t) + 1) & 1) * 32768; \
        bf16x8 b0[4], b1[4], a_[10]; if (ABL == 3) { _Pragma("unroll") for (int z_ = 0; z_ < 10; ++z_) a_[z_] = (bf16x8){0,0,0,0,0,0,0,0}; _Pragma("unroll") for (int z_ = 0; z_ < 4; ++z_) { b0[z_] = a_[0]; b1[z_] = a_[0]; } } \
        G2_RDB(b0[0], sbp, 0, 0); G2_RDB(b0[1], sbp, 1, 0); G2_RDB(b0[2], sbp, 2, 0); G2_RDB(b0[3], sbp, 3, 0); \
        a_[0] = G2_RDA(sap, 0, 0); a_[1] = G2_RDA(sap, 1, 0); \
        G2_S0(MODE, t, 0); G2_S0(MODE, t, 1); G2_S0(MODE, t, 2); G2_S0(MODE, t, 3); G2_S0(MODE, t, 4); G2_S0(MODE, t, 5); G2_S0(MODE, t, 6); G2_S0(MODE, t, 7); \
        a_[0] = a_[8]; a_[1] = a_[9]; \
        G2_S1(MODE, t, 0); G2_S1(MODE, t, 1); G2_S1(MODE, t, 2); G2_S1(MODE, t, 3); G2_S1(MODE, t, 4); G2_S1(MODE, t, 5); G2_S1(MODE, t, 6); G2_S1(MODE, t, 7); \
        asm volatile("s_waitcnt lgkmcnt(0)" ::: "memory"); __builtin_amdgcn_s_barrier(); asm volatile("" ::: "memory"); \
        sa_cur = (sa_cur == 65536) ? 0 : sa_cur + 32768; sa_nn = (sa_nn == 65536) ? 0 : sa_nn + 32768; } while (0)
    int t = 0;
    if constexpr (epi_mid<EF>::value) {
        for (; t < EF::MIDK; ++t) G2_KTILE(0, t);
#pragma unroll
        for (int mi = 0; mi < 8; ++mi) { const float sc = __shfl(mi < 4 ? rf_mid0 : rf_mid1, (mi & 3) * 16 + fr);
#pragma unroll
            for (int ni = 0; ni < 4; ++ni) acc[mi][ni] *= sc; }
    }
    for (; t < nt - 2; ++t) G2_KTILE(0, t);
    G2_KTILE(1, t); ++t;
    G2_KTILE(2, t);
#undef G2_KTILE
#undef G2_S0
#undef G2_S1
#undef G2_DMA
#undef G2_RDB
#undef G2_RDA
#undef G2_MMA
    epi_pre(E);
    float pfv[3] = {0.f, 0.f, 0.f}; pf.issue(pfv);
    int fr2 = fr, fq2 = fq; asm volatile("" : "+v"(fr2), "+v"(fq2));
    if constexpr (epi_mid<EF>::value) {
#pragma unroll
        for (int mi = 0; mi < 8; ++mi) { const float sc = __shfl(mi < 4 ? rf_end0 : rf_end1, (mi & 3) * 16 + fr2);
#pragma unroll
            for (int ni = 0; ni < 4; ++ni) acc[mi][ni] *= sc; }
    }
    if constexpr (epi_rowstore<EF>::value) { if (E.use_rows(n0)) {
        constexpr int RB = EF::TILE_COLS * 2, RS = RB + 16;
#pragma unroll
        for (int mi = 0; mi < 8; ++mi) { const int rl = wr * 128 + mi * 16 + fr2, row = m0 + rl;
            if constexpr (DUAL) {
#pragma unroll
                for (int ni = 0; ni < 2; ++ni) { const int cl = wc * 32 + ni * 16 + 4 * fq2; *(LAS u32x2*)(lds + rl * RS + cl * 2) = E.pack4d(row, n0 + cl, acc[mi][ni], acc[mi][ni + 2]); }
            } else if constexpr (!epi_prel<EF>::value) {
#pragma unroll
                for (int ni = 0; ni < 4; ++ni) { const int cl = wc * 64 + ni * 16 + 4 * fq2; *(LAS u32x2*)(lds + rl * RS + cl * 2) = E.pack4(row, n0 + cl, acc[mi][ni]); }
            } }
        if constexpr (!DUAL && epi_prel<EF>::value) {
            typename EF::Col cp[4];
#pragma unroll
            for (int ni = 0; ni < 4; ++ni) cp[ni] = E.colpre(n0 + wc * 64 + ni * 16 + 4 * fq2);
#pragma unroll
            for (int mb = 0; mb < 8; mb += EF::PRE_MI) {
                typename EF::Pre pp[EF::PRE_MI][4];
#pragma unroll
                for (int mj = 0; mj < EF::PRE_MI; ++mj)
#pragma unroll
                    for (int ni = 0; ni < 4; ++ni) pp[mj][ni] = E.pre(m0 + wr * 128 + (mb + mj) * 16 + fr2, n0 + wc * 64 + ni * 16 + 4 * fq2);
#pragma unroll
                for (int mj = 0; mj < EF::PRE_MI; ++mj) { const int rl = wr * 128 + (mb + mj) * 16 + fr2;
#pragma unroll
                    for (int ni = 0; ni < 4; ++ni) { const int cl = wc * 64 + ni * 16 + 4 * fq2; *(LAS u32x2*)(lds + rl * RS + cl * 2) = E.pack4p(pp[mj][ni], cp[ni], acc[mb + mj][ni]); } }
            } }
        asm volatile("s_waitcnt lgkmcnt(0)" ::: "memory"); __builtin_amdgcn_s_barrier(); asm volatile("" ::: "memory");
        constexpr int LPR = RB / 16, RPI = 64 / LPR;
#pragma unroll
        for (int it = 0; it < 32 / RPI; ++it) { const int rl = wid * 32 + it * RPI + lane / LPR, ch = lane % LPR;
            const u32x4 w = *(const LAS u32x4*)(lds + rl * RS + ch * 16);
            { bf16_t* gp_ = E.rowptr(m0 + rl, n0) + ch * 8;
              asm volatile("global_store_dwordx4 %0, %1, off sc1\n\ts_nop 1" :: "v"(gp_), "v"(w) : "memory"); }
            if constexpr (epi_rowsq<EF>::value) {
                float ss = bflo(w.x) * bflo(w.x) + bfhi(w.x) * bfhi(w.x) + bflo(w.y) * bflo(w.y) + bfhi(w.y) * bfhi(w.y) + bflo(w.z) * bflo(w.z) + bfhi(w.z) * bfhi(w.z) + bflo(w.w) * bflo(w.w) + bfhi(w.w) * bfhi(w.w);
#pragma unroll
                for (int m = 1; m < LPR; m <<= 1) ss += __shfl_xor(ss, m);
                if (ch == 0) E.rowsq(m0 + rl, n0, ss); } }
        asm volatile("s_waitcnt lgkmcnt(0)" ::: "memory"); __builtin_amdgcn_s_barrier(); asm volatile("" ::: "memory");
        pf.retire(pfv);
        return;
    } }
    if constexpr (DUAL && epi_pred<EF>::value) {
#pragma unroll
        for (int mb = 0; mb < 8; mb += EF::PRED_MI) {
            typename EF::PreD pp[EF::PRED_MI][2];
#pragma unroll
            for (int mj = 0; mj < EF::PRED_MI; ++mj)
#pragma unroll
                for (int ni = 0; ni < 2; ++ni) pp[mj][ni] = E.pred(m0 + wr * 128 + (mb + mj) * 16 + fr2, n0 + wc * 32 + ni * 16 + 4 * fq2);
#pragma unroll
            for (int mj = 0; mj < EF::PRED_MI; ++mj)
#pragma unroll
                for (int ni = 0; ni < 2; ++ni) E.store4dp(pp[mj][ni], m0 + wr * 128 + (mb + mj) * 16 + fr2, n0 + wc * 32 + ni * 16 + 4 * fq2, acc[mb + mj][ni], acc[mb + mj][ni + 2]);
        }
        pf.retire(pfv);
        return;
    }
#pragma unroll
    for (int mi = 0; mi < 8; ++mi) {
        const int row = m0 + wr * 128 + mi * 16 + fr2;
        if constexpr (DUAL) {
#pragma unroll
            for (int ni = 0; ni < 2; ++ni) E.store4d(row, n0 + wc * 32 + ni * 16 + 4 * fq2, acc[mi][ni], acc[mi][ni + 2]);
        } else {
#pragma unroll
            for (int ni = 0; ni < 4; ++ni) E.store4(row, n0 + wc * 64 + ni * 16 + 4 * fq2, acc[mi][ni]);
        }
    }
    pf.retire(pfv);
}


namespace pg8 {
#define PG8_LAS __attribute__((address_space(3)))
typedef unsigned short bf16_t;
typedef short bf16x8 __attribute__((ext_vector_type(8)));
typedef float f32x4 __attribute__((ext_vector_type(4)));
typedef unsigned u32x4 __attribute__((ext_vector_type(4)));
constexpr int BM = 256, BK = 64, HALF = 128, HTB = HALF * BK * 2  , STAGE_BYTES = 8 * HTB, NXCD = 8, WGM = 8;

__host__ __device__ __forceinline__ int lds_byte(int r, int c) { const int st = (r >> 4) * 2 + (c >> 5), rr = r & 15, cc = c & 31, ob = rr * 64 + cc * 2; return st * 1024 + (ob ^ (((ob >> 9) & 1) << 5)); }
__host__ __device__ __forceinline__ void stage_rc(int b, int& R, int& C) { const int st = b / 1024, sb = b % 1024, swz = sb ^ (((sb >> 9) & 1) << 5); R = (st >> 1) * 16 + swz / 64; C = (st & 1) * 32 + (swz % 64) / 2; }
__host__ __device__ __forceinline__ int perm32(int rho) { const int n = rho >> 4, i = rho & 15; return 8 * (i >> 2) + 4 * n + (i & 3); }

struct Unit { int pm, pn; };
struct Gemm { const bf16_t* A; const bf16_t* Bt; int M, N, K; };

struct StaticOrder {
    int nM, nN, nwg, G, c;
    __host__ __device__ void init(int M, int N, int G_, int c_) { nM = M / BM; nN = N / BM; nwg = nM * nN; G = G_; c = c_; }
    __host__ __device__ bool next(int i, Unit& u) const {
        const long L = (long)i * G + c; if (L >= nwg) return false;
        int wgid = (int)L; { const int q = nwg / NXCD, r = nwg % NXCD, xcd = wgid % NXCD, off = wgid / NXCD; wgid = (xcd < r ? xcd * (q + 1) : r * (q + 1) + (xcd - r) * q) + off; }
        const int nig = WGM * nN, gid = wgid / nig, fm = gid * WGM, gsz = (nM - fm) < WGM ? (nM - fm) : WGM;
        u.pm = fm + ((wgid % nig) % gsz); u.pn = (wgid % nig) / gsz; return true;
    }
    __device__ __forceinline__ void a_ready(const Unit&) const {}
    __device__ __forceinline__ void done(const Unit&) const {}
};

template <class Epi, class Sched, bool STAMP = false>
__device__ __forceinline__ void gemm_phase(PG8_LAS unsigned char* lds, const Gemm g, const Sched& S, const Epi& E, unsigned long long* stamps) {
    const int tid = threadIdx.x, wid = __builtin_amdgcn_readfirstlane(tid >> 6), lane = tid & 63, wr = wid >> 2, wc = wid & 3, fr = lane & 15, fq = lane >> 4;
    const int K = g.K, nt = K / BK;
    int ts_lo = 0, ts_hi = 0, nts = 0; const unsigned long long rt_entry = STAMP ? (unsigned long long)wall_clock64() : 0ull;
#define PG8_STAMP() do { if (STAMP && wid == 0 && nts < 64) { const unsigned long long _c = (unsigned long long)clock64(); \
        ts_lo = (lane == nts) ? (int)(unsigned)_c : ts_lo; ts_hi = (lane == nts) ? (int)(unsigned)(_c >> 32) : ts_hi; ++nts; } } while (0)
    PG8_STAMP();
    unsigned voffA[2], voffB[2];
#pragma unroll
    for (int i = 0; i < 2; ++i) { int R, C; stage_rc(tid * 16 + i * 8192, R, C); const int Rb = Epi::PERM ? ((R & ~31) + perm32(R & 31)) : R;
        voffA[i] = (unsigned)(R * K + C) * 2u; voffB[i] = (unsigned)(Rb * K + C) * 2u; }
    const size_t kstep = (size_t)(BK * 2);
    const size_t hstep = (size_t)HALF * K * 2;
    const size_t tstep = 2 * hstep;
    const unsigned ldsw = (unsigned)wid * 1024u;
    const int aoff = lds_byte(wr * 64 + fr, fq * 8), boff = lds_byte(wc * 32 + fr, fq * 8);
#define PG8_SA(b, h) (((b) * 2 + (h)) * HTB)
#define PG8_SB(b, h) ((4 + (b) * 2 + (h)) * HTB)
#define PG8_STAGE(bufoff, gbase, voff) do { _Pragma("unroll") for (int _i = 0; _i < 2; ++_i) \
        __builtin_amdgcn_global_load_lds((const unsigned*)((const char*)(gbase) + (voff)[_i]), (PG8_LAS unsigned*)(lds + (bufoff) + ldsw + _i * 8192), 16, 0, 0); } while (0)
#define PG8_LDA(dst, b, h) do { _Pragma("unroll") for (int m = 0; m < 4; ++m) _Pragma("unroll") for (int k = 0; k < 2; ++k) dst[m][k] = *(const PG8_LAS bf16x8*)(lds + PG8_SA(b, h) + aoff + m * 2048 + k * 1024); } while (0)
#define PG8_LDB(dst, b, h) do { _Pragma("unroll") for (int n = 0; n < 2; ++n) _Pragma("unroll") for (int k = 0; k < 2; ++k) dst[n][k] = *(const PG8_LAS bf16x8*)(lds + PG8_SB(b, h) + boff + n * 2048 + k * 1024); } while (0)
#define PG8_MMA(ai, bj, At, Bt) do { __builtin_amdgcn_s_setprio(1); _Pragma("unroll") for (int m = 0; m < 4; ++m) _Pragma("unroll") for (int n = 0; n < 2; ++n) _Pragma("unroll") for (int k = 0; k < 2; ++k) \
        acc[ai][bj][m][n] = __builtin_amdgcn_mfma_f32_16x16x32_bf16(Bt[n][k], At[m][k], acc[ai][bj][m][n], 0, 0, 0); __builtin_amdgcn_s_setprio(0); } while (0)
#define PG8_WAIT_V(n) asm volatile("s_waitcnt vmcnt(" #n ")" ::: "memory")
#define PG8_WAIT_L(n) asm volatile("s_waitcnt lgkmcnt(" #n ")" ::: "memory")
#define PG8_BAR __builtin_amdgcn_s_barrier()
#define PG8_SCHED __builtin_amdgcn_sched_barrier(0)
    Unit cur, nxt; int ui = 0;
    if (!S.next(0, cur)) return;
    f32x4 acc[2][2][4][2];
#pragma unroll
    for (int a = 0; a < 2; ++a)
#pragma unroll
        for (int b = 0; b < 2; ++b)
#pragma unroll
            for (int m = 0; m < 4; ++m)
#pragma unroll
                for (int n = 0; n < 2; ++n) acc[a][b][m][n] = (f32x4){0.f, 0.f, 0.f, 0.f};
    bf16x8 At[4][2], B0[2][2], B1[2][2];
    const char* cA = (const char*)g.A + (size_t)cur.pm * tstep; const char* cB = (const char*)g.Bt + (size_t)cur.pn * tstep;
    S.a_ready(cur);
    PG8_STAGE(PG8_SB(0, 0), cB, voffB); PG8_STAGE(PG8_SA(0, 0), cA, voffA); PG8_STAGE(PG8_SB(0, 1), cB + hstep, voffB); PG8_STAGE(PG8_SA(0, 1), cA + hstep, voffA);
    if (wr == 1) PG8_BAR;
    PG8_WAIT_V(4); PG8_BAR;
    PG8_STAGE(PG8_SB(1, 0), cB + kstep, voffB); PG8_STAGE(PG8_SA(1, 0), cA + kstep, voffA); PG8_STAGE(PG8_SB(1, 1), cB + hstep + kstep, voffB);
    PG8_WAIT_V(6); PG8_BAR;
    PG8_STAMP();
    for (;;) {
        const bool has_next = S.next(ui + 1, nxt);
        const char* nA = has_next ? (const char*)g.A + (size_t)nxt.pm * tstep : cA; const char* nB = has_next ? (const char*)g.Bt + (size_t)nxt.pn * tstep : cB;
        for (int t = 0; t < nt; t += 2) {
            const bool last = (t == nt - 2);
            const char* a1 = cA + (size_t)(t + 1) * kstep;
            const char* a2 = last ? nA : cA + (size_t)(t + 2) * kstep; const char* b2 = last ? nB : cB + (size_t)(t + 2) * kstep;
            const char* a3 = a2 + kstep; const char* b3 = b2 + kstep;
            if (last && has_next) S.a_ready(nxt);
            PG8_LDB(B0, 0, 0); PG8_SCHED; PG8_LDA(At, 0, 0); PG8_STAGE(PG8_SA(1, 1), a1 + hstep, voffA);
            PG8_WAIT_L(8); PG8_BAR; PG8_WAIT_L(0); PG8_MMA(0, 0, At, B0); PG8_BAR; PG8_SCHED;
            PG8_LDB(B1, 0, 1); PG8_STAGE(PG8_SB(0, 0), b2, voffB);
            PG8_BAR; PG8_WAIT_L(0); PG8_MMA(0, 1, At, B1); PG8_BAR;
            PG8_LDA(At, 0, 1); PG8_STAGE(PG8_SA(0, 0), a2, voffA);
            PG8_BAR; PG8_WAIT_L(0); PG8_MMA(1, 0, At, B0); PG8_BAR; PG8_SCHED;
            PG8_STAGE(PG8_SB(0, 1), b2 + hstep, voffB);
            PG8_WAIT_V(6); PG8_BAR; PG8_MMA(1, 1, At, B1); PG8_BAR;
            PG8_LDB(B0, 1, 0); PG8_SCHED; PG8_LDA(At, 1, 0); PG8_STAGE(PG8_SA(0, 1), a2 + hstep, voffA);
            PG8_WAIT_L(8); PG8_BAR; PG8_WAIT_L(0); PG8_MMA(0, 0, At, B0); PG8_BAR; PG8_SCHED;
            PG8_LDB(B1, 1, 1); PG8_STAGE(PG8_SB(1, 0), b3, voffB);
            PG8_BAR; PG8_WAIT_L(0); PG8_MMA(0, 1, At, B1); PG8_BAR;
            PG8_LDA(At, 1, 1); PG8_STAGE(PG8_SA(1, 0), a3, voffA);
            PG8_BAR; PG8_WAIT_L(0); PG8_MMA(1, 0, At, B0); PG8_BAR; PG8_SCHED;
            PG8_STAGE(PG8_SB(1, 1), b3 + hstep, voffB);
            PG8_WAIT_V(6); PG8_BAR; PG8_MMA(1, 1, At, B1); PG8_BAR;
        }
        PG8_STAMP();
        if constexpr (!Epi::AFTER_DRAIN) { E(acc, cur, wr, wc, fr, fq); S.done(cur); }
        PG8_STAMP();
        if (!has_next) break;
#pragma unroll
        for (int a = 0; a < 2; ++a)
#pragma unroll
            for (int b = 0; b < 2; ++b)
#pragma unroll
                for (int m = 0; m < 4; ++m)
#pragma unroll
                    for (int n = 0; n < 2; ++n) acc[a][b][m][n] = (f32x4){0.f, 0.f, 0.f, 0.f};
        cur = nxt; cA = nA; cB = nB; ++ui;
    }
    PG8_WAIT_V(0);
    if (wr == 0) PG8_BAR;
    PG8_BAR;
    if constexpr (Epi::AFTER_DRAIN) { E.fused(acc, cur, wr, wc, fr, fq, lds, wid, lane); S.done(cur); }
    PG8_STAMP();
    if (STAMP && wid == 0) { stamps[lane] = lane < nts ? (((unsigned long long)(unsigned)ts_hi << 32) | (unsigned)ts_lo) : 0ull;
        if (lane == 62) stamps[62] = rt_entry; if (lane == 63) stamps[63] = (unsigned long long)wall_clock64(); }
#undef PG8_STAMP
#undef PG8_SA
#undef PG8_SB
#undef PG8_STAGE
#undef PG8_LDA
#undef PG8_LDB
#undef PG8_MMA
#undef PG8_WAIT_V
#undef PG8_WAIT_L
#undef PG8_BAR
#undef PG8_SCHED
}
}

template <class EF> struct Pg8Epi { static constexpr bool PERM = false, AFTER_DRAIN = false; EF e;
    __device__ __forceinline__ void operator()(const pg8::f32x4 (&acc)[2][2][4][2], const pg8::Unit& u, int wr, int wc, int fr, int fq) const {
        int fr2 = fr, fq2 = fq; asm volatile("" : "+v"(fr2), "+v"(fq2));
#pragma unroll
        for (int ai = 0; ai < 2; ++ai)
#pragma unroll
            for (int m = 0; m < 4; ++m) { const int row = u.pm * 256 + ai * 128 + wr * 64 + m * 16 + fr2;
#pragma unroll
                for (int bj = 0; bj < 2; ++bj)
#pragma unroll
                    for (int n = 0; n < 2; ++n) e.store4(row, u.pn * 256 + bj * 128 + wc * 32 + n * 16 + 4 * fq2, acc[ai][bj][m][n]); }
    } };
__device__ __forceinline__ int unit_of(const Frame& F, int round) { return (F.G % 8 == 0) ? round * F.G + (F.bid & 7) * (F.G >> 3) + (F.bid >> 3) : round * F.G + F.bid; }
__device__ __forceinline__ void tile_of(int v, int nN, int& pm, int& pn) { const int gid = v >> 5, loc = v & 31, gn = nN >> 2; pm = (gid / gn) * 8 + (loc & 7); pn = (gid % gn) * 4 + (loc >> 3); }

__device__ __forceinline__ void p_inproj_fast(const Frame& F) {
    const ARows A{(const bf16_t*)(F.ws + WS_H1), DM};
    const EpiInProj E{(bf16_t*)(F.ws + WS_UX), (bf16_t*)(F.ws + WS_Q), (bf16_t*)(F.ws + WS_K), (bf16_t*)(F.ws + WS_V)};
    for (int r = 0;; ++r) { const int v = unit_of(F, r); if (v >= 32 * 16) break; int pm, pn; tile_of(v, 16, pm, pn);
        B2Bf16 Bl; Bl.base = (const bf16_t*)(F.ws + WS_WINB) + pn * 256; Bl.ld = DINP;
        gemm_tile2<ARows, B2Bf16, EpiInProj, false>(F.lds, A, Bl, E, pm * 256, pn * 256, DM); }
}
__device__ __forceinline__ void p_glu_fast(const Frame& F) {
    const ARows A{(const bf16_t*)(F.ws + WS_ZB), 1024};
    const EpiGlu E{(const bf16_t*)(F.ws + WS_ZB), F.in[I_BGLU], (bf16_t*)(F.ws + WS_MIX), (float*)(F.ws + WS_SQS)};
    for (int r = 0;; ++r) { const int v = unit_of(F, r); if (v >= 32 * 4) break; int pm, pn; tile_of(v, 4, pm, pn);
        B2Bf16 Bl; Bl.base = (const bf16_t*)(F.ws + WS_WGLUB) + pn * 256; Bl.ld = 1024;
        gemm_tile2<ARows, B2Bf16, EpiGlu, false>(F.lds, A, Bl, E, pm * 256, pn * 256, 1024); }
}
__device__ __forceinline__ void p_outproj_fast(const Frame& F) {
    const ARows A{(const bf16_t*)(F.ws + WS_MIX), DM};
    for (int r = 0;; ++r) { const int v = unit_of(F, r); if (v >= 32 * 8) break; int pm, pn; tile_of(v, 8, pm, pn);
        const EpiOut E{F.in[I_X], F.modp(), (bf16_t*)(F.ws + WS_X1), (const float*)(F.ws + WS_SQS), (const float*)(F.ws + WS_SQA), pm >> 3};
        B2Bf16 Bl; Bl.base = (const bf16_t*)(F.ws + WS_WOUTB) + pn * 256; Bl.ld = DM;
        gemm_tile2<ARows, B2Bf16, EpiOut, false>(F.lds, A, Bl, E, pm * 256, pn * 256, DM);
        if (F.G == 256) {
            asm volatile("s_waitcnt vmcnt(0)" ::: "memory"); __syncthreads();
            if (F.tid == 0) { __hip_atomic_fetch_add((unsigned*)(F.ws + WS_CTL + 25088) + pm * 16, 1u, __ATOMIC_RELAXED, __HIP_MEMORY_SCOPE_AGENT); } } }
}
__device__ __forceinline__ void p_moe1_fast(const Frame& F) {
    constexpr int NU = NE * 22 * 4;
    constexpr unsigned KSPLIT = 1152u;
    const bool split_tail = (F.G == 256);
    AsoPre apre{{0u, 0u, 0u, 0u}, false}, apre_next{{0u, 0u, 0u, 0u}, false};
    for (int r = 0;; ++r) {
        apre = apre_next; apre_next.on = false;
        int v = unit_of(F, r); bool helper = false;
        if (split_tail && r == 5) { helper = (F.bid & 7) >= 4; if (helper) v -= 4 * 32; }
        if (v >= NU) break;
        const int pm = v & 3, pn = (v >> 2) % 22, e = (v >> 2) / 22;
        B2F32Dual Bl; Bl.g = F.in[I_WGATE] + (size_t)e * DM * DFF + pn * 128; Bl.u = F.in[I_WUP] + (size_t)e * DM * DFF + pn * 128; Bl.ld = DFF;
        PfLines pf; pf.on = false; pf.a = nullptr; pf.b0 = nullptr; pf.b1 = nullptr;
        if (split_tail && r < 5) {
            int vn = unit_of(F, r + 1); unsigned kst = 0u; if (r + 1 == 5 && (F.bid & 7) >= 4) { vn -= 4 * 32; kst = KSPLIT; }
            const int pmn = vn & 3, pnn = (vn >> 2) % 22, en = (vn >> 2) / 22;
            const AGather An{(const bf16_t*)(F.ws + WS_H2), (const int*)(F.ws + WS_IDX), en, kst};
            pf.a = An.base + An.off(pmn * 256 + (F.tid >> 1)) + (F.tid & 1) * 64;
#pragma unroll
            for (int p = 0; p < 4; ++p) { const int row = p * 64 + (F.tid >> 3), ch = (F.tid & 7) ^ ((row >> 1) & 7); apre_next.v[p] = (An.off(pmn * 256 + row) + (unsigned)(ch * 8)) * 2u; }
            apre_next.on = true;
            const int id0 = 2 * F.tid, k0 = id0 >> 3, rem0 = id0 & 7;
            const float* bb = ((rem0 >> 2) ? F.in[I_WUP] : F.in[I_WGATE]) + (size_t)en * DM * DFF + (size_t)(kst + k0) * DFF + pnn * 128 + (rem0 & 3) * 32;
            pf.b0 = bb; pf.b1 = bb + 32; pf.on = true; }
        if (split_tail && r == 5) {
            const int pair = v - 5 * 256;
            float* part = (float*)(F.ws + WS_SS) + (size_t)pair * 65536;
            unsigned* flag = (unsigned*)(F.ws + WS_CTL + 16384) + pair * 16; unsigned* tmo = (unsigned*)(F.ws + WS_CTL) + XB_TMO;
            if (helper) {
                const AGather A{(const bf16_t*)(F.ws + WS_H2), (const int*)(F.ws + WS_IDX), e, KSPLIT};
                Bl.g += (size_t)KSPLIT * DFF; Bl.u += (size_t)KSPLIT * DFF;
                const EpiMoe1Part E{part};
                gemm_tile2<AGather, B2F32Dual, EpiMoe1Part, true, 0, NoPf>(F.lds, A, Bl, E, pm * 256, pn * 128, DM - (int)KSPLIT, NoPf(), apre);
                asm volatile("s_waitcnt vmcnt(0)" ::: "memory"); __syncthreads();
                if (F.tid == 0) __hip_atomic_store(flag, 1u, __ATOMIC_RELAXED, __HIP_MEMORY_SCOPE_AGENT);
                { const int v2 = unit_of(F, 0), pn2 = (v2 >> 2) & 7, e2 = v2 >> 5; float tv_[4];
#pragma unroll
                  for (int j = 0; j < 4; ++j) { const int id = F.tid * 4 + j; tv_[j] = (F.in[I_WDOWN] + (size_t)e2 * DFF * DM + (size_t)(id >> 3) * DM + pn2 * 256 + (id & 7) * 32)[0]; }
                  asm volatile("" :: "v"(tv_[0]), "v"(tv_[1]), "v"(tv_[2]), "v"(tv_[3])); }
            } else {
                const AGather A{(const bf16_t*)(F.ws + WS_H2), (const int*)(F.ws + WS_IDX), e, 0u};
                const EpiMoe1Comb E{(bf16_t*)(F.ws + WS_HID) + (size_t)e * 1024 * DFF, part, flag, tmo};
                gemm_tile2<AGather, B2F32Dual, EpiMoe1Comb, true, 0, NoPf>(F.lds, A, Bl, E, pm * 256, pn * 128, (int)KSPLIT, NoPf(), apre);
            }
            break;
        }
        const AGather A{(const bf16_t*)(F.ws + WS_H2), (const int*)(F.ws + WS_IDX), e, 0u};
        const EpiMoe1 E{(bf16_t*)(F.ws + WS_HID) + (size_t)e * 1024 * DFF};
        gemm_tile2<AGather, B2F32Dual, EpiMoe1, true, 0, PfLines>(F.lds, A, Bl, E, pm * 256, pn * 128, DM, pf, apre); }
}
__device__ __forceinline__ void p_moe2_fast(const Frame& F) {
    for (int r = 0;; ++r) { const int v = unit_of(F, r); if (v >= NE * 8 * 4) break; const int pm = v & 3, pn = (v >> 2) & 7, e = v >> 5;
        const ARows A{(const bf16_t*)(F.ws + WS_HID) + (size_t)e * 1024 * DFF, DFF};
        B2F32 Bl; Bl.base = F.in[I_WDOWN] + (size_t)e * DFF * DM + pn * 256; Bl.ld = DM;
        const EpiMoe2 E{(bf16_t*)(F.ws + WS_YE) + (size_t)e * 1024 * DM, (const float*)(F.ws + WS_WAFF), e};
        PfLines pf; pf.on = false; pf.a = nullptr; pf.b0 = nullptr; pf.b1 = nullptr;
        { const int vn = unit_of(F, r + 1);
          if (vn < NE * 8 * 4) { const int pmn = vn & 3, pnn = (vn >> 2) & 7, en = vn >> 5;
            pf.a = (const bf16_t*)(F.ws + WS_HID) + (size_t)en * 1024 * DFF + (size_t)(pmn * 256 + (F.tid >> 1)) * DFF + (F.tid & 1) * 64;
            const int id0 = 2 * F.tid;
            const float* bb = F.in[I_WDOWN] + (size_t)en * DFF * DM + (size_t)(id0 >> 3) * DM + pnn * 256 + (id0 & 7) * 32;
            pf.b0 = bb; pf.b1 = bb + 32; pf.on = true; } }
        gemm_tile2<ARows, B2F32, EpiMoe2, false, 0, PfLines>(F.lds, A, Bl, E, pm * 256, pn * 256, DFF, pf); }
}


__device__ __forceinline__ void p_ssm_prep(const Frame& F, int g, int part, int nparts) {
    float* lam = (float*)F.lds;
    float* bb = lam + 4352;
    float* cc = bb + 4096;
    float* Tt = cc + 4160;
    const int tid = F.tid;
    if (tid < 128) {
        const int dir = tid >> 6, p = tid & 63, pg = dir * 64 + g;
        const double dt = exp((double)F.in[I_LOGDT][pg]);
        const double lr = (double)F.in[I_ARE][pg * 64 + p], li = (double)F.in[I_AIM][pg * 64 + p];
        const double mg = exp(lr * dt), lbr = mg * cos(li * dt), lbi = mg * sin(li * dt);
        double pr = 1.0, pi = 0.0;
        for (int m = 0; m <= 16; ++m) { lam[((dir * 64 + p) * 17 + m) * 2 + 0] = (float)pr; lam[((dir * 64 + p) * 17 + m) * 2 + 1] = (float)pi;
            if (m == 16 && part == 0) { float* LAM = (float*)(F.ws + WS_LAM); LAM[((dir * 64 + g) * 64 + p) * 2 + 0] = (float)pr; LAM[((dir * 64 + g) * 64 + p) * 2 + 1] = (float)pi; }
            const double nr_ = pr * lbr - pi * lbi, ni_ = pr * lbi + pi * lbr; pr = nr_; pi = ni_; }
        const double den = lr * lr + li * li, nr = lbr - 1.0;
        const double fr = (nr * lr + lbi * li) / den, fi = (lbi * lr - nr * li) / den;
        const f32x4* bre = (const f32x4*)(F.in[I_BRE] + (size_t)(pg * 64 + p) * 16); const f32x4* bim = (const f32x4*)(F.in[I_BIM] + (size_t)(pg * 64 + p) * 16);
#pragma unroll
        for (int q = 0; q < 4; ++q) { const f32x4 br4 = bre[q], bi4 = bim[q];
#pragma unroll
            for (int j = 0; j < 4; ++j) { const double br = br4[j], bi = bi4[j]; const int h = q * 4 + j;
                bb[((dir * 64 + p) * 16 + h) * 2 + 0] = (float)(fr * br - fi * bi); bb[((dir * 64 + p) * 16 + h) * 2 + 1] = (float)(fr * bi + fi * br); } }
    }
    for (int i = tid; i < 2048; i += NT) { const int dir = i >> 10, h = (i >> 6) & 15, p = i & 63;
        cc[((dir * 16 + h) * 65 + p) * 2 + 0] = F.in[I_CRE][(size_t)((dir * 64 + g) * 16 + h) * 64 + p]; cc[((dir * 16 + h) * 65 + p) * 2 + 1] = F.in[I_CIM][(size_t)((dir * 64 + g) * 16 + h) * 64 + p]; }
    __syncthreads();
    {
        const int slot = tid >> 4, hp = tid & 15;
        const int dir = slot < 16 ? 1 : 0, m = slot < 16 ? 15 - slot : slot - 16;
        float s[16];
#pragma unroll
        for (int h = 0; h < 16; ++h) s[h] = 0.f;
        for (int p = 0; p < 64; ++p) { const f32x2 c = *(const f32x2*)(cc + ((dir * 16 + hp) * 65 + p) * 2), l = *(const f32x2*)(lam + ((dir * 64 + p) * 17 + m) * 2);
            const float mr = c[0] * l[0] - c[1] * l[1], mi = c[0] * l[1] + c[1] * l[0];
            const f32x4* bp = (const f32x4*)(bb + (dir * 64 + p) * 32);
#pragma unroll
            for (int q = 0; q < 8; ++q) { const f32x4 bv = bp[q]; s[2 * q] += mr * bv[0] - mi * bv[1]; s[2 * q + 1] += mr * bv[2] - mi * bv[3]; } }
        float* red0 = Tt + 31 * 264;
        if (slot == 15) {
#pragma unroll
            for (int h = 0; h < 16; ++h) red0[h * 16 + hp] = s[h]; }
        __syncthreads();
        if (slot != 15) { const int ti = slot < 15 ? slot : slot - 1;
            if (slot == 16) {
#pragma unroll
                for (int h = 0; h < 16; ++h) s[h] += red0[h * 16 + hp] + ((h == hp) ? F.in[I_SSMD][g * 16 + hp] : 0.f); }
#pragma unroll
            for (int h = 0; h < 16; ++h) Tt[ti * 264 + h * 16 + hp] = s[h]; }
    }
    __syncthreads();
    bf16_t* BM = (bf16_t*)(F.ws + WS_BMAT) + (size_t)g * 256 * 256;
    for (int i = part * NT + tid; i < 256 * 32; i += nparts * NT) { const int k = i >> 5, nc = i & 31, j = k >> 4, h = k & 15, dir = nc >> 4, ri = (nc >> 3) & 1, p0 = (nc & 7) * 8, m = dir ? j : 15 - j; float v[8];
#pragma unroll
        for (int q = 0; q < 8; ++q) { const f32x2 l = *(const f32x2*)(lam + ((dir * 64 + p0 + q) * 17 + m) * 2), bv = *(const f32x2*)(bb + ((dir * 64 + p0 + q) * 16 + h) * 2);
            v[q] = ri ? (l[0] * bv[1] + l[1] * bv[0]) : (l[0] * bv[0] - l[1] * bv[1]); }
        u32x4 w; w.x = pack2(v[0], v[1]); w.y = pack2(v[2], v[3]); w.z = pack2(v[4], v[5]); w.w = pack2(v[6], v[7]);
        *(u32x4*)(BM + (size_t)k * 256 + nc * 8) = w; }
    bf16_t* KC = (bf16_t*)(F.ws + WS_KCMAT) + (size_t)g * 512 * 256;
    for (int i = part * NT + tid; i < 512 * 32; i += nparts * NT) { const int k = i >> 5, nc = i & 31, ii = nc >> 1, hp0 = (nc & 1) * 8; float v[8];
        if (k < 256) { const int j = k >> 4, h = k & 15; const f32x4* tp = (const f32x4*)(Tt + (ii - j + 15) * 264 + h * 16 + hp0); const f32x4 t0 = tp[0], t1 = tp[1];
            v[0] = t0[0]; v[1] = t0[1]; v[2] = t0[2]; v[3] = t0[3]; v[4] = t1[0]; v[5] = t1[1]; v[6] = t1[2]; v[7] = t1[3]; }
        else { const int kk = k - 256, dir = kk >> 7, ri = (kk >> 6) & 1, p = kk & 63, m = dir ? 16 - ii : ii + 1; const f32x2 l = *(const f32x2*)(lam + ((dir * 64 + p) * 17 + m) * 2);
#pragma unroll
            for (int q = 0; q < 8; ++q) { const f32x2 c = *(const f32x2*)(cc + ((dir * 16 + hp0 + q) * 65 + p) * 2); v[q] = ri ? -(c[0] * l[1] + c[1] * l[0]) : (c[0] * l[0] - c[1] * l[1]); } }
        u32x4 w; w.x = pack2(v[0], v[1]); w.y = pack2(v[2], v[3]); w.z = pack2(v[4], v[5]); w.w = pack2(v[6], v[7]);
        *(u32x4*)(KC + (size_t)k * 256 + nc * 8) = w; }
    __syncthreads();
}
struct EpiS { float* SS;
    __device__ __forceinline__ void store4(int r, int n, f32x4 v) const { *(f32x4*)(SS + (size_t)r * 256 + n) = v; } };
struct EpiSLds { LAS unsigned char* img;
    static constexpr int RS = 528;
    __device__ __forceinline__ void store4(int r, int n, f32x4 v) const { u32x2 w; w.x = pack2(v[0], v[1]); w.y = pack2(v[2], v[3]); *(LAS u32x2*)(img + (r & 255) * RS + n * 2) = w; } };
struct EpiY { bf16_t* ZB; int g;
    __device__ __forceinline__ void store4(int r, int n, f32x4 v) const { const int b = r >> 7, c = r & 127, i = n >> 4, hp = n & 15; const size_t t = (size_t)b * SEQ + c * 16 + i;
        const f32x2 ya_ = gelu_tanh_2((f32x2){v[0], v[1]}), yb_ = gelu_tanh_2((f32x2){v[2], v[3]}); u32x2 w; w.x = pack2(ya_[0], ya_[1]); w.y = pack2(yb_[0], yb_[1]); st8_wt(ZB + t * 1024 + g * 16 + hp, w); } };
__device__ __forceinline__ void p_ssm_sgemm(const Frame& F) {
    for (int r = 0;; ++r) { const int v = unit_of(F, r); if (v >= 128) break; const int g = v >> 1, pm = v & 1;
        const ARows A{(const bf16_t*)(F.ws + WS_UX) + (size_t)g * 512 * 512, 512};
        B2Bf16 Bl; Bl.base = (const bf16_t*)(F.ws + WS_BMAT) + (size_t)g * 256 * 256; Bl.ld = 256;
        const EpiS E{(float*)(F.ws + WS_SS) + (size_t)g * 512 * 256};
        gemm_tile2<ARows, B2Bf16, EpiS, false>(F.lds, A, Bl, E, pm * 256, 0, 256); }
}
__device__ __forceinline__ void p_ssm_ygemm(const Frame& F) {
    for (int r = 0;; ++r) { const int v = unit_of(F, r); if (v >= 128) break; const int g = v >> 1, pm = v & 1;
        const ARows A{(const bf16_t*)(F.ws + WS_UX) + (size_t)g * 512 * 512, 512};
        B2Bf16 Bl; Bl.base = (const bf16_t*)(F.ws + WS_KCMAT) + (size_t)g * 512 * 256; Bl.ld = 256;
        const EpiY E{(bf16_t*)(F.ws + WS_ZB), g};
        gemm_tile2<ARows, B2Bf16, EpiY, false>(F.lds, A, Bl, E, pm * 256, 0, 512); }
}
__device__ __forceinline__ void p_ssm_scan(const Frame& F) {
    const float* SS = (const float*)(F.ws + WS_SS); bf16_t* UX = (bf16_t*)(F.ws + WS_UX); const float* LAM = (const float*)(F.ws + WS_LAM);
    for (int w = F.bid + F.G * F.wave; w < NG * NB * 2; w += F.G * 8) {
        const int dir = w & 1, b = (w >> 1) & 3, g = w >> 3, p = F.lane;
        const float l16r = LAM[((dir * 64 + g) * 64 + p) * 2], l16i = LAM[((dir * 64 + g) * 64 + p) * 2 + 1];
        float xr = 0.f, xi = 0.f;
        for (int c0 = 0; c0 < 128; c0 += 8) {
            float sr[8], si[8];
#pragma unroll
            for (int q = 0; q < 8; ++q) { const int c = dir ? 127 - (c0 + q) : c0 + q; const float* sp = SS + ((size_t)g * 512 + b * 128 + c) * 256 + dir * 128 + p; sr[q] = sp[0]; si[q] = sp[64]; }
#pragma unroll
            for (int q = 0; q < 8; ++q) { const int c = dir ? 127 - (c0 + q) : c0 + q; bf16_t* xp = UX + ((size_t)g * 512 + b * 128 + c) * 512 + 256 + dir * 128 + p;
                xp[0] = f2bf(xr); xp[64] = f2bf(xi);
                const float nr = l16r * xr - l16i * xi + sr[q], ni = l16r * xi + l16i * xr + si[q]; xr = nr; xi = ni; }
        }
    }
}


struct AttnStage { u32x4 vv[9], kv[9]; bf16x8 q0, q1; float rpv; };
__device__ __forceinline__ void attn_prefetch(const Frame& F, int pu, AttnStage& st) {
    const bf16_t* Kb = (const bf16_t*)(F.ws + WS_K); const bf16_t* Vb = (const bf16_t*)(F.ws + WS_V);
    const int b = pu >> 8, h = (pu >> 4) & 15, i2 = pu & 15, r0 = 2 * i2;
    int rs0 = r0 - 4; rs0 = rs0 < 0 ? 0 : (rs0 > 24 ? 24 : rs0);
    const int base = rs0 < 23 ? rs0 : 23;
#pragma unroll
    for (int i = 0; i < 9; ++i) { const int c = F.tid + i * NT, key = c >> 3, chunk = c & 7; const size_t go = (size_t)(b * SEQ + base * 64 + key) * 1024 + h * 64 + chunk * 8;
        st.vv[i] = *(const u32x4*)(Vb + go); st.kv[i] = *(const u32x4*)(Kb + go); }
    { const int r = r0 + (F.wave >> 2), wq = 16 * (F.wave & 3) + (F.lane & 15);
      const bf16_t* qp = (const bf16_t*)(F.ws + WS_Q) + (size_t)(b * SEQ + r * 64 + wq) * 1024 + h * 64 + 8 * (F.lane >> 4);
      st.q0 = *(const bf16x8*)qp; st.q1 = *(const bf16x8*)(qp + 32); }
    st.rpv = (F.tid < 465) ? F.in[I_RPB][h * 465 + F.tid] : 0.f;
}
__device__ __forceinline__ void attn_pair_unit(const Frame& F, int pu, int pu_next, AttnStage& st) {
    LAS unsigned char* lds = (LAS unsigned char*)F.lds;
    LAS float* rp = (LAS float*)(lds + 147456);
    const bf16_t* Q = (const bf16_t*)(F.ws + WS_Q); const bf16_t* Kb = (const bf16_t*)(F.ws + WS_K); const bf16_t* Vb = (const bf16_t*)(F.ws + WS_V);
    bf16_t* Y = (bf16_t*)(F.ws + WS_MIX) + 1024; float* SQA = (float*)(F.ws + WS_SQA); const float* rpb = F.in[I_RPB];
    const int lane = F.lane, wave = F.wave, q = lane & 15, G = lane >> 4;
    {
        const int b = pu >> 8, h = (pu >> 4) & 15, i2 = pu & 15, r0 = 2 * i2;
        int rs0 = r0 - 4; rs0 = rs0 < 0 ? 0 : (rs0 > 24 ? 24 : rs0);
        const int base = rs0 < 23 ? rs0 : 23;
        {
#pragma unroll
          for (int i = 0; i < 9; ++i) { const int c = F.tid + i * NT, key = c >> 3, chunk = c & 7;
              *(LAS u32x4*)(lds + key * 128 + (((((chunk >> 1) ^ ((key >> 1) & 3)) << 1) | (chunk & 1)) << 4)) = st.vv[i];
              *(LAS u32x4*)(lds + 73728 + key * 128 + ((chunk ^ ((key >> 1) & 7)) << 4)) = st.kv[i]; } }
        if (F.tid < 465) rp[(F.tid / 31) * 32 + (F.tid % 31)] = st.rpv * 1.44269504088896f; else if (F.tid >= 480 && F.tid < 495) rp[(F.tid - 480) * 32 + 31] = -1e30f;
        const bf16x8 qf0 = st.q0, qf1 = st.q1;
        __syncthreads();
        {
            const int r = r0 + (wave >> 2), qb = wave & 3;
            int rs = r - 4; rs = rs < 0 ? 0 : (rs > 24 ? 24 : rs);
            const int c0 = (qb == 0) ? 0 : (qb == 1) ? 8 : (qb == 2) ? 24 : 32;
            const int wq = 16 * qb + q;
            int cs = wq - 8; cs = cs < 0 ? 0 : (cs > 48 ? 48 : cs);
            const LAS float* rpl = rp + (rs - r + 7) * 32;
            int bo[2][4];
#pragma unroll
            for (int hf = 0; hf < 2; ++hf)
#pragma unroll
                for (int e = 0; e < 4; ++e) { const int wk = c0 + 16 * hf + 4 * G + e; const bool valid = (wk >= cs) && (wk < cs + 16); bo[hf][e] = valid ? wk - wq + 15 : 31; }
            f32x4 s[16];
            bf16x8 k0r[4], k1r[4]; f32x4 bir[4];
#define QK_LOAD(t_) do { const int kk_ = (rs + ((t_) >> 1) - base) * 64 + c0 + 16 * ((t_) & 1) + q;         \
                k0r[(t_) & 3] = *(const LAS bf16x8*)(lds + 73728 + kk_ * 128 + ((G ^ ((kk_ >> 1) & 7)) << 4)); k1r[(t_) & 3] = *(const LAS bf16x8*)(lds + 73728 + kk_ * 128 + (((4 + G) ^ ((kk_ >> 1) & 7)) << 4)); \
                bir[(t_) & 3] = (f32x4){rpl[((t_) >> 1) * 32 + bo[(t_) & 1][0]], rpl[((t_) >> 1) * 32 + bo[(t_) & 1][1]], rpl[((t_) >> 1) * 32 + bo[(t_) & 1][2]], rpl[((t_) >> 1) * 32 + bo[(t_) & 1][3]]}; } while (0)
            QK_LOAD(0); QK_LOAD(1); QK_LOAD(2);
            __builtin_amdgcn_sched_barrier(0);
#pragma unroll
            for (int t = 0; t < 16; ++t) {
                if (t + 3 < 16) QK_LOAD(t + 3);
                f32x4 a = bir[t & 3];
                a = __builtin_amdgcn_mfma_f32_16x16x32_bf16(k0r[t & 3], qf0, a, 0, 0, 0);
                a = __builtin_amdgcn_mfma_f32_16x16x32_bf16(k1r[t & 3], qf1, a, 0, 0, 0);
                s[t] = a;
                __builtin_amdgcn_sched_barrier(0);
            }
#undef QK_LOAD
            __builtin_amdgcn_sched_barrier(0);
            if (pu_next >= 0) attn_prefetch(F, pu_next, st);
            __builtin_amdgcn_sched_barrier(0);
            float mx = -1e30f;
#pragma unroll
            for (int t = 0; t < 16; ++t) mx = fmaxf(fmaxf(mx, fmaxf(s[t][0], s[t][1])), fmaxf(s[t][2], s[t][3]));
            mx = fmaxf(mx, __shfl_xor(mx, 16)); mx = fmaxf(mx, __shfl_xor(mx, 32));
            float lsum = 0.f;
#pragma unroll
            for (int t = 0; t < 16; ++t)
#pragma unroll
                for (int e = 0; e < 4; ++e) { const float p = __builtin_amdgcn_exp2f(s[t][e] - mx); s[t][e] = p; lsum += p; }
            lsum += __shfl_xor(lsum, 16); lsum += __shfl_xor(lsum, 32);
            f32x4 o[4];
#pragma unroll
            for (int dt = 0; dt < 4; ++dt) o[dt] = (f32x4){0.f, 0.f, 0.f, 0.f};
            s16x4 vlo[4], vhi[4];
#define PV_LOAD(i_) do { const int keyA_ = (rs + ((i_) >> 2) - base) * 64 + c0 + 4 * G + (q >> 2), keyB_ = keyA_ + 16; \
                const int aA_ = keyA_ * 128 + ((((i_) & 3) ^ ((keyA_ >> 1) & 3)) << 5) + 8 * (q & 3), aB_ = keyB_ * 128 + ((((i_) & 3) ^ ((keyB_ >> 1) & 3)) << 5) + 8 * (q & 3); \
                vlo[(i_) & 3] = __builtin_amdgcn_ds_read_tr16_b64_v4i16((LAS s16x4*)(lds + aA_)); vhi[(i_) & 3] = __builtin_amdgcn_ds_read_tr16_b64_v4i16((LAS s16x4*)(lds + aB_)); } while (0)
            PV_LOAD(0); PV_LOAD(1); PV_LOAD(2);
            __builtin_amdgcn_sched_barrier(0);
            union { bf16x8 v; unsigned u[4]; } pf;
#pragma unroll
            for (int i = 0; i < 32; ++i) { const int kk = i >> 2, dt = i & 3;
                if (i + 3 < 32) PV_LOAD(i + 3);
                if (dt == 0) { pf.u[0] = pack2(s[2 * kk][0], s[2 * kk][1]); pf.u[1] = pack2(s[2 * kk][2], s[2 * kk][3]);
                    pf.u[2] = pack2(s[2 * kk + 1][0], s[2 * kk + 1][1]); pf.u[3] = pack2(s[2 * kk + 1][2], s[2 * kk + 1][3]); }
                const bf16x8 vf = (bf16x8){vlo[i & 3][0], vlo[i & 3][1], vlo[i & 3][2], vlo[i & 3][3], vhi[i & 3][0], vhi[i & 3][1], vhi[i & 3][2], vhi[i & 3][3]};
                o[dt] = __builtin_amdgcn_mfma_f32_16x16x32_bf16(vf, pf.v, o[dt], 0, 0, 0);
                __builtin_amdgcn_sched_barrier(0);
            }
#undef PV_LOAD
            const float inv = 1.0f / lsum;
            bf16_t* yp = Y + (size_t)(b * SEQ + r * 64 + wq) * DM + h * 64 + 4 * G;
            float ssq = 0.f;
#pragma unroll
            for (int dt = 0; dt < 4; ++dt) { u32x2 w; w.x = pack2(o[dt][0] * inv, o[dt][1] * inv); w.y = pack2(o[dt][2] * inv, o[dt][3] * inv); *(u32x2*)(yp + 16 * dt) = w;
                ssq += bflo(w.x) * bflo(w.x) + bfhi(w.x) * bfhi(w.x) + bflo(w.y) * bflo(w.y) + bfhi(w.y) * bfhi(w.y); }
            ssq += __shfl_xor(ssq, 16); ssq += __shfl_xor(ssq, 32);
            if (G == 0) SQA[(size_t)(b * SEQ + r * 64 + wq) * 16 + h] = ssq;
        }
        __syncthreads();
    }
}

__device__ __forceinline__ void attn_units(const Frame& F, int first, int step, int end) {
    if (first >= end) return;
    AttnStage st; attn_prefetch(F, first, st);
    for (int pu = first; pu < end; pu += step) attn_pair_unit(F, pu, (pu + step < end) ? pu + step : -1, st);
}
__device__ __forceinline__ void p_attn_fast(const Frame& F) { attn_units(F, F.bid, F.G, NB * NH * 16); }

__device__ __forceinline__ void ssm_scan_half(const Frame& F, int g, int pm) {
    if (F.wave >= 4) return;
    const float* SS = (const float*)(F.ws + WS_SS); bf16_t* UX = (bf16_t*)(F.ws + WS_UX); const float* LAM = (const float*)(F.ws + WS_LAM);
    const int dir = F.wave & 1, b = 2 * pm + (F.wave >> 1), p = F.lane;
    const float l16r = LAM[((dir * 64 + g) * 64 + p) * 2], l16i = LAM[((dir * 64 + g) * 64 + p) * 2 + 1];
    float xr = 0.f, xi = 0.f;
    for (int c0 = 0; c0 < 128; c0 += 32) {
        float sr[32], si[32];
#pragma unroll
        for (int q = 0; q < 32; ++q) { const int c = dir ? 127 - (c0 + q) : c0 + q; const float* sp = SS + ((size_t)g * 512 + b * 128 + c) * 256 + dir * 128 + p;
            sr[q] = __hip_atomic_load(sp, __ATOMIC_RELAXED, __HIP_MEMORY_SCOPE_AGENT); si[q] = __hip_atomic_load(sp + 64, __ATOMIC_RELAXED, __HIP_MEMORY_SCOPE_AGENT); }
#pragma unroll
        for (int q = 0; q < 32; ++q) { const int c = dir ? 127 - (c0 + q) : c0 + q; bf16_t* xp = UX + ((size_t)g * 512 + b * 128 + c) * 512 + 256 + dir * 128 + p;
            xp[0] = f2bf(xr); xp[64] = f2bf(xi);
            const float nr = l16r * xr - l16i * xi + sr[q], ni = l16r * xi + l16i * xr + si[q]; xr = nr; xi = ni; }
    }
}
__device__ __forceinline__ void ssm_scan_half_lds(const Frame& F, int g, int pm) {
    if (F.wave >= 4) return;
    const LAS unsigned char* img = (const LAS unsigned char*)F.lds; bf16_t* UX = (bf16_t*)(F.ws + WS_UX); const float* LAM = (const float*)(F.ws + WS_LAM);
    const int dir = F.wave & 1, bl = F.wave >> 1, b = 2 * pm + bl, p = F.lane;
    const float l16r = LAM[((dir * 64 + g) * 64 + p) * 2], l16i = LAM[((dir * 64 + g) * 64 + p) * 2 + 1];
    float xr = 0.f, xi = 0.f;
#pragma unroll 16
    for (int q = 0; q < 128; ++q) { const int c = dir ? 127 - q : q;
        const LAS bf16_t* sp = (const LAS bf16_t*)(img + (bl * 128 + c) * EpiSLds::RS + (dir * 128 + p) * 2);
        const float sr = bf2f(sp[0]), si = bf2f(sp[64]);
        bf16_t* xp = UX + ((size_t)g * 512 + b * 128 + c) * 512 + 256 + dir * 128 + p;
        xp[0] = f2bf(xr); xp[64] = f2bf(xi);
        const float nr = l16r * xr - l16i * xi + sr, ni = l16r * xi + l16i * xr + si; xr = nr; xi = ni; }
}
__device__ __forceinline__ void touch_x_tile(const Frame& F) {
    int pm_, pn_; tile_of(unit_of(F, 0), 8, pm_, pn_);
    const float* xb = F.in[I_X] + (size_t)pm_ * 256 * DM + pn_ * 256;
    float t0_ = xb[(size_t)((F.tid) >> 3) * DM + (F.tid & 7) * 32], t1_ = xb[(size_t)((F.tid + 512) >> 3) * DM + (F.tid & 7) * 32],
          t2_ = xb[(size_t)((F.tid + 1024) >> 3) * DM + (F.tid & 7) * 32], t3_ = xb[(size_t)((F.tid + 1536) >> 3) * DM + (F.tid & 7) * 32];
    const bf16_t* wb = (const bf16_t*)(F.ws + WS_WOUTB) + pn_ * 256;
    float t4_ = *(const float*)(wb + (size_t)(F.tid >> 2) * DM + (F.tid & 3) * 64), t5_ = *(const float*)(wb + (size_t)(128 + (F.tid >> 2)) * DM + (F.tid & 3) * 64);
    asm volatile("" :: "v"(t0_), "v"(t1_), "v"(t2_), "v"(t3_), "v"(t4_), "v"(t5_));
}
__device__ __forceinline__ void p_mixer(const Frame& F) {
    for (int u = F.bid; u < 2 * NG; u += F.G) { const int g = u >> 1, pm = u & 1;
        const ARows A{(const bf16_t*)(F.ws + WS_UX) + (size_t)g * 512 * 512, 512};
        { B2Bf16 Bl; Bl.base = (const bf16_t*)(F.ws + WS_BMAT) + (size_t)g * 256 * 256; Bl.ld = 256; const EpiSLds E{(LAS unsigned char*)F.lds};
          gemm_tile2<ARows, B2Bf16, EpiSLds, false>(F.lds, A, Bl, E, pm * 256, 0, 256); }
        __syncthreads();
        ssm_scan_half_lds(F, g, pm);
        asm volatile("s_waitcnt vmcnt(0)" ::: "memory"); __syncthreads();
        { B2Bf16 Bl; Bl.base = (const bf16_t*)(F.ws + WS_KCMAT) + (size_t)g * 512 * 256; Bl.ld = 256; const EpiY E{(bf16_t*)(F.ws + WS_ZB), g};
          gemm_tile2<ARows, B2Bf16, EpiY, false>(F.lds, A, Bl, E, pm * 256, 0, 512); }
        __syncthreads();
    }
    if (F.G == 256) {
        if (F.bid < 128) {
            unsigned* ycnt = (unsigned*)(F.ws + WS_CTL + 24576);
            unsigned* tmo = (unsigned*)(F.ws + WS_CTL) + XB_TMO;
            asm volatile("s_waitcnt vmcnt(0)" ::: "memory"); __syncthreads();
            if (F.tid == 0) {
                __hip_atomic_fetch_add(ycnt, 1u, __ATOMIC_RELAXED, __HIP_MEMORY_SCOPE_AGENT);
                unsigned sp = 0;
                while (__hip_atomic_load(ycnt, __ATOMIC_RELAXED, __HIP_MEMORY_SCOPE_AGENT) < 128u) { __builtin_amdgcn_s_sleep(2);
                    if ((++sp & 255u) == 0u) { if (__hip_atomic_load(tmo, __ATOMIC_RELAXED, __HIP_MEMORY_SCOPE_AGENT)) break; if (sp > (1u << 20)) { atomicAdd(tmo, 1u); break; } } }
                __builtin_amdgcn_fence(__ATOMIC_ACQUIRE, "agent"); asm volatile("s_waitcnt vmcnt(0)" ::: "memory");
            }
            __syncthreads();
            const ARows A{(const bf16_t*)(F.ws + WS_ZB), 1024};
            const EpiGlu E{(const bf16_t*)(F.ws + WS_ZB), F.in[I_BGLU], (bf16_t*)(F.ws + WS_MIX), (float*)(F.ws + WS_SQS)};
            int pm, pn; tile_of(F.bid, 4, pm, pn);
            B2Bf16 Bl; Bl.base = (const bf16_t*)(F.ws + WS_WGLUB) + pn * 256; Bl.ld = 1024;
            gemm_tile2<ARows, B2Bf16, EpiGlu, false>(F.lds, A, Bl, E, pm * 256, pn * 256, 1024);
        }
        else { attn_units(F, F.bid - 128, 128, NB * NH * 16);
            touch_x_tile(F); }
    } else attn_units(F, F.bid, F.G, NB * NH * 16);
}


#ifndef PROBE_ABL
#define PROBE_ABL -1
#endif
#ifndef PROBE_X
#define PROBE_X 0
#endif
__device__ __forceinline__ void p_moe1_probe(const Frame& F) {
#if PROBE_ABL >= 0
    for (int r = 0;; ++r) { const int v = unit_of(F, r); if (v >= NE * 22 * 4) break; const int pm = v & 3, pn = (v >> 2) % 22, e = (v >> 2) / 22;
        const AGather A{(const bf16_t*)(F.ws + WS_H2), (const int*)(F.ws + WS_IDX), e, 0u};
        B2F32Dual Bl; Bl.g = F.in[I_WGATE] + (size_t)e * DM * DFF + pn * 128; Bl.u = F.in[I_WUP] + (size_t)e * DM * DFF + pn * 128; Bl.ld = DFF;
        const EpiMoe1 E{(bf16_t*)(F.ws + WS_HID) + (size_t)e * 1024 * DFF};
        gemm_tile2<AGather, B2F32Dual, EpiMoe1, true, PROBE_ABL>(F.lds, A, Bl, E, pm * 256, pn * 128, DM); }
#endif
}
__device__ __forceinline__ void p_ssm_naive(const Frame& F) {
    if (F.wave != 0) return;
    const bf16_t* UX = (const bf16_t*)(F.ws + WS_UX); float* ybuf = (float*)(F.ws + WS_SS); bf16_t* ZB = (bf16_t*)(F.ws + WS_ZB);
    const int lane = F.lane;
    for (int u = F.bid; u < NB * NG; u += F.G) {
        const int b = u >> 6, g = u & 63;
        for (int dir = 0; dir < 2; ++dir) {
            const int pg = dir * 64 + g;
            const float dt = expf(F.in[I_LOGDT][pg]);
            const float lr = F.in[I_ARE][pg * 64 + lane], li = F.in[I_AIM][pg * 64 + lane];
            const float mag = expf(lr * dt); const float lbr = mag * cosf(li * dt), lbi = mag * sinf(li * dt);
            const float den = lr * lr + li * li, nr = lbr - 1.0f;
            const float fr = (nr * lr + lbi * li) / den, fi = (lbi * lr - nr * li) / den;
            float bbr[16], bbi[16], cr[16], ci[16];
#pragma unroll
            for (int h = 0; h < 16; ++h) { const float br = F.in[I_BRE][(size_t)(pg * 64 + lane) * 16 + h], bi = F.in[I_BIM][(size_t)(pg * 64 + lane) * 16 + h];
                bbr[h] = fr * br - fi * bi; bbi[h] = fr * bi + fi * br;
                cr[h] = F.in[I_CRE][(size_t)(pg * 16 + h) * 64 + lane]; ci[h] = F.in[I_CIM][(size_t)(pg * 16 + h) * 64 + lane]; }
            const float dsk = F.in[I_SSMD][g * 16 + (lane & 15)];
            float xr = 0.f, xi = 0.f;
            for (int s = 0; s < SEQ; ++s) {
                const int l = dir ? (SEQ - 1 - s) : s;
                const bf16_t* up = UX + (size_t)(g * 512 + b * 128 + (l >> 4)) * 512 + (l & 15) * 16;
                const float uval = bf2f(up[lane & 15]);
                float bur = 0.f, bui = 0.f;
#pragma unroll
                for (int h = 0; h < 16; ++h) { const float uh = __shfl(uval, h); bur += bbr[h] * uh; bui += bbi[h] * uh; }
                const float nxr = lbr * xr - lbi * xi + bur, nxi = lbr * xi + lbi * xr + bui; xr = nxr; xi = nxi;
                float myy = 0.f;
#pragma unroll
                for (int h = 0; h < 16; ++h) { const float v = wave_sum(cr[h] * xr - ci[h] * xi); if (lane == h) myy = v; }
                const size_t o = (size_t)(b * SEQ + l) * 1024 + g * 16;
                if (lane < 16) {
                    if (dir == 0) ybuf[o + lane] = myy;
                    else { const float y = ybuf[o + lane] + myy + dsk * uval; ZB[o + lane] = f2bf(gelu_tanh(y)); }
                }
            }
        }
    }
}

__device__ __forceinline__ void p_attn_naive(const Frame& F) {
    const bf16_t* Q = (const bf16_t*)(F.ws + WS_Q); const bf16_t* Kb = (const bf16_t*)(F.ws + WS_K); const bf16_t* Vb = (const bf16_t*)(F.ws + WS_V);
    bf16_t* Y = (bf16_t*)(F.ws + WS_YATT); const float* rpb = F.in[I_RPB];
    for (int id = F.bid * NT + F.tid; id < TOK * NH; id += F.G * NT) {
        const int t = id >> 4, h = id & 15, b = t >> 11, l = t & 2047, r = l >> 6, w = l & 63;
        int rs = r - 4; rs = rs < 0 ? 0 : (rs > 24 ? 24 : rs);
        int cs = w - 8; cs = cs < 0 ? 0 : (cs > 48 ? 48 : cs);
        float q[64], acc[64];
        const u32x4* qp = (const u32x4*)(Q + (size_t)t * 1024 + h * 64);
#pragma unroll
        for (int i = 0; i < 8; ++i) { const u32x4 v = qp[i]; q[i * 8 + 0] = bflo(v.x); q[i * 8 + 1] = bfhi(v.x); q[i * 8 + 2] = bflo(v.y); q[i * 8 + 3] = bfhi(v.y);
            q[i * 8 + 4] = bflo(v.z); q[i * 8 + 5] = bfhi(v.z); q[i * 8 + 6] = bflo(v.w); q[i * 8 + 7] = bfhi(v.w); }
#pragma unroll
        for (int d = 0; d < 64; ++d) acc[d] = 0.f;
        float m = -1e30f, lsum = 0.f;
        for (int j = 0; j < 8; ++j) {
            const int kr = rs + j, dr = kr - r + 7;
            for (int kk = 0; kk < 16; ++kk) {
                const int wk = cs + kk, dc = wk - w + 15;
                const size_t kt = (size_t)(b * SEQ + kr * 64 + wk) * 1024 + h * 64;
                const u32x4* kp = (const u32x4*)(Kb + kt);
                float s = 0.f;
#pragma unroll
                for (int i = 0; i < 8; ++i) { const u32x4 v = kp[i];
                    s += q[i * 8 + 0] * bflo(v.x) + q[i * 8 + 1] * bfhi(v.x) + q[i * 8 + 2] * bflo(v.y) + q[i * 8 + 3] * bfhi(v.y)
                       + q[i * 8 + 4] * bflo(v.z) + q[i * 8 + 5] * bfhi(v.z) + q[i * 8 + 6] * bflo(v.w) + q[i * 8 + 7] * bfhi(v.w); }
                s += rpb[(h * 15 + dr) * 31 + dc];
                const float mn = fmaxf(m, s); const float corr = __expf(m - mn), p = __expf(s - mn);
                lsum = lsum * corr + p; m = mn;
                const u32x4* vp = (const u32x4*)(Vb + kt);
#pragma unroll
                for (int i = 0; i < 8; ++i) { const u32x4 v = vp[i];
                    acc[i * 8 + 0] = acc[i * 8 + 0] * corr + p * bflo(v.x); acc[i * 8 + 1] = acc[i * 8 + 1] * corr + p * bfhi(v.x);
                    acc[i * 8 + 2] = acc[i * 8 + 2] * corr + p * bflo(v.y); acc[i * 8 + 3] = acc[i * 8 + 3] * corr + p * bfhi(v.y);
                    acc[i * 8 + 4] = acc[i * 8 + 4] * corr + p * bflo(v.z); acc[i * 8 + 5] = acc[i * 8 + 5] * corr + p * bfhi(v.z);
                    acc[i * 8 + 6] = acc[i * 8 + 6] * corr + p * bflo(v.w); acc[i * 8 + 7] = acc[i * 8 + 7] * corr + p * bfhi(v.w); }
            }
        }
        const float inv = 1.0f / lsum;
        u32x4* yp = (u32x4*)(Y + (size_t)t * 1024 + h * 64);
#pragma unroll
        for (int i = 0; i < 8; ++i) { u32x4 o; o.x = pack2(acc[i * 8 + 0] * inv, acc[i * 8 + 1] * inv); o.y = pack2(acc[i * 8 + 2] * inv, acc[i * 8 + 3] * inv);
            o.z = pack2(acc[i * 8 + 4] * inv, acc[i * 8 + 5] * inv); o.w = pack2(acc[i * 8 + 6] * inv, acc[i * 8 + 7] * inv); yp[i] = o; }
    }
}

__device__ __forceinline__ void p_normcat(const Frame& F) {
    const bf16_t* YS = (const bf16_t*)(F.ws + WS_YSSM); const bf16_t* YA = (const bf16_t*)(F.ws + WS_YATT); bf16_t* MIX = (bf16_t*)(F.ws + WS_MIX);
    const int step = F.G * 8; int t = F.bid * 8 + F.wave;
    u32x4 nw[2][2];
    if (t < TOK) {
#pragma unroll
        for (int half = 0; half < 2; ++half)
#pragma unroll
            for (int i = 0; i < 2; ++i) nw[half][i] = *(const u32x4*)((half ? YA : YS) + (size_t)t * 1024 + i * 512 + F.lane * 8); }
    for (; t < TOK; t += step) {
        u32x4 cw[2][2];
#pragma unroll
        for (int half = 0; half < 2; ++half)
#pragma unroll
            for (int i = 0; i < 2; ++i) cw[half][i] = nw[half][i];
        if (t + step < TOK) {
#pragma unroll
            for (int half = 0; half < 2; ++half)
#pragma unroll
                for (int i = 0; i < 2; ++i) nw[half][i] = *(const u32x4*)((half ? YA : YS) + (size_t)(t + step) * 1024 + i * 512 + F.lane * 8); }
#pragma unroll
        for (int half = 0; half < 2; ++half) {
            const float* g = F.in[half ? I_GATT : I_GSSM];
            float v[16]; float ss = 0.f;
#pragma unroll
            for (int i = 0; i < 2; ++i) { const u32x4 w = cw[half][i];
                v[i * 8 + 0] = bflo(w.x); v[i * 8 + 1] = bfhi(w.x); v[i * 8 + 2] = bflo(w.y); v[i * 8 + 3] = bfhi(w.y); v[i * 8 + 4] = bflo(w.z); v[i * 8 + 5] = bfhi(w.z); v[i * 8 + 6] = bflo(w.w); v[i * 8 + 7] = bfhi(w.w); }
#pragma unroll
            for (int i = 0; i < 16; ++i) ss += v[i] * v[i];
            ss = wave_sum(ss);
            const float rstd = rsqrtf(ss * (1.0f / 1024.0f) + EPS);
#pragma unroll
            for (int i = 0; i < 2; ++i) { const int k = i * 512 + F.lane * 8; const f32x4 g0 = *(const f32x4*)(g + k), g1 = *(const f32x4*)(g + k + 4);
                u32x4 o; o.x = pack2(v[i * 8 + 0] * rstd * g0[0], v[i * 8 + 1] * rstd * g0[1]); o.y = pack2(v[i * 8 + 2] * rstd * g0[2], v[i * 8 + 3] * rstd * g0[3]);
                o.z = pack2(v[i * 8 + 4] * rstd * g1[0], v[i * 8 + 5] * rstd * g1[1]); o.w = pack2(v[i * 8 + 6] * rstd * g1[2], v[i * 8 + 7] * rstd * g1[3]);
                *(u32x4*)(MIX + (size_t)t * DM + half * 1024 + k) = o; }
        }
    }
}

template <int N> __device__ __forceinline__ void h2_step(float (&lg)[32], int lane, int m) {
    const bool hi = (lane & m) != 0;
#pragma unroll
    for (int j = 0; j < N; ++j) { float a = lg[j], b = lg[j + N]; asm volatile("" : "+v"(a), "+v"(b));
        const float keep = hi ? b : a, give = hi ? a : b; lg[j] = keep + __shfl_xor(give, m); }
}
__device__ __forceinline__ void p_h2(const Frame& F, int panel = -1, int pn = 0) {
    const bf16_t* X1 = (const bf16_t*)(F.ws + WS_X1); const float* g = F.in[I_GFFN]; const float* mod = F.modp(); const float* wr = F.in[I_WROUTER];
    bf16_t* H2 = (bf16_t*)(F.ws + WS_H2); float* AFF = (float*)(F.ws + WS_AFF);
    float* wt = (float*)F.lds;
    for (int idx = F.tid; idx < 2048 * 16; idx += NT) wt[(idx & 15) * 2052 + (idx >> 4)] = wr[idx];
    if (panel >= 0 && F.tid == 0) { unsigned* pc = (unsigned*)(F.ws + WS_CTL + 25088) + panel * 16; unsigned* tmo = (unsigned*)(F.ws + WS_CTL) + XB_TMO; unsigned sp = 0;
        while (__hip_atomic_load(pc, __ATOMIC_RELAXED, __HIP_MEMORY_SCOPE_AGENT) < 8u) { __builtin_amdgcn_s_sleep(2);
            if ((++sp & 255u) == 0u) { if (__hip_atomic_load(tmo, __ATOMIC_RELAXED, __HIP_MEMORY_SCOPE_AGENT)) break; if (sp > (1u << 20)) { atomicAdd(tmo, 1u); break; } } }
        __builtin_amdgcn_fence(__ATOMIC_ACQUIRE, "agent"); asm volatile("s_waitcnt vmcnt(0)" ::: "memory"); }
    __syncthreads();
    const int lane = F.lane;
    const int tp_first = panel >= 0 ? (panel * 256 + pn * 32) / 2 + F.wave : F.bid * 8 + F.wave, tp_step = panel >= 0 ? 8 : F.G * 8, tp_end = panel >= 0 ? (panel * 256 + pn * 32) / 2 + 16 : TOK / 2;
    for (int tp = tp_first; tp < tp_end; tp += tp_step) {
        const int t0 = 2 * tp, b = t0 >> 11, l0 = t0 & 2047; const bf16_t* xr = X1 + (size_t)t0 * DM;
        float ss0 = 0.f, ss1 = 0.f;
        u32x2 xw0[8], xw1[8];
        const bf16_t* xl = xr + lane * 4; const float* gl = g + lane * 4; const float* ml = mod + b * 12288 + 6144 + lane * 4;
#pragma unroll
        for (int i = 0; i < 8; ++i) { xw0[i] = *(const u32x2*)(xl + i * 256); xw1[i] = *(const u32x2*)(xl + DM + i * 256); }
        f32x4 ga[8], sb[8];
#pragma unroll
        for (int i = 0; i < 8; ++i) {
            const f32x4 gv = *(const f32x4*)(gl + i * 256), sc = *(const f32x4*)(ml + 2048 + i * 256); sb[i] = *(const f32x4*)(ml + i * 256);
#pragma unroll
            for (int j = 0; j < 4; ++j) ga[i][j] = gv[j] * (1.0f + sc[j]); }
#pragma unroll
        for (int i = 0; i < 8; ++i) { const f32x4 a0 = (f32x4){bflo(xw0[i].x), bfhi(xw0[i].x), bflo(xw0[i].y), bfhi(xw0[i].y)}, a1 = (f32x4){bflo(xw1[i].x), bfhi(xw1[i].x), bflo(xw1[i].y), bfhi(xw1[i].y)};
            ss0 += a0[0] * a0[0] + a0[1] * a0[1] + a0[2] * a0[2] + a0[3] * a0[3];
            ss1 += a1[0] * a1[0] + a1[1] * a1[1] + a1[2] * a1[2] + a1[3] * a1[3]; }
        __builtin_amdgcn_sched_barrier(0);
        ss0 = wave_sum(ss0); ss1 = wave_sum(ss1);
        const float r0 = rsqrtf(ss0 * (1.0f / DM) + EPS), r1 = rsqrtf(ss1 * (1.0f / DM) + EPS);
        f32x2 lg2[16];
#pragma unroll
        for (int e = 0; e < 16; ++e) lg2[e] = (f32x2){0.f, 0.f};
#pragma unroll
        for (int i = 0; i < 8; ++i) { const int k = i * 256 + lane * 4;
            const f32x4 a0 = (f32x4){bflo(xw0[i].x), bfhi(xw0[i].x), bflo(xw0[i].y), bfhi(xw0[i].y)}, a1 = (f32x4){bflo(xw1[i].x), bfhi(xw1[i].x), bflo(xw1[i].y), bfhi(xw1[i].y)};
            f32x4 o0, o1;
#pragma unroll
            for (int j = 0; j < 4; ++j) { o0[j] = (a0[j] * r0) * ga[i][j] + sb[i][j]; o1[j] = (a1[j] * r1) * ga[i][j] + sb[i][j]; }
            u32x2 w; w.x = pack2(o0[0], o0[1]); w.y = pack2(o0[2], o0[3]); *(u32x2*)(H2 + (size_t)t0 * DM + k) = w;
            w.x = pack2(o1[0], o1[1]); w.y = pack2(o1[2], o1[3]); *(u32x2*)(H2 + (size_t)(t0 + 1) * DM + k) = w;
            const f32x2 op0 = (f32x2){o0[0], o1[0]}, op1 = (f32x2){o0[1], o1[1]}, op2 = (f32x2){o0[2], o1[2]}, op3 = (f32x2){o0[3], o1[3]};
#pragma unroll
            for (int e = 0; e < 16; ++e) { const f32x4 wv = *(const f32x4*)(wt + e * 2052 + k);
                f32x2 a = lg2[e];
                a = __builtin_elementwise_fma(op0, (f32x2){wv[0], wv[0]}, a); a = __builtin_elementwise_fma(op1, (f32x2){wv[1], wv[1]}, a);
                a = __builtin_elementwise_fma(op2, (f32x2){wv[2], wv[2]}, a); a = __builtin_elementwise_fma(op3, (f32x2){wv[3], wv[3]}, a);
                lg2[e] = a;
                if ((e & 3) == 3) __builtin_amdgcn_sched_barrier(0); }
        }
        float lg[32];
#pragma unroll
        for (int e = 0; e < 16; ++e) { lg[e] = lg2[e][0]; lg[16 + e] = lg2[e][1]; }
h2_step<16>(lg, lane, 32); h2_step<8>(lg, lane, 16); h2_step<4>(lg, lane, 8); h2_step<2>(lg, lane, 4); h2_step<1>(lg, lane, 2);
        float z = lg[0] + __shfl_xor(lg[0], 1);
        float mx = z;
#pragma unroll
        for (int m = 2; m <= 16; m <<= 1) mx = fmaxf(mx, __shfl_xor(mx, m));
        const float ex = expf(z - mx); float den = ex;
#pragma unroll
        for (int m = 2; m <= 16; m <<= 1) den += __shfl_xor(den, m);
        if ((lane & 1) == 0) AFF[(size_t)(b * NE + ((lane >> 1) & 15)) * SEQ + l0 + (lane >> 5)] = ex / den;
    }
}

__device__ __forceinline__ int tk_block_excl_scan(int v, int tid, int lane, int wave, int* wsum, int& total) {
    int x = v;
#pragma unroll
    for (int o = 1; o < 64; o <<= 1) { const int y = __shfl_up(x, o); if (lane >= o) x += y; }
    if (lane == 63) wsum[wave] = x;
    __syncthreads();
    int off = 0, tot = 0;
#pragma unroll
    for (int w = 0; w < 8; ++w) { const int s = wsum[w]; if (w < wave) off += s; tot += s; }
    __syncthreads();
    total = tot; return off + x - v;
}
__device__ __forceinline__ void p_topk(const Frame& F) {
    int* hist = (int*)F.lds;
    int* ctl = hist + 256;
    int* wsum = hist + 272;
    const float* AFF = (const float*)(F.ws + WS_AFF); int* IDX = (int*)(F.ws + WS_IDX); float* WAFF = (float*)(F.ws + WS_WAFF); int* SLOT = (int*)(F.ws + WS_SLOT);
    const int tid = F.tid, lane = F.lane, wave = F.wave;
    for (int u = F.bid; u < NB * NE; u += F.G) {
        unsigned key[4];
        { const f32x4 v = *(const f32x4*)(AFF + (size_t)u * SEQ + 4 * tid);
#pragma unroll
          for (int s = 0; s < 4; ++s) key[s] = __float_as_uint(v[s]); }
        unsigned prefix = 0u; int remaining = CAP;
#pragma unroll
        for (int pass = 0; pass < 4; ++pass) {
            const int shift = 24 - 8 * pass;
            if (tid < 256) hist[tid] = 0;
            __syncthreads();
#pragma unroll
            for (int s = 0; s < 4; ++s) { const bool cand = (pass == 0) || ((key[s] >> (shift + 8)) == prefix); if (cand) atomicAdd(&hist[(key[s] >> shift) & 255u], 1); }
            __syncthreads();
            if (wave == 0) {
                const int h0 = hist[4 * lane], h1 = hist[4 * lane + 1], h2 = hist[4 * lane + 2], h3 = hist[4 * lane + 3];
                const int mine = h0 + h1 + h2 + h3;
                int suf = mine;
#pragma unroll
                for (int o = 1; o < 64; o <<= 1) { const int y = __shfl_down(suf, o); if (lane + o < 64) suf += y; }
                const int above = suf - mine;
                if (above < remaining && remaining <= suf) {
                    int d, ab;
                    if (above + h3 >= remaining) { d = 3; ab = above; }
                    else if (above + h3 + h2 >= remaining) { d = 2; ab = above + h3; }
                    else if (above + h3 + h2 + h1 >= remaining) { d = 1; ab = above + h3 + h2; }
                    else { d = 0; ab = above + h3 + h2 + h1; }
                    ctl[0] = 4 * lane + d; ctl[1] = remaining - ab;
                }
            }
            __syncthreads();
            prefix = (prefix << 8) | (unsigned)ctl[0]; remaining = ctl[1];
            __syncthreads();
        }
        const unsigned T = prefix; const int need = remaining;
        int neq = 0;
#pragma unroll
        for (int s = 0; s < 4; ++s) neq += (key[s] == T) ? 1 : 0;
        int toteq; int eqbase = tk_block_excl_scan(neq, tid, lane, wave, wsum, toteq);
        int nsel = 0; bool sel[4];
#pragma unroll
        for (int s = 0; s < 4; ++s) { const bool eq = (key[s] == T); sel[s] = (key[s] > T) || (eq && eqbase < need); if (eq) ++eqbase; nsel += sel[s] ? 1 : 0; }
        int totsel; int slot = tk_block_excl_scan(nsel, tid, lane, wave, wsum, totsel);
#pragma unroll
        for (int s = 0; s < 4; ++s) { const int tok = 4 * tid + s;
            if (sel[s]) { IDX[u * CAP + slot] = tok; WAFF[u * CAP + slot] = __uint_as_float(key[s]); SLOT[(size_t)u * SEQ + tok] = slot; ++slot; }
            else SLOT[(size_t)u * SEQ + tok] = -1; }
        __syncthreads();
    }
}

__device__ __forceinline__ void p_final(const Frame& F) {
    const bf16_t* X1 = (const bf16_t*)(F.ws + WS_X1); const float* mod = F.modp(); const float* g = F.in[I_GFINAL];
    const bf16_t* YE = (const bf16_t*)(F.ws + WS_YE); const int* SLOT = (const int*)(F.ws + WS_SLOT);
    const int tstep = F.G * 8;
    f32x4 gv[8];
#pragma unroll
    for (int i = 0; i < 8; ++i) gv[i] = *(const f32x4*)(g + i * 256 + F.lane * 4);
    for (int tb = F.bid * 8 + F.wave; tb < TOK; tb += 4 * tstep) {
        int sl[4];
#pragma unroll
        for (int k = 0; k < 4; ++k) { const int t = tb + k * tstep; sl[k] = -1;
            if (t < TOK && F.lane < NE) sl[k] = SLOT[(size_t)((t >> 11) * NE + F.lane) * SEQ + (t & 2047)]; }
#pragma unroll
        for (int k = 0; k < 4; ++k) { const int t = tb + k * tstep; if (t >= TOK) break;
            const int b = t >> 11;
            u32x2 xw[8]; f32x4 gt[8];
#pragma unroll
            for (int i = 0; i < 8; ++i) { xw[i] = __builtin_nontemporal_load((const u32x2*)(X1 + (size_t)t * DM + i * 256 + F.lane * 4)); gt[i] = *(const f32x4*)(mod + b * 12288 + 10240 + i * 256 + F.lane * 4); }
            f32x4 mo[8];
#pragma unroll
            for (int i = 0; i < 8; ++i) mo[i] = (f32x4){0.f, 0.f, 0.f, 0.f};
            unsigned m = (unsigned)__ballot(sl[k] >= 0) & 0xFFFFu;
            while (m) {
                const bf16_t* yr[4]; int n = 0;
#pragma unroll
                for (int j = 0; j < 4; ++j) { yr[j] = YE; if (m) { const int e = __builtin_ctz(m); m &= m - 1u; const int s = __builtin_amdgcn_readlane(sl[k], e); yr[j] = YE + ((size_t)e * 1024 + b * 256 + s) * DM; n = j + 1; } }
                u32x2 y[4][8];
#pragma unroll
                for (int j = 0; j < 4; ++j) if (j < n) {
#pragma unroll
                    for (int i = 0; i < 8; ++i) y[j][i] = __builtin_nontemporal_load((const u32x2*)(yr[j] + i * 256 + F.lane * 4)); }
#pragma unroll
                for (int j = 0; j < 4; ++j) if (j < n) {
#pragma unroll
                    for (int i = 0; i < 8; ++i) { mo[i][0] += bflo(y[j][i].x); mo[i][1] += bfhi(y[j][i].x); mo[i][2] += bflo(y[j][i].y); mo[i][3] += bfhi(y[j][i].y); } }
            }
            f32x4 v[8]; float ss = 0.f;
#pragma unroll
            for (int i = 0; i < 8; ++i) { const f32x4 xv = (f32x4){bflo(xw[i].x), bfhi(xw[i].x), bflo(xw[i].y), bfhi(xw[i].y)};
                v[i] = xv + gt[i] * mo[i]; ss += v[i][0] * v[i][0] + v[i][1] * v[i][1] + v[i][2] * v[i][2] + v[i][3] * v[i][3]; }
            ss = wave_sum(ss);
            const float rstd = rsqrtf(ss * (1.0f / DM) + EPS);
#pragma unroll
            for (int i = 0; i < 8; ++i) *(f32x4*)(F.out + (size_t)t * DM + i * 256 + F.lane * 4) = v[i] * rstd * gv[i];
        }
    }
}

constexpr int N_PHASES = 14;
__global__ void __launch_bounds__(NT, 2) fwd(Args args) {
    extern __shared__ __attribute__((aligned(16))) unsigned char lds[];
    Frame F;
#pragma unroll
    for (int i = 0; i < 26; ++i) F.in[i] = args.in[i];
    F.out = args.out; F.ws = args.ws; F.lds = lds;
    F.tid = threadIdx.x; F.lane = F.tid & 63; F.wave = __builtin_amdgcn_readfirstlane(F.tid >> 6); F.G = gridDim.x; F.bid = blockIdx.x;
    const int lo = args.ph_lo, hi = args.ph_hi;
    XcdBarrier bar; bar.bar = (unsigned*)(F.ws + WS_CTL); bar.x = 0; bar.nloc = 0u; bar.nx = 0u;
    if (hi - lo > 1) bar = xcd_barrier_post((unsigned*)(F.ws + WS_CTL));
    bool bar_ready = false;
#define IN(k) (lo <= (k) && (k) < hi)
#define GRID_BAR() do { if (!bar_ready) { xcd_barrier_setup(bar); bar_ready = true; } xcd_barrier(bar); } while (0)
#define SEAM(k) do { if (IN(k) && IN((k) + 1)) GRID_BAR(); } while (0)
#define ADA_DONE() do { asm volatile("s_waitcnt vmcnt(0)" ::: "memory"); __syncthreads();          \
        if (F.tid == 0) { __hip_atomic_fetch_add((unsigned*)(F.ws + WS_CTL + 24832), 1u, __ATOMIC_RELAXED, __HIP_MEMORY_SCOPE_AGENT); } } while (0)
#define ADA_WAIT() do { if (F.tid == 0) { unsigned* acnt_ = (unsigned*)(F.ws + WS_CTL + 24832); unsigned* tmo_ = (unsigned*)(F.ws + WS_CTL) + XB_TMO; unsigned sp_ = 0; \
            while (__hip_atomic_load(acnt_, __ATOMIC_RELAXED, __HIP_MEMORY_SCOPE_AGENT) < (unsigned)F.G) { __builtin_amdgcn_s_sleep(2); \
                if ((++sp_ & 255u) == 0u) { if (__hip_atomic_load(tmo_, __ATOMIC_RELAXED, __HIP_MEMORY_SCOPE_AGENT)) break; if (sp_ > (1u << 20)) { atomicAdd(tmo_, 1u); break; } } } \
            __builtin_amdgcn_fence(__ATOMIC_ACQUIRE, "agent"); asm volatile("s_waitcnt vmcnt(0)" ::: "memory"); } \
        __syncthreads(); } while (0)
    f32x4 code_touch = (f32x4){0.f, 0.f, 0.f, 0.f};
    if (IN(0)) { unsigned long long pc_; asm volatile("s_getpc_b64 %0" : "=s"(pc_));
        const char* cp_ = (const char*)(pc_ & ~0xFFFull) + (size_t)(F.bid >> 3) * 8192 + (size_t)F.tid * 16;
        asm volatile("global_load_dwordx4 %0, %1, off" : "+v"(code_touch) : "v"(cp_)); }
    if (IN(0)) { for (int rep_ = 0; rep_ <= REPS(0); ++rep_) { if (FAST_SSM && F.G == 256) {
            if (F.bid < 128) { p_ada(F, F.bid, 128, 256); ADA_DONE(); p_ssm_prep(F, F.bid >> 1, F.bid & 1, 2); }
            else { p_ada(F, 128 + F.bid, 128, 768); ADA_DONE(); p_wconv(F, F.bid - 128, 128); }
        } else { p_ada(F, F.bid, F.G, 768); p_wconv(F, F.bid, F.G); if (FAST_SSM) for (int g = F.bid; g < NG; g += F.G) p_ssm_prep(F, g, 0, 1); } __syncthreads(); } } asm volatile("s_waitcnt vmcnt(0)" :: "v"(code_touch) : "memory");
    if (IN(0) && IN(1)) { if (FAST_SSM && F.G == 256) ADA_WAIT(); else GRID_BAR(); }
    if (IN(1)) { for (int rep_ = 0; rep_ <= REPS(1); ++rep_) { p_h1(F); __syncthreads(); } } SEAM(1);
    if (IN(2)) { for (int rep_ = 0; rep_ <= REPS(2); ++rep_) { if (FAST_INPROJ) p_inproj_fast(F); else p_inproj_naive(F); __syncthreads(); } } SEAM(2);
    if (IN(3)) { for (int rep_ = 0; rep_ <= REPS(3); ++rep_) { if (FAST_SSM && FAST_ATTN) p_mixer(F); else { p_ssm_naive(F); __syncthreads(); p_attn_naive(F); } __syncthreads(); } } do { if (IN(3) && IN(6) && IN(8)) GRID_BAR(); } while (0);
    if (IN(6) && !(FAST_SSM && FAST_ATTN && FAST_GLU && F.G == 256)) { for (int rep_ = 0; rep_ <= REPS(6); ++rep_) { if (FAST_GLU) p_glu_fast(F); else p_glu_naive(F); __syncthreads(); } if (IN(8)) GRID_BAR(); }
    if (IN(8)) { for (int rep_ = 0; rep_ <= REPS(8); ++rep_) { if (FAST_OUT) p_outproj_fast(F); else p_outproj_naive(F); __syncthreads(); } }
    const bool h2_by_panel = FAST_OUT && F.G == 256 && IN(8) && IN(9) && PROBE_MASK == 0;
    if (IN(8) && IN(9) && !h2_by_panel) GRID_BAR();
    if (IN(9)) { for (int rep_ = 0; rep_ <= REPS(9); ++rep_) { if (h2_by_panel) { int pm_, pn_; tile_of(unit_of(F, 0), 8, pm_, pn_); p_h2(F, pm_, pn_); } else p_h2(F); __syncthreads(); } } SEAM(9);
    if (IN(10)) { for (int rep_ = 0; rep_ <= REPS(10); ++rep_) { p_topk(F); __syncthreads(); } }
    if (IN(10) && IN(11) && FAST_MOE1 && F.bid >= NB * NE) {
        const int v_ = unit_of(F, 0), pn_ = (v_ >> 2) % 22, e_ = (v_ >> 2) / 22; float tv_[4];
#pragma unroll
        for (int j = 0; j < 4; ++j) { const int id = F.tid * 4 + j, k = id >> 3, rem = id & 7;
            tv_[j] = (((rem >> 2) ? F.in[I_WUP] : F.in[I_WGATE]) + (size_t)e_ * DM * DFF + (size_t)k * DFF + pn_ * 128 + (rem & 3) * 32)[0]; }
        asm volatile("" :: "v"(tv_[0]), "v"(tv_[1]), "v"(tv_[2]), "v"(tv_[3])); }
    SEAM(10);
    if (IN(11)) { for (int rep_ = 0; rep_ <= REPS(11); ++rep_) { if (FAST_MOE1) p_moe1_fast(F); else p_moe1_naive(F); __syncthreads(); } } SEAM(11);
    if (IN(12)) { for (int rep_ = 0; rep_ <= REPS(12); ++rep_) { if (FAST_MOE2) p_moe2_fast(F); else p_moe2_naive(F); __syncthreads(); } }
    SEAM(12);
    if (PROBE_ABL >= 0 && IN(12)) { GRID_BAR(); p_moe1_probe(F); }
#if PROBE_X == 1
    if (IN(12)) { GRID_BAR(); p_attn_fast(F); }
#elif PROBE_X == 2
    if (IN(12)) { GRID_BAR(); for (int u = F.bid; u < 2 * NG; u += F.G) { const int g = u >> 1, pm = u & 1;
        const ARows A{(const bf16_t*)(F.ws + WS_UX) + (size_t)g * 512 * 512, 512};
        { B2Bf16 Bl; Bl.base = (const bf16_t*)(F.ws + WS_BMAT) + (size_t)g * 256 * 256; Bl.ld = 256; const EpiS E{(float*)(F.ws + WS_SS) + (size_t)g * 512 * 256};
          gemm_tile2<ARows, B2Bf16, EpiS, false>(F.lds, A, Bl, E, pm * 256, 0, 256); }
        asm volatile("s_waitcnt vmcnt(0)" ::: "memory"); __syncthreads(); ssm_scan_half(F, g, pm); asm volatile("s_waitcnt vmcnt(0)" ::: "memory"); __syncthreads();
        { B2Bf16 Bl; Bl.base = (const bf16_t*)(F.ws + WS_KCMAT) + (size_t)g * 512 * 256; Bl.ld = 256; const EpiY E{(bf16_t*)(F.ws + WS_ZB), g};
          gemm_tile2<ARows, B2Bf16, EpiY, false>(F.lds, A, Bl, E, pm * 256, 0, 512); } __syncthreads(); } }
#elif PROBE_X == 4
    if (IN(12)) { GRID_BAR(); for (int u = F.bid; u < 2 * NG; u += F.G) { const int g = u >> 1, pm = u & 1; ssm_scan_half(F, g, pm); } }
#elif PROBE_X == 3
    if (IN(12)) { GRID_BAR(); }
#endif
    if (IN(13)) { for (int rep_ = 0; rep_ <= REPS(13); ++rep_) { p_final(F); __syncthreads(); } }
#undef IN
#undef SEAM
}

extern "C" void kernel_launch(void* const* d_in, const int* in_sizes, int n_in, void* d_out, int out_size, void* d_ws, size_t ws_size, hipStream_t stream) {
    static int grid = 0;
    if (grid == 0) {
        if (n_in != 26 || out_size != TOK * DM || ws_size < WS_END) { fprintf(stderr, "kernel_launch: unexpected problem (n_in %d out %d ws %zu need %zu)\n", n_in, out_size, ws_size, (size_t)WS_END); grid = -1; return; }
        int dev = 0, cus = 0, per_cu = 0;
        if (hipGetDevice(&dev) != hipSuccess || hipDeviceGetAttribute(&cus, hipDeviceAttributeMultiprocessorCount, dev) != hipSuccess) { grid = -1; return; }
        if (hipFuncSetAttribute((const void*)fwd, hipFuncAttributeMaxDynamicSharedMemorySize, LDS_BYTES) != hipSuccess) { fprintf(stderr, "kernel_launch: hipFuncSetAttribute failed\n"); grid = -1; return; }
        if (hipOccupancyMaxActiveBlocksPerMultiprocessor(&per_cu, (const void*)fwd, NT, LDS_BYTES) != hipSuccess || per_cu < 1) { fprintf(stderr, "kernel_launch: occupancy query says %d\n", per_cu); }
        (void)hipGetLastError();
        grid = cus;
    }
    if (grid < 0) return;
    (void)hipMemsetAsync((char*)d_ws + WS_CTL, 0, CTL_BYTES + (size_t)NB * 12288 * 4, stream);
    Args a{};
    for (int i = 0; i < 26; ++i) a.in[i] = (const float*)d_in[i];
    a.out = (float*)d_out; a.ws = (unsigned char*)d_ws;
#if N_LAUNCH_MODE == 1
    a.ph_lo = 0; a.ph_hi = N_PHASES;
    hipLaunchKernelGGL(fwd, dim3(grid), dim3(NT), LDS_BYTES, stream, a);
#else
    for (int p = 0; p < N_PHASES; ++p) {
        if (p == 4 || p == 5) continue;
        a.ph_lo = p; a.ph_hi = p + 1;
        hipLaunchKernelGGL(fwd, dim3(grid), dim3(NT), LDS_BYTES, stream, a);
    }
#endif
}
```
